# Optimizing an MI355X kernel written in HIP

```python
import math
import jax
import jax.numpy as jnp
from jax import lax
import numpy as np

D_MODEL = 1024
BATCH = 16
SEQ = 2048
DEPTH = 4

GRID_W = 64
CTX_LEN = 256
N_BRANCH = 4
BRANCH_W = D_MODEL // N_BRANCH
HEAD_DIM = 64
N_HEADS = BRANCH_W // HEAD_DIM
FOURIER_GROUPS = N_HEADS
CHUNK = 64
CONV_K = 5
SSD_STATE = 64
SSD_GROUPS = 2
N_EXPERTS = 16
EXPERT_FF = 1024
EC_CAPACITY_FACTOR = 2
DEEPNORM_ALPHA = (2.0 * DEPTH) ** 0.25
DEEPNORM_BETA = (8.0 * DEPTH) ** -0.25
NORM_EPS = 1e-6

IN_SPLITS = (
    ("a_q", BRANCH_W), ("a_f_fwd", BRANCH_W), ("a_f_bwd", BRANCH_W), ("a_v", BRANCH_W), ("a_g", BRANCH_W),
    ("b_qkv", 3 * BRANCH_W), ("b_g", BRANCH_W), ("b_a", 2 * N_HEADS), ("b_beta", 2 * N_HEADS),
    ("c_u", BRANCH_W),
    ("d_xbc", BRANCH_W + 2 * SSD_GROUPS * SSD_STATE), ("d_z", BRANCH_W), ("d_dt", 2 * N_HEADS),
)
IN_COLS = sum(s for _, s in IN_SPLITS)

kernel_name = "hybrid_bidir_diffusion_trunk"


def _layer_norm(x):
    xf = x.astype(jnp.float32)
    mu = jnp.mean(xf, axis=-1, keepdims=True)
    var = jnp.mean(jnp.square(xf - mu), axis=-1, keepdims=True)
    return (xf - mu) * lax.rsqrt(var + NORM_EPS)


def post_norm(x, g, b):
    return (_layer_norm(x) * g + b).astype(x.dtype)


def modulate(x, shift, scale):
    return (_layer_norm(x) * (1.0 + scale) + shift).astype(x.dtype)


def _rms(x):
    return x * lax.rsqrt(jnp.mean(jnp.square(x), axis=-1, keepdims=True) + NORM_EPS)


def to_heads(x):
    b_, t_, w_ = x.shape
    return x.reshape(b_, t_, N_HEADS, w_ // N_HEADS).transpose(0, 2, 1, 3)


def from_heads(x):
    b_, h_, t_, d_ = x.shape
    return x.transpose(0, 2, 1, 3).reshape(b_, t_, h_ * d_)


def head_rms_norm(o, w):
    return from_heads(_rms(o)) * w


def l2norm(x):
    return x * lax.rsqrt(jnp.sum(jnp.square(x), axis=-1, keepdims=True) + NORM_EPS)


def split_columns(z):
    sizes = [s for _, s in IN_SPLITS]
    parts = jnp.split(z, np.cumsum(sizes)[:-1].tolist(), axis=-1)
    return {name: p for (name, _), p in zip(IN_SPLITS, parts)}


def conv_centred(x, w):
    pad = CONV_K // 2
    return lax.conv_general_dilated(x, w[:, None, :], window_strides=(1,), padding=[(pad, pad)],
                                    dimension_numbers=("NWC", "WIO", "NWC"),
                                    feature_group_count=x.shape[-1])


def sincos_grid(rows, cols, dim):
    quarter = dim // 4
    omega = 1.0 / (10000.0 ** (jnp.arange(quarter, dtype=jnp.float32) / quarter))
    er = jnp.arange(rows, dtype=jnp.float32)[:, None] * omega
    ec = jnp.arange(cols, dtype=jnp.float32)[:, None] * omega
    er = jnp.concatenate([jnp.sin(er), jnp.cos(er)], axis=-1)
    ec = jnp.concatenate([jnp.sin(ec), jnp.cos(ec)], axis=-1)
    emb = jnp.concatenate([jnp.broadcast_to(er[:, None, :], (rows, cols, dim // 2)),
                           jnp.broadcast_to(ec[None, :, :], (rows, cols, dim // 2))], axis=-1)
    return emb.reshape(rows * cols, dim)


def _chunk(x):
    return x.reshape(x.shape[0], x.shape[1], x.shape[2] // CHUNK, CHUNK, *x.shape[3:])


def _tri():
    return jnp.tril(jnp.ones((CHUNK, CHUNK), dtype=bool))


def gla_vector_scan(q, k, v, logf, s0):
    tri = _tri()
    xs = tuple(jnp.moveaxis(_chunk(a), 2, 0) for a in (q, k, v, logf))

    def step(S, inp):
        qc, kc, vc, lf = inp
        g = jnp.cumsum(lf, axis=2)
        rel = jnp.where(tri[:, :, None], g[:, :, :, None, :] - g[:, :, None, :, :], -jnp.inf)
        att = jnp.einsum("bhid,bhijd,bhjd->bhij", qc, jnp.exp(rel), kc)
        g_last = g[:, :, -1:, :]
        o = att @ vc + (qc * jnp.exp(g)) @ S
        S = jnp.exp(g_last[:, :, 0, :, None]) * S + jnp.einsum("bhjd,bhje->bhde", kc * jnp.exp(g_last - g), vc)
        return S, o

    S, o = lax.scan(step, s0, xs)
    return jnp.moveaxis(o, 0, 2).reshape(v.shape), S


def ssd_scan(q, k, v, loga, s0):
    tri = _tri()
    qc, kc, vc, la = _chunk(q), _chunk(k), _chunk(v), _chunk(loga)
    g = jnp.cumsum(la, axis=-1)
    L = jnp.exp(jnp.where(tri, g[..., :, None] - g[..., None, :], -jnp.inf))
    o_intra = jnp.einsum("bhnij,bhnje->bhnie", jnp.einsum("bhnid,bhnjd->bhnij", qc, kc) * L, vc)
    g_last = g[..., -1]
    dS = jnp.einsum("bhnjd,bhnje->bhnde", kc * jnp.exp(g_last[..., None] - g)[..., None], vc)

    def step(S, inp):
        dS_c, gl_c = inp
        return jnp.exp(gl_c)[..., None, None] * S + dS_c, S

    S_T, S_in = lax.scan(step, s0, (jnp.moveaxis(dS, 2, 0), jnp.moveaxis(g_last, 2, 0)))
    S_in = jnp.moveaxis(S_in, 0, 2)
    o = o_intra + jnp.einsum("bhnid,bhnde->bhnie", qc * jnp.exp(g)[..., None], S_in)
    return o.reshape(v.shape), S_T


def gated_delta_scan(q, k, v, loga, beta, s0):
    tri = _tri()
    strict = tri & ~jnp.eye(CHUNK, dtype=bool)
    qc, kc, vc, la, bt = _chunk(q), _chunk(k), _chunk(v), _chunk(loga), _chunk(beta)
    g = jnp.cumsum(la, axis=-1)
    L = jnp.exp(jnp.where(tri, g[..., :, None] - g[..., None, :], -jnp.inf))
    a_mat = jnp.where(strict, bt[..., :, None] * jnp.einsum("bhnid,bhnjd->bhnij", kc, kc) * L, 0.0)
    t_mat = a_mat + jnp.eye(CHUNK, dtype=a_mat.dtype)
    u = lax.linalg.triangular_solve(t_mat, bt[..., None] * vc, left_side=True, lower=True, unit_diagonal=True)
    w = lax.linalg.triangular_solve(t_mat, bt[..., None] * kc * jnp.exp(g)[..., None],
                                    left_side=True, lower=True, unit_diagonal=True)
    qk = jnp.einsum("bhnid,bhnjd->bhnij", qc, kc) * L
    g_last = g[..., -1]
    q_dec = qc * jnp.exp(g)[..., None]
    k_dec = kc * jnp.exp(g_last[..., None] - g)[..., None]
    xs = tuple(jnp.moveaxis(a, 2, 0) for a in (u, w, qk, q_dec, k_dec, g_last))

    def step(S, inp):
        u_c, w_c, qk_c, qd_c, kd_c, gl_c = inp
        v_new = u_c - w_c @ S
        o_c = qd_c @ S + qk_c @ v_new
        S = jnp.exp(gl_c)[..., None, None] * S + jnp.einsum("bhjd,bhje->bhde", kd_c, v_new)
        return S, o_c

    S, o = lax.scan(step, s0, xs)
    return jnp.moveaxis(o, 0, 2).reshape(v.shape), S


def bidirectional(scan_fn, ctx_fwd, lat_fwd, ctx_bwd, lat_bwd, s0):
    def flip(t):
        return tuple(jnp.flip(a, axis=2) for a in t)
    oc_f, sc_f = scan_fn(*ctx_fwd, s0)
    ol_f, _ = scan_fn(*lat_fwd, sc_f)
    oc_b, sc_b = scan_fn(*flip(ctx_bwd), s0)
    ol_b, _ = scan_fn(*flip(lat_bwd), sc_b)
    return oc_f + jnp.flip(oc_b, axis=2), ol_f + jnp.flip(ol_b, axis=2)


def hgrn_lower_bounds(logits):
    cum = jnp.cumsum(jax.nn.softmax(logits.astype(jnp.float32), axis=1), axis=1)
    return cum - cum[:, :1]


def hgrn2_mixer(zc, zl, lb, norm_w):
    def inputs(z, d):
        zf = z[("a_f_fwd", "a_f_bwd")[d]].astype(jnp.float32)
        lbd = lb[d]
        logf = jnp.logaddexp(jnp.log(lbd), jnp.log1p(-lbd) + jax.nn.log_sigmoid(zf))
        inp = (1.0 - lbd) * jax.nn.sigmoid(-zf)
        q = jax.nn.silu(z["a_q"].astype(jnp.float32))
        v = z["a_v"].astype(jnp.float32)
        return (to_heads(q), to_heads(inp), to_heads(v), to_heads(logf))

    b_ = zc["a_q"].shape[0]
    s0 = jnp.zeros((b_, N_HEADS, HEAD_DIM, HEAD_DIM), jnp.float32)
    oc, ol = bidirectional(gla_vector_scan, inputs(zc, 0), inputs(zl, 0), inputs(zc, 1), inputs(zl, 1), s0)

    def finish(o, z):
        return head_rms_norm(o, norm_w) * jax.nn.silu(z["a_g"].astype(jnp.float32))
    return finish(oc, zc), finish(ol, zl)


def gated_deltanet_mixer(zc, zl, conv_w, a_log, dt_bias, norm_w):
    def inputs(z):
        qkv = jax.nn.silu(conv_centred(z["b_qkv"], conv_w)).astype(jnp.float32)
        q, k, v = jnp.split(qkv, 3, axis=-1)
        q = l2norm(to_heads(q)) * HEAD_DIM ** -0.5
        k = l2norm(to_heads(k))
        v = to_heads(v)
        a = z["b_a"].astype(jnp.float32)
        bb = z["b_beta"].astype(jnp.float32)
        dirs = []
        for d in range(2):
            sl = slice(d * N_HEADS, (d + 1) * N_HEADS)
            loga = -jnp.exp(a_log[d].astype(jnp.float32)) * jax.nn.softplus(a[..., sl] + dt_bias[d])
            beta = jax.nn.sigmoid(bb[..., sl])
            dirs.append((q, k, v, jnp.swapaxes(loga, 1, 2), jnp.swapaxes(beta, 1, 2)))
        return dirs

    ctx_in, lat_in = inputs(zc), inputs(zl)
    b_ = zc["b_g"].shape[0]
    s0 = jnp.zeros((b_, N_HEADS, HEAD_DIM, HEAD_DIM), jnp.float32)
    oc, ol = bidirectional(gated_delta_scan, ctx_in[0], lat_in[0], ctx_in[1], lat_in[1], s0)

    def finish(o, z):
        return head_rms_norm(o, norm_w) * jax.nn.silu(z["b_g"].astype(jnp.float32))
    return finish(oc, zc), finish(ol, zl)


def fourier_mixer(u):
    b_, t_, _ = u.shape
    ug = u.astype(jnp.float32).reshape(b_, t_, FOURIER_GROUPS, BRANCH_W // FOURIER_GROUPS)
    return jnp.fft.fft2(ug, axes=(1, 3), norm="ortho").real.reshape(b_, t_, BRANCH_W)


def ssd_mixer(zc, zl, conv_w, conv_b, a_log, dt_bias, d_skip, norm_w):
    def group_heads(t):
        b_, t_, _ = t.shape
        t = jnp.repeat(t.reshape(b_, t_, SSD_GROUPS, SSD_STATE), N_HEADS // SSD_GROUPS, axis=2)
        return t.transpose(0, 2, 1, 3)

    def inputs(z):
        xbc = jax.nn.silu(conv_centred(z["d_xbc"], conv_w) + conv_b).astype(jnp.float32)
        xs, bs, cs = jnp.split(xbc, [BRANCH_W, BRANCH_W + SSD_GROUPS * SSD_STATE], axis=-1)
        xh, bh, ch = to_heads(xs), group_heads(bs), group_heads(cs)
        dt_raw = z["d_dt"].astype(jnp.float32)
        dirs = []
        for d in range(2):
            dt = jax.nn.softplus(dt_raw[..., d * N_HEADS:(d + 1) * N_HEADS] + dt_bias[d])
            dt = jnp.swapaxes(dt, 1, 2)
            loga = -jnp.exp(a_log[d].astype(jnp.float32))[:, None] * dt
            dirs.append((ch, bh, xh * dt[..., None], loga))
        return xh, dirs

    xh_c, ctx_in = inputs(zc)
    xh_l, lat_in = inputs(zl)
    b_ = xh_c.shape[0]
    s0 = jnp.zeros((b_, N_HEADS, SSD_STATE, HEAD_DIM), jnp.float32)
    oc, ol = bidirectional(ssd_scan, ctx_in[0], lat_in[0], ctx_in[1], lat_in[1], s0)

    def finish(o, xh, z):
        y = from_heads(o + d_skip[:, None, None] * xh) * jax.nn.silu(z["d_z"].astype(jnp.float32))
        return _rms(y) * norm_w
    return finish(oc, xh_c, zc), finish(ol, xh_l, zl)


def merge_branches(h, outs, w_gate, b_gate, w_branch, w_out):
    t = [jax.nn.sigmoid(h @ w_gate[g] + b_gate[g]) * (outs[g].astype(h.dtype) @ w_branch[g])
         for g in range(N_BRANCH)]
    return (t[0] + t[1] + t[2] + t[3]) @ w_out


def token_mixer(hc, hl, w_in, lb, hgrn_norm_w, gdn_conv_w, gdn_a_log, gdn_dt_bias, gdn_norm_w,
                ssd_conv_w, ssd_conv_b, ssd_a_log, ssd_dt_bias, ssd_d, ssd_norm_w,
                w_gate, b_gate, w_branch, w_out, with_ctx):
    zc = split_columns(hc @ w_in)
    zl = split_columns(hl @ w_in)
    a_c, a_l = hgrn2_mixer(zc, zl, lb, hgrn_norm_w)
    b_c, b_l = gated_deltanet_mixer(zc, zl, gdn_conv_w, gdn_a_log, gdn_dt_bias, gdn_norm_w)
    d_c, d_l = ssd_mixer(zc, zl, ssd_conv_w, ssd_conv_b, ssd_a_log, ssd_dt_bias, ssd_d, ssd_norm_w)
    y_l = merge_branches(hl, (a_l, b_l, fourier_mixer(zl["c_u"]), d_l), w_gate, b_gate, w_branch, w_out)
    y_c = None
    if with_ctx:
        y_c = merge_branches(hc, (a_c, b_c, fourier_mixer(zc["c_u"]), d_c), w_gate, b_gate, w_branch, w_out)
    return y_c, y_l


def expert_choice_ffn(h, w_router, w_ff_gate, w_ff_up, w_ff_down):
    b_, t_, _ = h.shape
    cap = EC_CAPACITY_FACTOR * t_ // N_EXPERTS
    aff = jax.nn.softmax(jnp.einsum("btd,de->bte", h, w_router).astype(jnp.float32), axis=-1)
    weight, idx = lax.top_k(jnp.swapaxes(aff, 1, 2), cap)
    bidx = jnp.arange(b_)[:, None, None]
    xe = h[bidx, idx]
    hid = jax.nn.silu(jnp.einsum("becd,edf->becf", xe, w_ff_gate)) * jnp.einsum("becd,edf->becf", xe, w_ff_up)
    ye = jnp.einsum("becf,efd->becd", hid, w_ff_down) * weight[..., None].astype(h.dtype)
    return jnp.zeros_like(h).at[bidx, idx].add(ye)


def setup_inputs(seed: int = 0) -> dict:
    key = jax.random.key(seed)
    ks = iter(jax.random.split(key, 48))
    f32 = jnp.float32
    L, D, W, H, E, F = DEPTH, D_MODEL, BRANCH_W, N_HEADS, N_EXPERTS, EXPERT_FF
    XBC = W + 2 * SSD_GROUPS * SSD_STATE

    def nrm(shape, scale):
        return jax.random.normal(next(ks), shape, f32) * scale

    def gain(shape):
        return 1.0 + nrm(shape, 0.02)

    def a_log_init(shape):
        return jnp.log(jax.random.uniform(next(ks), shape, f32, 1.0, 16.0))

    def dt_bias_init(shape):
        dt = jnp.exp(jax.random.uniform(next(ks), shape, f32, math.log(1e-3), math.log(1e-1)))
        return dt + jnp.log(-jnp.expm1(-dt))

    return {
        "x": nrm((BATCH, SEQ, D), 1.0),
        "c": nrm((BATCH, D), 1.0),
        "ctx": nrm((BATCH, CTX_LEN, D), 1.0),
        "c_ctx": nrm((D,), 1.0),
        "ada_w": nrm((L, D, 6 * D), 0.5 * D ** -0.5),
        "ada_b": nrm((L, 6 * D), 0.02),
        "w_in": nrm((L, D, IN_COLS), D ** -0.5),
        "hgrn_lb_logits": nrm((2, L, W), 0.5),
        "hgrn_norm_w": gain((L, W)),
        "gdn_conv_w": nrm((L, CONV_K, 3 * W), CONV_K ** -0.5),
        "gdn_a_log": a_log_init((L, 2, H)),
        "gdn_dt_bias": dt_bias_init((L, 2, H)),
        "gdn_norm_w": gain((L, W)),
        "ssd_conv_w": nrm((L, CONV_K, XBC), CONV_K ** -0.5),
        "ssd_conv_b": nrm((L, XBC), 0.02),
        "ssd_a_log": a_log_init((L, 2, H)),
        "ssd_dt_bias": dt_bias_init((L, 2, H)),
        "ssd_d": gain((L, H)),
        "ssd_norm_w": gain((L, W)),
        "w_gate": nrm((L, N_BRANCH, D, D), D ** -0.5),
        "b_gate": nrm((L, N_BRANCH, D), 0.02),
        "w_branch": nrm((L, N_BRANCH, W, D), W ** -0.5),
        "w_out": nrm((L, D, D), DEEPNORM_BETA * D ** -0.5),
        "ln1_g": gain((L, D)),
        "ln1_b": nrm((L, D), 0.02),
        "w_router": nrm((L, D, E), D ** -0.5),
        "w_ff_gate": nrm((L, E, D, F), D ** -0.5),
        "w_ff_up": nrm((L, E, D, F), D ** -0.5),
        "w_ff_down": nrm((L, E, F, D), DEEPNORM_BETA * F ** -0.5),
        "ln2_g": gain((L, D)),
        "ln2_b": nrm((L, D), 0.02),
    }


def reference(x, c, ctx, c_ctx, ada_w, ada_b, w_in, hgrn_lb_logits, hgrn_norm_w,
              gdn_conv_w, gdn_a_log, gdn_dt_bias, gdn_norm_w,
              ssd_conv_w, ssd_conv_b, ssd_a_log, ssd_dt_bias, ssd_d, ssd_norm_w,
              w_gate, b_gate, w_branch, w_out, ln1_g, ln1_b,
              w_router, w_ff_gate, w_ff_up, w_ff_down, ln2_g, ln2_b):
    n_lat = x.shape[1]
    rows = n_lat // GRID_W
    xl = x + sincos_grid(rows, GRID_W, D_MODEL).astype(x.dtype)
    xc = ctx
    lb_all = hgrn_lower_bounds(hgrn_lb_logits)
    for l in range(DEPTH):
        with_ctx = l < DEPTH - 1
        mod_l = jax.nn.silu(c) @ ada_w[l] + ada_b[l]
        mod_c = jax.nn.silu(c_ctx) @ ada_w[l] + ada_b[l]
        sh1_l, sc1_l, g1_l, sh2_l, sc2_l, g2_l = jnp.split(mod_l[:, None, :], 6, axis=-1)
        sh1_c, sc1_c, g1_c, sh2_c, sc2_c, g2_c = jnp.split(mod_c, 6, axis=-1)
        hl = modulate(xl, sh1_l, sc1_l)
        hc = modulate(xc, sh1_c, sc1_c)
        y_c, y_l = token_mixer(hc, hl, w_in[l], lb_all[:, l], hgrn_norm_w[l],
                               gdn_conv_w[l], gdn_a_log[l], gdn_dt_bias[l], gdn_norm_w[l],
                               ssd_conv_w[l], ssd_conv_b[l], ssd_a_log[l], ssd_dt_bias[l], ssd_d[l], ssd_norm_w[l],
                               w_gate[l], b_gate[l], w_branch[l], w_out[l], with_ctx)
        xl = post_norm(DEEPNORM_ALPHA * xl + g1_l * y_l, ln1_g[l], ln1_b[l])
        hl2 = modulate(xl, sh2_l, sc2_l)
        xl = post_norm(DEEPNORM_ALPHA * xl + g2_l * expert_choice_ffn(hl2, w_router[l], w_ff_gate[l], w_ff_up[l], w_ff_down[l]),
                       ln2_g[l], ln2_b[l])
        if with_ctx:
            xc = post_norm(DEEPNORM_ALPHA * xc + g1_c * y_c, ln1_g[l], ln1_b[l])
            hc2 = modulate(xc, sh2_c, sc2_c)
            xc = post_norm(DEEPNORM_ALPHA * xc + g2_c * expert_choice_ffn(hc2, w_router[l], w_ff_gate[l], w_ff_up[l], w_ff_down[l]),
                           ln2_g[l], ln2_b[l])
    return xl
```

```cpp
#include <hip/hip_runtime.h>
#include <cstdio>
#include <cstdint>

#define LAS __attribute__((address_space(3)))
typedef unsigned short bf16;
typedef short bf16x8 __attribute__((ext_vector_type(8)));
typedef float f32x4 __attribute__((ext_vector_type(4)));
typedef float f32x2 __attribute__((ext_vector_type(2)));
typedef unsigned v4u __attribute__((ext_vector_type(4)));
typedef unsigned v2u __attribute__((ext_vector_type(2)));

constexpr int D = 1024, BATCH = 16, SEQ = 2048, CTXL = 256, DEPTH = 4, BW = 256, NH = 4, HD = 64, NE = 16, FF = 1024;
constexpr int ML = BATCH * SEQ, MC = BATCH * CTXL, MT = ML + MC;
constexpr int IN_COLS = 3352;
constexpr int NZB = 2816, NZF = 768;
constexpr int NPB = 1280;
constexpr float LN_EPS = 1e-6f;
constexpr float ALPHA = 1.681792830507429f;
constexpr int CAP_L = 256, CAP_C = 32;
constexpr int NWAVES = 8, NTHREADS = 512;

constexpr size_t MiB = 1u << 20;
constexpr size_t WS_CTL = 0, CTL_ZERO_BYTES = 1 * MiB;
constexpr size_t WS_MOD = 1 * MiB;
constexpr size_t WS_LB = 3 * MiB;
constexpr size_t WS_DFT64 = 4 * MiB;
constexpr size_t WS_DFTC = 5 * MiB;
constexpr size_t WS_DFTL = 6 * MiB;
constexpr size_t WS_AFF = 22 * MiB;
constexpr size_t WS_SLOT = 25 * MiB;
constexpr size_t WS_ROWW = 28 * MiB;
constexpr size_t WS_WIN = 32 * MiB;
constexpr size_t WS_WG = 39 * MiB;
constexpr size_t WS_WBR = 47 * MiB;
constexpr size_t WS_WOUT = 49 * MiB;
constexpr size_t WS_WGU = 51 * MiB;
constexpr size_t WS_WDN = 115 * MiB;
constexpr size_t WS_X = 147 * MiB;
constexpr size_t WS_H = 291 * MiB;
constexpr size_t WS_R1 = 364 * MiB;
constexpr size_t WS_ZB = WS_R1;
constexpr size_t WS_ZF = WS_R1 + 198 * MiB;
constexpr size_t WS_PB = WS_R1 + 306 * MiB;
constexpr size_t WS_SO = WS_R1 + 396 * MiB;
constexpr size_t WS_VTL = WS_R1 + 504 * MiB;
constexpr size_t WS_VTC = WS_R1 + 536 * MiB;
constexpr size_t WS_FO = WS_R1 + 540 * MiB;
constexpr size_t WS_OUTS = WS_R1 + 612 * MiB;
constexpr size_t WS_P = WS_R1;
constexpr size_t WS_T = WS_R1 + 288 * MiB;
constexpr size_t WS_Y = WS_R1 + 360 * MiB;
constexpr size_t WS_XE = WS_R1;
constexpr size_t WS_HID = WS_R1 + 144 * MiB;
constexpr size_t WS_YE = WS_R1 + 288 * MiB;
constexpr size_t WS_END = WS_R1 + 684 * MiB;
constexpr int CW_BAR = 4096;

constexpr int RING_BYTES = 131072;
constexpr int LDSCTL_OFF = RING_BYTES, MISC_OFF = LDSCTL_OFF + 320;
constexpr int LDS_BYTES = 147456;

__device__ __forceinline__ float bf2f(unsigned b) { return __uint_as_float(b << 16); }
__device__ __forceinline__ unsigned f2bf(float f) { unsigned u = __float_as_uint(f); return (u + 0x7fffu + ((u >> 16) & 1u)) >> 16; }
__device__ __forceinline__ unsigned pk2(float lo, float hi) { return f2bf(lo) | (f2bf(hi) << 16); }
__device__ __forceinline__ unsigned cvt_pk_bf16(float lo, float hi) { unsigned r; asm volatile("v_cvt_pk_bf16_f32 %0, %1, %2" : "=v"(r) : "v"(lo), "v"(hi)); return r; }
__device__ __forceinline__ float wave_sum(float v) {
#pragma unroll
    for (int o = 1; o < 64; o <<= 1) v += __shfl_xor(v, o);
    return v;
}
__device__ __forceinline__ float sigmoid_fast(float x) { return __builtin_amdgcn_rcpf(1.0f + __expf(-x)); }
__device__ __forceinline__ float sigmoid_acc(float x) { return 1.0f / (1.0f + expf(-x)); }
__device__ __forceinline__ float silu_acc(float x) { return x / (1.0f + expf(-x)); }
__device__ __forceinline__ float softplus_acc(float x) { return x > 20.f ? x : log1pf(expf(x)); }
#define LDS_WAIT() asm volatile("s_waitcnt lgkmcnt(0)" ::: "memory")
#define VM_WAIT() asm volatile("s_waitcnt vmcnt(0)" ::: "memory")

namespace pg8 {
constexpr int BM = 256, BK = 64, HALF = 128, HTB = HALF * BK * 2, STAGE_BYTES = 8 * HTB, NXCD = 8, WGM = 8;
__host__ __device__ __forceinline__ int lds_byte(int r, int c) { const int st = (r >> 4) * 2 + (c >> 5), rr = r & 15, cc = c & 31, ob = rr * 64 + cc * 2; return st * 1024 + (ob ^ (((ob >> 9) & 1) << 5)); }
__host__ __device__ __forceinline__ void stage_rc(int b, int& R, int& C) { const int st = b / 1024, sb = b % 1024, swz = sb ^ (((sb >> 9) & 1) << 5); R = (st >> 1) * 16 + swz / 64; C = (st & 1) * 32 + (swz % 64) / 2; }
__host__ __device__ __forceinline__ int perm32(int rho) { const int n = rho >> 4, i = rho & 15; return 8 * (i >> 2) + 4 * n + (i & 3); }

struct Unit { int pm, pn; const char* A; const char* B; };
struct Gemm { int K, lda, ldb; };

template <class Map> struct Order {
    int nM, nN, nwg, G, c; Map map;
    __device__ __forceinline__ void init(int nM_, int nN_, int G_, int c_) { nM = nM_; nN = nN_; nwg = nM * nN; G = G_; c = c_; }
    __device__ __forceinline__ bool next(int i, Unit& u) const {
        const long L = (long)i * G + c; if (L >= nwg) return false;
        int wgid = (int)L; { const int q = nwg / NXCD, r = nwg % NXCD, xcd = wgid % NXCD, off = wgid / NXCD; wgid = (xcd < r ? xcd * (q + 1) : r * (q + 1) + (xcd - r) * q) + off; }
        const int nig = WGM * nN, gid = wgid / nig, fm = gid * WGM, gsz = (nM - fm) < WGM ? (nM - fm) : WGM;
        u.pm = fm + ((wgid % nig) % gsz); u.pn = (wgid % nig) / gsz; map(u); return true;
    }
    __device__ __forceinline__ void a_ready(const Unit&) const {}
    __device__ __forceinline__ void done(const Unit&) const {}
};

template <class Epi, class Sched, bool ALIGN_EPI = true, bool SP2 = true>
__device__ __forceinline__ void gemm_phase(LAS unsigned char* lds, const Gemm g, const Sched& S, const Epi& E) {
    int tid_ = threadIdx.x; asm volatile("" : "+v"(tid_));
    const int tid = tid_, wid = __builtin_amdgcn_readfirstlane(tid >> 6), lane = tid & 63, wr = wid >> 2, wc = wid & 3, fr = lane & 15, fq = lane >> 4;
    const int K = g.K, nt = K / BK;
    unsigned voffA[2], voffB[2];
#pragma unroll
    for (int i = 0; i < 2; ++i) { int R, C; stage_rc(tid * 16 + i * 8192, R, C); const int Rb = Epi::PERM ? ((R & ~31) + perm32(R & 31)) : R;
        voffA[i] = (unsigned)(R * g.lda + C) * 2u; voffB[i] = (unsigned)(Rb * g.ldb + C) * 2u; }
    const size_t kstep = (size_t)(BK * 2);
    const size_t hstepA = (size_t)HALF * g.lda * 2, hstepB = (size_t)HALF * g.ldb * 2;
    const unsigned ldsw = (unsigned)wid * 1024u;
    const int aoff = lds_byte(wr * 64 + fr, fq * 8), boff = lds_byte(wc * 32 + fr, fq * 8);
#define PG8_SA(b, h) (((b) * 2 + (h)) * HTB)
#define PG8_SB(b, h) ((4 + (b) * 2 + (h)) * HTB)
#define PG8_STAGE(bufoff, gbase, voff) do { _Pragma("unroll") for (int _i = 0; _i < 2; ++_i) \
        __builtin_amdgcn_global_load_lds((const unsigned*)((const char*)(gbase) + (voff)[_i]), (LAS unsigned*)(lds + (bufoff) + ldsw + _i * 8192), 16, 0, 0); } while (0)
#define PG8_LDA(dst, b, h) do { _Pragma("unroll") for (int m = 0; m < 4; ++m) _Pragma("unroll") for (int k = 0; k < 2; ++k) dst[m][k] = *(const LAS bf16x8*)(lds + PG8_SA(b, h) + aoff + m * 2048 + k * 1024); } while (0)
#define PG8_LDB(dst, b, h) do { _Pragma("unroll") for (int n = 0; n < 2; ++n) _Pragma("unroll") for (int k = 0; k < 2; ++k) dst[n][k] = *(const LAS bf16x8*)(lds + PG8_SB(b, h) + boff + n * 2048 + k * 1024); } while (0)
#define PG8_MMA(ai, bj, At, Bt) do { __builtin_amdgcn_s_setprio(1); _Pragma("unroll") for (int m = 0; m < 4; ++m) _Pragma("unroll") for (int n = 0; n < 2; ++n) _Pragma("unroll") for (int k = 0; k < 2; ++k) \
        acc[ai][bj][m][n] = __builtin_amdgcn_mfma_f32_16x16x32_bf16(Bt[n][k], At[m][k], acc[ai][bj][m][n], 0, 0, 0); __builtin_amdgcn_s_setprio(0); } while (0)
#define PG8_WAIT_V(n) asm volatile("s_waitcnt vmcnt(" #n ")" ::: "memory")
#define PG8_WAIT_L(n) asm volatile("s_waitcnt lgkmcnt(" #n ")" ::: "memory")
#define PG8_BAR __builtin_amdgcn_s_barrier()
#define PG8_SCHED __builtin_amdgcn_sched_barrier(0)
    Unit cur, nxt; int ui = 0;
    if (!S.next(0, cur)) return;
    f32x4 acc[2][2][4][2];
#pragma unroll
    for (int a = 0; a < 2; ++a)
#pragma unroll
        for (int b = 0; b < 2; ++b)
#pragma unroll
            for (int m = 0; m < 4; ++m)
#pragma unroll
                for (int n = 0; n < 2; ++n) acc[a][b][m][n] = (f32x4){0.f, 0.f, 0.f, 0.f};
    bf16x8 At[4][2], B0[2][2], B1[2][2];
    const char* cA = cur.A; const char* cB = cur.B;
    S.a_ready(cur);
    if constexpr (SP2) {
        PG8_STAGE(PG8_SB(0, 0), cB, voffB); PG8_STAGE(PG8_SB(0, 1), cB + hstepB, voffB); PG8_STAGE(PG8_SA(0, 0), cA, voffA); PG8_STAGE(PG8_SA(0, 1), cA + hstepA, voffA);
        if (wr == 1) PG8_BAR;
        PG8_WAIT_V(2); PG8_BAR;
        PG8_STAGE(PG8_SB(1, 0), cB + kstep, voffB); PG8_STAGE(PG8_SA(1, 0), cA + kstep, voffA); PG8_STAGE(PG8_SB(1, 1), cB + hstepB + kstep, voffB);
        PG8_WAIT_V(6); PG8_BAR;
    } else {
        PG8_STAGE(PG8_SB(0, 0), cB, voffB); PG8_STAGE(PG8_SA(0, 0), cA, voffA); PG8_STAGE(PG8_SB(0, 1), cB + hstepB, voffB); PG8_STAGE(PG8_SA(0, 1), cA + hstepA, voffA);
        if (wr == 1) PG8_BAR;
        PG8_WAIT_V(4); PG8_BAR;
        PG8_STAGE(PG8_SB(1, 0), cB + kstep, voffB); PG8_STAGE(PG8_SA(1, 0), cA + kstep, voffA); PG8_STAGE(PG8_SB(1, 1), cB + hstepB + kstep, voffB);
        PG8_WAIT_V(6); PG8_BAR;
    }
    for (;;) {
        const bool has_next = S.next(ui + 1, nxt);
        const char* nA = has_next ? nxt.A : cA; const char* nB = has_next ? nxt.B : cB;
#pragma unroll 1
        for (int t = 0; t < nt; t += 2) {
            const bool last = (t == nt - 2);
            const char* a1 = cA + (size_t)(t + 1) * kstep;
            const char* a2 = last ? nA : cA + (size_t)(t + 2) * kstep; const char* b2 = last ? nB : cB + (size_t)(t + 2) * kstep;
            const char* a3 = a2 + kstep; const char* b3 = b2 + kstep;
            if (last && has_next) S.a_ready(nxt);
            if constexpr (SP2) {
            PG8_LDB(B0, 0, 0); PG8_LDB(B1, 0, 1); PG8_SCHED; PG8_LDA(At, 0, 0); PG8_STAGE(PG8_SA(1, 1), a1 + hstepA, voffA);
            PG8_WAIT_V(8); PG8_WAIT_L(0); PG8_BAR; PG8_MMA(0, 0, At, B0); PG8_MMA(0, 1, At, B1); PG8_BAR; PG8_SCHED;
            PG8_LDA(At, 0, 1); PG8_STAGE(PG8_SB(0, 0), b2, voffB); PG8_STAGE(PG8_SB(0, 1), b2 + hstepB, voffB); PG8_STAGE(PG8_SA(0, 0), a2, voffA);
            PG8_WAIT_V(8); PG8_WAIT_L(0); PG8_BAR; PG8_MMA(1, 0, At, B0); PG8_MMA(1, 1, At, B1); PG8_BAR; PG8_SCHED;
            PG8_LDB(B0, 1, 0); PG8_LDB(B1, 1, 1); PG8_SCHED; PG8_LDA(At, 1, 0); PG8_STAGE(PG8_SA(0, 1), a2 + hstepA, voffA);
            PG8_WAIT_V(8); PG8_WAIT_L(0); PG8_BAR; PG8_MMA(0, 0, At, B0); PG8_MMA(0, 1, At, B1); PG8_BAR; PG8_SCHED;
            PG8_LDA(At, 1, 1); PG8_STAGE(PG8_SB(1, 0), b3, voffB); PG8_STAGE(PG8_SB(1, 1), b3 + hstepB, voffB); PG8_STAGE(PG8_SA(1, 0), a3, voffA);
            PG8_WAIT_V(8); PG8_WAIT_L(0); PG8_BAR; PG8_MMA(1, 0, At, B0); PG8_MMA(1, 1, At, B1); PG8_BAR; PG8_SCHED;
            } else {
            PG8_LDB(B0, 0, 0); PG8_SCHED; PG8_LDA(At, 0, 0); PG8_STAGE(PG8_SA(1, 1), a1 + hstepA, voffA);
            PG8_WAIT_L(8); PG8_BAR; PG8_WAIT_L(0); PG8_MMA(0, 0, At, B0); PG8_BAR; PG8_SCHED;
            PG8_LDB(B1, 0, 1); PG8_STAGE(PG8_SB(0, 0), b2, voffB);
            PG8_BAR; PG8_WAIT_L(0); PG8_MMA(0, 1, At, B1); PG8_BAR;
            PG8_LDA(At, 0, 1); PG8_STAGE(PG8_SA(0, 0), a2, voffA);
            PG8_BAR; PG8_WAIT_L(0); PG8_MMA(1, 0, At, B0); PG8_BAR; PG8_SCHED;
            PG8_STAGE(PG8_SB(0, 1), b2 + hstepB, voffB);
            PG8_WAIT_V(6); PG8_BAR; PG8_MMA(1, 1, At, B1); PG8_BAR;
            PG8_LDB(B0, 1, 0); PG8_SCHED; PG8_LDA(At, 1, 0); PG8_STAGE(PG8_SA(0, 1), a2 + hstepA, voffA);
            PG8_WAIT_L(8); PG8_BAR; PG8_WAIT_L(0); PG8_MMA(0, 0, At, B0); PG8_BAR; PG8_SCHED;
            PG8_LDB(B1, 1, 1); PG8_STAGE(PG8_SB(1, 0), b3, voffB);
            PG8_BAR; PG8_WAIT_L(0); PG8_MMA(0, 1, At, B1); PG8_BAR;
            PG8_LDA(At, 1, 1); PG8_STAGE(PG8_SA(1, 0), a3, voffA);
            PG8_BAR; PG8_WAIT_L(0); PG8_MMA(1, 0, At, B0); PG8_BAR; PG8_SCHED;
            PG8_STAGE(PG8_SB(1, 1), b3 + hstepB, voffB);
            PG8_WAIT_V(6); PG8_BAR; PG8_MMA(1, 1, At, B1); PG8_BAR;
            }
        }
        if constexpr (ALIGN_EPI) { if (wr == 0) PG8_BAR; }
        E(acc, cur, wr, wc, fr, fq); S.done(cur);
        if (!has_next) break;
#pragma unroll
        for (int a = 0; a < 2; ++a)
#pragma unroll
            for (int b = 0; b < 2; ++b)
#pragma unroll
                for (int m = 0; m < 4; ++m)
#pragma unroll
                    for (int n = 0; n < 2; ++n) acc[a][b][m][n] = (f32x4){0.f, 0.f, 0.f, 0.f};
        cur = nxt; cA = nA; cB = nB; ++ui;
        if constexpr (ALIGN_EPI) { if (wr == 1) PG8_BAR; }
    }
    PG8_WAIT_V(0);
    if constexpr (!ALIGN_EPI) { if (wr == 0) PG8_BAR; }
    PG8_BAR;
#undef PG8_SA
#undef PG8_SB
#undef PG8_STAGE
#undef PG8_LDA
#undef PG8_LDB
#undef PG8_MMA
#undef PG8_WAIT_V
#undef PG8_WAIT_L
#undef PG8_BAR
#undef PG8_SCHED
}
}
using pg8::Unit;

#define XB_TMO      128
#define XB_XCNT(j)  (256  + 64 * (j))
#define XB_XSUB(j)  (1280 + 64 * (j))
#define XB_XGEN(j)  (2304 + 64 * (j))
#define XB_TOP      3328
#define XB_TOPGEN   3392
#define XCD_BAR_WORDS 3456
#define XB_SPIN_CAP (1u << 18)

__device__ __forceinline__ unsigned xb_ld(unsigned* p)              { return __hip_atomic_load(p, __ATOMIC_RELAXED, __HIP_MEMORY_SCOPE_AGENT); }
__device__ __forceinline__ unsigned xb_add(unsigned* p, unsigned v) { return __hip_atomic_fetch_add(p, v, __ATOMIC_RELAXED, __HIP_MEMORY_SCOPE_AGENT); }
__device__ __forceinline__ unsigned xb_xcc_id() { return (unsigned)__builtin_amdgcn_s_getreg((3 << 11) | 20) & 0xFu; }
#define XB_SPIN(cond, bar) do { unsigned _sp = 0; while (cond) { __builtin_amdgcn_s_sleep(1); \
    if ((++_sp & 255u) == 0u) { if (xb_ld(&(bar)[XB_TMO])) break; if (_sp > XB_SPIN_CAP) { atomicAdd(&(bar)[XB_TMO], 1u); break; } } } } while (0)

struct XcdBarrier {
    unsigned* bar; unsigned x;
    volatile LAS unsigned* st;
};

__device__ __forceinline__ XcdBarrier xcd_barrier_post(unsigned* bar, volatile LAS unsigned* st) {
    XcdBarrier b; b.bar = bar; b.x = xb_xcc_id(); b.st = st;
    if (threadIdx.x == 0) (void)xb_add(&bar[XB_XCNT(b.x)], 1u);
    return b;
}
__device__ __forceinline__ void xcd_barrier_complete(unsigned* bar, unsigned x, unsigned& nloc, unsigned& nx) {
    const unsigned G = gridDim.x * gridDim.y * gridDim.z;
    unsigned sum, cnt, mine, sp = 0u;
    for (;;) {
        sum = 0u; cnt = 0u; mine = 0u;
#pragma unroll
        for (unsigned j = 0; j < 16; ++j) { const unsigned c = xb_ld(&bar[XB_XCNT(j)]); sum += c; cnt += (c > 0u) ? 1u : 0u; mine = (j == x) ? c : mine; }
        if (sum == G) break;
        __builtin_amdgcn_s_sleep(1);
        if ((++sp & 255u) == 0u) { if (xb_ld(&bar[XB_TMO])) break; if (sp > XB_SPIN_CAP) { atomicAdd(&bar[XB_TMO], 1u); break; } }
    }
    nloc = mine > 0u ? mine : 1u; nx = cnt > 0u ? cnt : 1u;
}

__device__ __forceinline__ void xcd_barrier(const XcdBarrier& b) {
    asm volatile("s_waitcnt vmcnt(0)" ::: "memory");
    __syncthreads();
    if (threadIdx.x == 0) {
        unsigned* bar = b.bar;
        __builtin_amdgcn_s_waitcnt(0);
        unsigned nloc = b.st[0], nx = b.st[1];
        if (nloc == 0u) { xcd_barrier_complete(bar, b.x, nloc, nx); b.st[0] = nloc; b.st[1] = nx; }
        const unsigned old = xb_add(&bar[XB_XSUB(b.x)], 1u);
        const unsigned gen = old / nloc;
        if (old + 1u == (gen + 1u) * nloc) {
            __builtin_amdgcn_fence(__ATOMIC_RELEASE, "agent");
            asm volatile("s_waitcnt vmcnt(0)" ::: "memory");
            const unsigned og = xb_add(&bar[XB_TOP], 1u);
            const unsigned tg = og / nx;
            if (og + 1u == (tg + 1u) * nx) xb_add(&bar[XB_TOPGEN], 1u);
            else XB_SPIN(xb_ld(&bar[XB_TOPGEN]) == tg, bar);
            __builtin_amdgcn_fence(__ATOMIC_ACQUIRE, "agent");
            xb_add(&bar[XB_XGEN(b.x)], 1u);
            asm volatile("s_waitcnt vmcnt(0)" ::: "memory");
        } else {
            XB_SPIN(xb_ld(&bar[XB_XGEN(b.x)]) == gen, bar);
            __builtin_amdgcn_fence(__ATOMIC_ACQUIRE, "agent");
            asm volatile("s_waitcnt vmcnt(0)" ::: "memory");
        }
    }
    __syncthreads();
}

#define EPI_SIG const f32x4 (&acc)[2][2][4][2], const Unit& u, int wr, int wc, int fr, int fq
struct EpiZ { static constexpr bool PERM = true; bf16* ZB; float* ZF;
    __device__ __forceinline__ void operator()(EPI_SIG) const {
        const int row0 = u.pm * 256 + wr * 64 + fr;
        if (u.pn < 11) {
            const int col0 = u.pn * 256 + wc * 32 + 8 * fq;
#pragma unroll
            for (int ai = 0; ai < 2; ++ai)
#pragma unroll
                for (int m = 0; m < 4; ++m) { bf16* rowp = ZB + (size_t)(row0 + ai * 128 + m * 16) * NZB + col0;
#pragma unroll
                    for (int bj = 0; bj < 2; ++bj) { const f32x4 v0 = acc[ai][bj][m][0], v1 = acc[ai][bj][m][1]; v4u w; w.x = cvt_pk_bf16(v0[0], v0[1]); w.y = cvt_pk_bf16(v0[2], v0[3]); w.z = cvt_pk_bf16(v1[0], v1[1]); w.w = cvt_pk_bf16(v1[2], v1[3]);
                        *(v4u*)(rowp + bj * 128) = w; } }
        } else {
            const int col0 = (u.pn - 11) * 256 + wc * 32 + 8 * fq;
#pragma unroll
            for (int ai = 0; ai < 2; ++ai)
#pragma unroll
                for (int m = 0; m < 4; ++m) { float* rowp = ZF + (size_t)(row0 + ai * 128 + m * 16) * NZF + col0;
#pragma unroll
                    for (int bj = 0; bj < 2; ++bj) { *(f32x4*)(rowp + bj * 128) = acc[ai][bj][m][0]; *(f32x4*)(rowp + bj * 128 + 4) = acc[ai][bj][m][1]; } }
        }
    }
};
struct EpiBf { static constexpr bool PERM = true; bf16* O; int ldc; const float* roww;
    __device__ __forceinline__ void operator()(EPI_SIG) const {
        const int row0 = u.pm * 256 + wr * 64 + fr, col0 = u.pn * 256 + wc * 32 + 8 * fq;
#pragma unroll
        for (int ai = 0; ai < 2; ++ai)
#pragma unroll
            for (int m = 0; m < 4; ++m) { const int row = row0 + ai * 128 + m * 16; const float s = roww ? roww[row] : 1.0f; bf16* rowp = O + (size_t)row * ldc + col0;
#pragma unroll
                for (int bj = 0; bj < 2; ++bj) { const f32x4 v0 = acc[ai][bj][m][0] * s, v1 = acc[ai][bj][m][1] * s; v4u w; w.x = cvt_pk_bf16(v0[0], v0[1]); w.y = cvt_pk_bf16(v0[2], v0[3]); w.z = cvt_pk_bf16(v1[0], v1[1]); w.w = cvt_pk_bf16(v1[2], v1[3]);
                    *(v4u*)(rowp + bj * 128) = w; } }
    }
};
struct EpiFour1 { static constexpr bool PERM = true; bf16* VTL; bf16* VTC;
    __device__ __forceinline__ void operator()(EPI_SIG) const {
        bf16* base; int ldc;
        if (u.pn < 128) { const int b = u.pn >> 3, t0 = (u.pn & 7) * 256; base = VTL + (size_t)b * 256 * 4096 + u.pm * 2048 + t0; ldc = 4096; }
        else { const int b = u.pn - 128; base = VTC + (size_t)b * 256 * 512 + u.pm * 256; ldc = 512; }
        const int r0 = wr * 64 + fr, col0 = wc * 32 + 8 * fq;
#pragma unroll
        for (int ai = 0; ai < 2; ++ai)
#pragma unroll
            for (int m = 0; m < 4; ++m) { bf16* rowp = base + (size_t)(r0 + ai * 128 + m * 16) * ldc + col0;
#pragma unroll
                for (int bj = 0; bj < 2; ++bj) { const f32x4 v0 = acc[ai][bj][m][0], v1 = acc[ai][bj][m][1]; v4u w; w.x = cvt_pk_bf16(v0[0], v0[1]); w.y = cvt_pk_bf16(v0[2], v0[3]); w.z = cvt_pk_bf16(v1[0], v1[1]); w.w = cvt_pk_bf16(v1[2], v1[3]);
                    *(v4u*)(rowp + bj * 128) = w; } }
    }
};
struct EpiF32 { static constexpr bool PERM = false; float* C; int ldc;
    __device__ __forceinline__ void operator()(EPI_SIG) const {
        const int row0 = u.pm * 256 + wr * 64 + fr, col0 = u.pn * 256 + wc * 32 + 4 * fq;
#pragma unroll
        for (int ai = 0; ai < 2; ++ai)
#pragma unroll
            for (int m = 0; m < 4; ++m) { float* rowp = C + (size_t)(row0 + ai * 128 + m * 16) * ldc + col0;
#pragma unroll
                for (int bj = 0; bj < 2; ++bj)
#pragma unroll
                    for (int n = 0; n < 2; ++n) *(f32x4*)(rowp + bj * 128 + n * 16) = acc[ai][bj][m][n]; }
    }
};
struct EpiFourT { static constexpr bool PERM = false; float* FO; int ctx;
    __device__ __forceinline__ void operator()(EPI_SIG) const {
        float* base = ctx ? FO + (size_t)(ML + u.pn * 256) * 256 : FO + (size_t)(u.pn & 1) * MT * 256 + (size_t)((u.pn >> 1) * 2048 + u.pm * 256) * 256;
        const int r0 = wr * 64 + fr, col0 = wc * 32 + 4 * fq;
#pragma unroll
        for (int ai = 0; ai < 2; ++ai)
#pragma unroll
            for (int m = 0; m < 4; ++m) { float* rowp = base + (size_t)(r0 + ai * 128 + m * 16) * 256 + col0;
#pragma unroll
                for (int bj = 0; bj < 2; ++bj)
#pragma unroll
                    for (int n = 0; n < 2; ++n) *(f32x4*)(rowp + bj * 128 + n * 16) = acc[ai][bj][m][n]; }
    }
};
struct EpiMerge { static constexpr bool PERM = false; const bf16* P; bf16* T; const float* bg;
    __device__ __forceinline__ void operator()(EPI_SIG) const {
        const int row0 = u.pm * 256 + wr * 64 + fr, oc = u.pn * 64 + wc * 16 + 4 * fq;
        f32x4 bv[4];
#pragma unroll
        for (int g = 0; g < 4; ++g) bv[g] = *(const f32x4*)(bg + g * 1024 + oc);
#pragma unroll
        for (int ai = 0; ai < 2; ++ai)
#pragma unroll
            for (int m = 0; m < 4; ++m) { const int row = row0 + ai * 128 + m * 16; const bf16* prow = P + (size_t)row * 4096 + oc;
                v2u pw[4];
#pragma unroll
                for (int g = 0; g < 4; ++g) pw[g] = *(const v2u*)(prow + g * 1024);
                f32x4 t = (f32x4){0.f, 0.f, 0.f, 0.f};
#pragma unroll
                for (int bj = 0; bj < 2; ++bj)
#pragma unroll
                    for (int n = 0; n < 2; ++n) { const int g = 2 * bj + n; const f32x4 a = acc[ai][bj][m][n] + bv[g];
                        t[0] += sigmoid_fast(a[0]) * bf2f(pw[g].x & 0xffffu); t[1] += sigmoid_fast(a[1]) * bf2f(pw[g].x >> 16);
                        t[2] += sigmoid_fast(a[2]) * bf2f(pw[g].y & 0xffffu); t[3] += sigmoid_fast(a[3]) * bf2f(pw[g].y >> 16); }
                v2u w; w.x = cvt_pk_bf16(t[0], t[1]); w.y = cvt_pk_bf16(t[2], t[3]);
                *(v2u*)(T + (size_t)row * 1024 + oc) = w; }
    }
};
struct EpiSwiGLU { static constexpr bool PERM = true; bf16* HID;
    __device__ __forceinline__ void operator()(EPI_SIG) const {
        const int row0 = u.pm * 256 + wr * 64 + fr, col0 = u.pn * 128 + wc * 32 + 8 * fq;
#pragma unroll
        for (int ai = 0; ai < 2; ++ai)
#pragma unroll
            for (int m = 0; m < 4; ++m) { bf16* rowp = HID + (size_t)(row0 + ai * 128 + m * 16) * 1024 + col0; float o[8];
#pragma unroll
                for (int n = 0; n < 2; ++n)
#pragma unroll
                    for (int j = 0; j < 4; ++j) { const float gv = acc[ai][0][m][n][j], uv = acc[ai][1][m][n][j]; o[4 * n + j] = gv * sigmoid_fast(gv) * uv; }
                v4u w; w.x = cvt_pk_bf16(o[0], o[1]); w.y = cvt_pk_bf16(o[2], o[3]); w.z = cvt_pk_bf16(o[4], o[5]); w.w = cvt_pk_bf16(o[6], o[7]);
                *(v4u*)rowp = w; }
    }
};
struct MapPlain { const char* A; const char* B; size_t sa, sb; __device__ __forceinline__ void operator()(Unit& u) const { u.A = A + (size_t)u.pm * sa; u.B = B + (size_t)u.pn * sb; } };
struct MapP { const char* OUTS; const char* WBR; __device__ __forceinline__ void operator()(Unit& u) const { const int g = u.pn >> 2; u.A = OUTS + (size_t)u.pm * (256 * 1024 * 2) + g * 512; u.B = WBR + (size_t)g * (1024 * 256 * 2) + (size_t)(u.pn & 3) * (256 * 256 * 2); } };
struct MapFourT { const char* DFTL; const char* VTL; __device__ __forceinline__ void operator()(Unit& u) const { const int kh = u.pn & 1; u.A = DFTL + (size_t)u.pm * (256 * 4096 * 2) + kh * 4096; u.B = VTL + (size_t)(u.pn >> 1) * (256 * 4096 * 2) + kh * 4096; } };
struct MapMoE { const char* A; const char* W; size_t se; __device__ __forceinline__ void operator()(Unit& u) const { const int e = u.pm < 256 ? (u.pm >> 4) : ((u.pm - 256) >> 1); u.A = A + (size_t)u.pm * (256 * 1024 * 2); u.B = W + (size_t)e * se + (size_t)u.pn * (256 * 1024 * 2); } };
struct Args { const float* in[31]; float* out; unsigned char* ws; int ph_lo, ph_hi, li, pad; };
enum { I_X = 0, I_C, I_CTX, I_CCTX, I_ADAW, I_ADAB, I_WIN, I_LBLOG, I_HGRN_NW, I_GDN_CW, I_GDN_ALOG, I_GDN_DTB, I_GDN_NW, I_SSD_CW, I_SSD_CB, I_SSD_ALOG, I_SSD_DTB, I_SSD_D, I_SSD_NW,
       I_WGATE, I_BGATE, I_WBR, I_WOUT, I_LN1G, I_LN1B, I_WROUTER, I_WFFG, I_WFFU, I_WFFD, I_LN2G, I_LN2B };
struct WCtx { int tid, lane, wave, bid, G, gw, NGW; };

__device__ __forceinline__ int zrow(int n) {
    if (n < 256) return n;
    if (n < 512) return 11 * 256 + (n - 256);
    if (n < 768) return 12 * 256 + (n - 512);
    if (n < 1024) return 1 * 256 + (n - 768);
    if (n < 1280) return 2 * 256 + (n - 1024);
    if (n < 2048) return 3 * 256 + (n - 1280);
    if (n < 2304) return 6 * 256 + (n - 2048);
    if (n < 2312) return 13 * 256 + (n - 2304);
    if (n < 2320) return 13 * 256 + 8 + (n - 2312);
    if (n < 2576) return 7 * 256 + (n - 2320);
    if (n < 3088) return 8 * 256 + (n - 2576);
    if (n < 3344) return 10 * 256 + (n - 3088);
    return 13 * 256 + 16 + (n - 3344);
}
__device__ __forceinline__ int rowmap(int mode, int aux, int n) {
    if (mode == 0) return n;
    if (mode == 1) return zrow(n);
    if (mode == 2) return 256 * (n >> 6) + 128 * (aux >> 1) + 32 * ((n & 63) >> 4) + 16 * (aux & 1) + (n & 15);
    if (mode == 3) return 256 * (n >> 7) + (n & 127);
    return 256 * (n >> 7) + 128 + (n & 127);
}
__device__ __forceinline__ void transpose_item(const float* W, int N, bf16* WT, int ldt, LAS float* scr, int item, int lane, int mode, int aux) {
    const int nblk = (N + 31) >> 5, kb = item / nblk, nb = item - kb * nblk, k0 = 64 * kb, n0 = 32 * nb;
    const int ncol = n0 + (lane & 31);
#pragma unroll 8
    for (int i = 0; i < 32; ++i) { const int kk = 2 * i + (lane >> 5); scr[kk * 33 + (lane & 31)] = ncol < N ? W[(size_t)(k0 + kk) * N + ncol] : 0.f; }
    LDS_WAIT();
    const int c = lane & 7;
#pragma unroll
    for (int j = 0; j < 4; ++j) { const int nn = (lane >> 3) + 8 * j, n = n0 + nn; const LAS float* s = scr + (8 * c) * 33 + nn;
        v4u o; o.x = pk2(s[0 * 33], s[1 * 33]); o.y = pk2(s[2 * 33], s[3 * 33]); o.z = pk2(s[4 * 33], s[5 * 33]); o.w = pk2(s[6 * 33], s[7 * 33]);
        if (n < N) *(v4u*)(WT + (size_t)rowmap(mode, aux, n) * ldt + k0 + 8 * c) = o; }
    LDS_WAIT();
}
constexpr int WI_IN = 16 * 105, WI_G = 4 * 512, WI_BR = 4 * 128, WI_OUT = 512, WI_FF = 16 * 512;
constexpr int WI_TOTAL = WI_IN + WI_G + WI_BR + WI_OUT + 3 * WI_FF;
__device__ __forceinline__ void convert_weights(const Args& a, LAS unsigned char* lds, const WCtx& w, int l) {
    LAS float* scr = (LAS float*)(lds + w.wave * 16384);
    unsigned char* ws = a.ws;
    for (int it = w.gw; it < WI_TOTAL; it += w.NGW) {
        int r = it;
        if (r < WI_IN) { transpose_item(a.in[I_WIN] + (size_t)l * 1024 * IN_COLS, IN_COLS, (bf16*)(ws + WS_WIN), 1024, scr, r, w.lane, 1, 0); continue; } r -= WI_IN;
        if (r < WI_G) { const int g = r >> 9; transpose_item(a.in[I_WGATE] + (size_t)(l * 4 + g) * 1024 * 1024, 1024, (bf16*)(ws + WS_WG), 1024, scr, r & 511, w.lane, 2, g); continue; } r -= WI_G;
        if (r < WI_BR) { const int g = r >> 7; transpose_item(a.in[I_WBR] + (size_t)(l * 4 + g) * 256 * 1024, 1024, (bf16*)(ws + WS_WBR) + (size_t)g * 1024 * 256, 256, scr, r & 127, w.lane, 0, 0); continue; } r -= WI_BR;
        if (r < WI_OUT) { transpose_item(a.in[I_WOUT] + (size_t)l * 1024 * 1024, 1024, (bf16*)(ws + WS_WOUT), 1024, scr, r, w.lane, 0, 0); continue; } r -= WI_OUT;
        if (r < WI_FF) { const int e = r >> 9; transpose_item(a.in[I_WFFG] + (size_t)(l * 16 + e) * 1024 * 1024, 1024, (bf16*)(ws + WS_WGU) + (size_t)e * 2048 * 1024, 1024, scr, r & 511, w.lane, 3, 0); continue; } r -= WI_FF;
        if (r < WI_FF) { const int e = r >> 9; transpose_item(a.in[I_WFFU] + (size_t)(l * 16 + e) * 1024 * 1024, 1024, (bf16*)(ws + WS_WGU) + (size_t)e * 2048 * 1024, 1024, scr, r & 511, w.lane, 4, 0); continue; } r -= WI_FF;
        { const int e = r >> 9; transpose_item(a.in[I_WFFD] + (size_t)(l * 16 + e) * 1024 * 1024, 1024, (bf16*)(ws + WS_WDN) + (size_t)e * 1024 * 1024, 1024, scr, r & 511, w.lane, 0, 0); }
    }
}

__device__ __forceinline__ void row_load(const float* p, int lane, f32x4 (&v)[4]) { const f32x4* xr = (const f32x4*)p + lane;
#pragma unroll
    for (int j = 0; j < 4; ++j) v[j] = xr[64 * j]; }
__device__ __forceinline__ void row_store(float* p, int lane, const f32x4 (&v)[4]) { f32x4* xr = (f32x4*)p + lane;
#pragma unroll
    for (int j = 0; j < 4; ++j) xr[64 * j] = v[j]; }
__device__ __forceinline__ void ln_stats(const f32x4 (&v)[4], float& mean, float& rstd) {
    float s = 0.f;
#pragma unroll
    for (int j = 0; j < 4; ++j) s += (v[j][0] + v[j][1]) + (v[j][2] + v[j][3]);
    mean = wave_sum(s) * (1.f / 1024.f); float q = 0.f;
#pragma unroll
    for (int j = 0; j < 4; ++j) { const f32x4 d = v[j] - mean; q += (d[0] * d[0] + d[1] * d[1]) + (d[2] * d[2] + d[3] * d[3]); }
    rstd = 1.0f / sqrtf(wave_sum(q) * (1.f / 1024.f) + LN_EPS);
}
__device__ __forceinline__ void modulate_row(const f32x4 (&v)[4], const float* sh, const float* sc, bf16* hrow, int lane, f32x4 (&hv)[4]) {
    float mean, rstd; ln_stats(v, mean, rstd);
#pragma unroll
    for (int j = 0; j < 4; ++j) { const f32x4 s = *((const f32x4*)sc + lane + 64 * j), t = *((const f32x4*)sh + lane + 64 * j);
        hv[j] = (v[j] - mean) * rstd * (s + 1.0f) + t;
        v2u w; w.x = cvt_pk_bf16(hv[j][0], hv[j][1]); w.y = cvt_pk_bf16(hv[j][2], hv[j][3]); *((v2u*)hrow + lane + 64 * j) = w; }
}
__device__ __forceinline__ const float* mod_ptr(const Args& a, int l, int row, int chunk) { const int r = row < ML ? (row >> 11) : 16; return (const float*)(a.ws + WS_MOD) + ((size_t)(l * 17 + r) * 6144 + chunk * 1024); }

__device__ __forceinline__ void phase_prologue(const Args& a, LAS unsigned char* lds, const WCtx& w) {
    {
        LAS float* SC = (LAS float*)lds; LAS float* RED = (LAS float*)(lds + 17 * 1024 * 4);
        for (int i = w.tid; i < 17 * 1024; i += NTHREADS) { const int r = i >> 10, k = i & 1023; const float v = r < 16 ? a.in[I_C][r * 1024 + k] : a.in[I_CCTX][k]; SC[i] = silu_acc(v); }
        __syncthreads();
        float* MOD = (float*)(a.ws + WS_MOD);
        for (int it = w.bid; it < 4 * 96; it += w.G) {
            const int l = it / 96, cg = it - l * 96;
            const float* wp = a.in[I_ADAW] + (size_t)l * 1024 * 6144 + cg * 64 + w.lane;
            float acc[17];
#pragma unroll
            for (int r = 0; r < 17; ++r) acc[r] = 0.f;
            const int k0 = w.wave * 128;
            for (int k = k0; k < k0 + 128; k += 4) {
                const float w0 = wp[(size_t)k * 6144], w1 = wp[(size_t)(k + 1) * 6144], w2 = wp[(size_t)(k + 2) * 6144], w3 = wp[(size_t)(k + 3) * 6144];
#pragma unroll
                for (int r = 0; r < 17; ++r) { const f32x4 s = *(const LAS f32x4*)(SC + r * 1024 + k); acc[r] += (s[0] * w0 + s[1] * w1) + (s[2] * w2 + s[3] * w3); }
            }
#pragma unroll
            for (int r = 0; r < 17; ++r) RED[(w.wave * 17 + r) * 64 + w.lane] = acc[r];
            __syncthreads();
            for (int i = w.tid; i < 17 * 64; i += NTHREADS) { const int r = i >> 6, col = i & 63; float s = 0.f;
#pragma unroll
                for (int q = 0; q < 8; ++q) s += RED[(q * 17 + r) * 64 + col];
                MOD[(size_t)(l * 17 + r) * 6144 + cg * 64 + col] = s + a.in[I_ADAB][l * 6144 + cg * 64 + col]; }
            __syncthreads();
        }
    }
    {
        float* X = (float*)(a.ws + WS_X);
        float om[4];
#pragma unroll
        for (int e = 0; e < 4; ++e) om[e] = 1.0f / powf(10000.0f, (float)(4 * w.lane + e) * (1.0f / 256.0f));
        for (int row = w.gw; row < MT; row += w.NGW) {
            f32x4 v[4];
            if (row < ML) { row_load(a.in[I_X] + (size_t)row * 1024, w.lane, v); const int t = row & 2047; const float pr = (float)(t >> 6), pc = (float)(t & 63);
#pragma unroll
                for (int e = 0; e < 4; ++e) { v[0][e] += sinf(pr * om[e]); v[1][e] += cosf(pr * om[e]); v[2][e] += sinf(pc * om[e]); v[3][e] += cosf(pc * om[e]); } }
            else row_load(a.in[I_CTX] + (size_t)(row - ML) * 1024, w.lane, v);
            row_store(X + (size_t)row * 1024, w.lane, v);
        }
    }
    {
        bf16* DL = (bf16*)(a.ws + WS_DFTL); const float scl = 1.0f / sqrtf(2048.0f * 64.0f);
        for (int i = w.bid * NTHREADS + w.tid; i < 2048 * 256; i += w.G * NTHREADS) { const int kt = i >> 8, t8 = (i & 255) * 8; float cs[8], sn[8];
#pragma unroll
            for (int q = 0; q < 8; ++q) { const int m = (kt * (t8 + q)) & 2047; sincospif((float)m * (1.0f / 1024.0f), &sn[q], &cs[q]); cs[q] *= scl; sn[q] *= scl; }
            v4u wc, wsn; wc.x = pk2(cs[0], cs[1]); wc.y = pk2(cs[2], cs[3]); wc.z = pk2(cs[4], cs[5]); wc.w = pk2(cs[6], cs[7]);
            wsn.x = pk2(sn[0], sn[1]); wsn.y = pk2(sn[2], sn[3]); wsn.z = pk2(sn[4], sn[5]); wsn.w = pk2(sn[6], sn[7]);
            *(v4u*)(DL + (size_t)kt * 4096 + t8) = wc; *(v4u*)(DL + (size_t)kt * 4096 + 2048 + t8) = wsn; }
        bf16* DC = (bf16*)(a.ws + WS_DFTC); const float scc = 1.0f / sqrtf(256.0f * 64.0f);
        for (int i = w.bid * NTHREADS + w.tid; i < 256 * 256; i += w.G * NTHREADS) { const int kt = i >> 8, t = i & 255; const int m = (kt * t) & 255; float s, c; sincospif((float)m * (1.0f / 128.0f), &s, &c);
            DC[kt * 512 + t] = (bf16)f2bf(c * scc); DC[kt * 512 + 256 + t] = (bf16)f2bf(s * scc); }
        bf16* D6 = (bf16*)(a.ws + WS_DFT64);
        for (int i = w.bid * NTHREADS + w.tid; i < 512 * 256; i += w.G * NTHREADS) { const int j = i >> 8, k = i & 255; const int g = (j & 255) >> 6, kc = j & 63; float val = 0.f;
            if ((k >> 6) == g) { const int m = (kc * (k & 63)) & 63; float s, c; sincospif((float)m * (1.0f / 32.0f), &s, &c); val = (j >> 8) ? -s : c; }
            D6[i] = (bf16)f2bf(val); }
        if (w.bid == 0) { float* LB = (float*)(a.ws + WS_LB); const int d = w.tid >> 8, ch = w.tid & 255; float lg[4], mx = -1e30f;
#pragma unroll
            for (int l = 0; l < 4; ++l) { lg[l] = a.in[I_LBLOG][(d * 4 + l) * 256 + ch]; mx = fmaxf(mx, lg[l]); }
            float s = 0.f;
#pragma unroll
            for (int l = 0; l < 4; ++l) { lg[l] = expf(lg[l] - mx); s += lg[l]; }
            float cum = 0.f;
#pragma unroll
            for (int l = 0; l < 4; ++l) { if (l > 0) cum += lg[l] / s; LB[(d * 4 + l) * 256 + ch] = cum; } }
    }
    __syncthreads();
    convert_weights(a, lds, w, 0);
}
__device__ __forceinline__ void phase_mod_rows(const Args& a, const WCtx& w, int l) {
    const float* X = (const float*)(a.ws + WS_X); bf16* H = (bf16*)(a.ws + WS_H);
    for (int row = w.gw; row < MT; row += w.NGW) { f32x4 v[4], hv[4]; row_load(X + (size_t)row * 1024, w.lane, v);
        modulate_row(v, mod_ptr(a, l, row, 0), mod_ptr(a, l, row, 1), H + (size_t)row * 1024, w.lane, hv); }
}

__device__ __forceinline__ void phase_prep(const Args& a, const WCtx& w, int l) {
    const bf16* ZB = (const bf16*)(a.ws + WS_ZB); bf16* PB = (bf16*)(a.ws + WS_PB);
    for (int it = w.gw; it < 576 * 20; it += w.NGW) {
        const int seg = it / 20, cb = it - seg * 20;
        int T, t0, rowbase;
        if (seg < 512) { const int b = seg >> 5; t0 = (seg & 31) * 64; T = 2048; rowbase = b * 2048; } else { const int s2 = seg - 512; const int b = s2 >> 2; t0 = (s2 & 3) * 64; T = 256; rowbase = ML + b * 256; }
        int zcol, pcol; float cw[5], bias = 0.f;
        if (cb < 12) { const int c = cb * 64 + w.lane; zcol = 768 + c; pcol = c;
#pragma unroll
            for (int k = 0; k < 5; ++k) cw[k] = a.in[I_GDN_CW][(size_t)(l * 5 + k) * 768 + c]; }
        else { const int c = (cb - 12) * 64 + w.lane; zcol = 2048 + c; pcol = 768 + c; bias = a.in[I_SSD_CB][l * 512 + c];
#pragma unroll
            for (int k = 0; k < 5; ++k) cw[k] = a.in[I_SSD_CW][(size_t)(l * 5 + k) * 512 + c]; }
        const bf16* zp = ZB + (size_t)rowbase * NZB + zcol;
        float zm2 = (t0 - 2 >= 0) ? bf2f(zp[(size_t)(t0 - 2) * NZB]) : 0.f, zm1 = (t0 - 1 >= 0) ? bf2f(zp[(size_t)(t0 - 1) * NZB]) : 0.f;
        float z0 = bf2f(zp[(size_t)t0 * NZB]), zp1 = bf2f(zp[(size_t)(t0 + 1) * NZB]);
        for (int i = 0; i < 64; ++i) { const int t = t0 + i; const float zp2 = (t + 2 < T) ? bf2f(zp[(size_t)(t + 2) * NZB]) : 0.f;
            float y = bias + cw[0] * zm2 + cw[1] * zm1 + cw[2] * z0 + cw[3] * zp1 + cw[4] * zp2;
            y = silu_acc(y);
            if (cb < 8) { const float ss = wave_sum(y * y); y *= 1.0f / sqrtf(ss + LN_EPS); if (cb < 4) y *= 0.125f; }
            PB[(size_t)(rowbase + t) * NPB + pcol] = (bf16)f2bf(y);
            zm2 = zm1; zm1 = z0; z0 = zp1; zp1 = zp2; }
    }
}

__device__ __forceinline__ float red4(float x) { x += __shfl_xor(x, 1); x += __shfl_xor(x, 2); return x; }
__device__ __forceinline__ void phase_scan(const Args& a, LAS unsigned char* lds, const WCtx& w, int l) {
    LAS float* Qs = (LAS float*)lds; LAS float* Ks = Qs + 4096; LAS float* Dd = Qs + 8192; LAS float* Vs = Qs + 12288; LAS float* As = Qs + 16384; LAS float* Bs = As + 64;
    LAS bf16* Os = (LAS bf16*)(lds + 66048);
    const bf16* ZB = (const bf16*)(a.ws + WS_ZB); const float* ZF = (const float*)(a.ws + WS_ZF); const bf16* PB = (const bf16*)(a.ws + WS_PB); bf16* SO = (bf16*)(a.ws + WS_SO);
    const int sdir = w.tid >> 8, sr = (w.tid & 255) >> 3, c0 = (w.tid & 7) * 8;
    const int cdir = w.wave >> 2, eg = w.wave & 3, el = w.lane >> 2, dq = w.lane & 3;
    for (int pi = w.bid; pi < 192; pi += w.G) {
        const int mix = pi >> 6, b = (pi & 63) >> 2, h = pi & 3;
        float lbv[8]; float alog = 0.f, dtb = 0.f;
#pragma unroll
        for (int i = 0; i < 8; ++i) lbv[i] = 0.f;
        if (mix == 0) {
#pragma unroll
            for (int i = 0; i < 8; ++i) lbv[i] = ((const float*)(a.ws + WS_LB))[(sdir * 4 + l) * 256 + h * 64 + c0 + i]; }
        else if (mix == 1) { alog = expf(a.in[I_GDN_ALOG][(l * 2 + sdir) * 4 + h]); dtb = a.in[I_GDN_DTB][(l * 2 + sdir) * 4 + h]; }
        else { alog = expf(a.in[I_SSD_ALOG][(l * 2 + sdir) * 4 + h]); dtb = a.in[I_SSD_DTB][(l * 2 + sdir) * 4 + h]; }
        float S[16];
#pragma unroll
        for (int i = 0; i < 16; ++i) S[i] = 0.f;
        v4u rA, rB, rC; f32x4 rF0, rF1; float rs0 = 0.f, rs1 = 0.f;
        rA = rB = rC = (v4u){0u, 0u, 0u, 0u}; rF0 = rF1 = (f32x4){0.f, 0.f, 0.f, 0.f};
#define SCAN_ROW(dir_, sg_) (((sg_) < 256) ? (ML + b * 256 + ((dir_) ? 255 - (sg_) : (sg_))) : (b * 2048 + ((dir_) ? 2047 - ((sg_) - 256) : ((sg_) - 256))))
#define SCAN_LOAD(tb_) do { const int row_ = SCAN_ROW(sdir, (tb_) * 32 + sr); \
            if (mix == 0) { rA = *(const v4u*)(ZB + (size_t)row_ * NZB + h * 64 + c0); rC = *(const v4u*)(ZB + (size_t)row_ * NZB + 256 + h * 64 + c0); \
                            rF0 = *(const f32x4*)(ZF + (size_t)row_ * NZF + sdir * 256 + h * 64 + c0); rF1 = *(const f32x4*)(ZF + (size_t)row_ * NZF + sdir * 256 + h * 64 + c0 + 4); } \
            else if (mix == 1) { rA = *(const v4u*)(PB + (size_t)row_ * NPB + h * 64 + c0); rB = *(const v4u*)(PB + (size_t)row_ * NPB + 256 + h * 64 + c0); rC = *(const v4u*)(PB + (size_t)row_ * NPB + 512 + h * 64 + c0); \
                            rs0 = ZF[(size_t)row_ * NZF + 512 + sdir * 4 + h]; rs1 = ZF[(size_t)row_ * NZF + 520 + sdir * 4 + h]; } \
            else { rA = *(const v4u*)(PB + (size_t)row_ * NPB + 768 + 384 + (h >> 1) * 64 + c0); rB = *(const v4u*)(PB + (size_t)row_ * NPB + 768 + 256 + (h >> 1) * 64 + c0); rC = *(const v4u*)(PB + (size_t)row_ * NPB + 768 + h * 64 + c0); \
                            rs0 = ZF[(size_t)row_ * NZF + 528 + sdir * 4 + h]; } } while (0)
#define SCAN_STORE() do { const int o_ = (sdir * 32 + sr) * 64 + c0; float qa[8], ka[8], va[8], da[8]; \
            const unsigned ua[4] = {rA.x, rA.y, rA.z, rA.w}, ub[4] = {rB.x, rB.y, rB.z, rB.w}, uc[4] = {rC.x, rC.y, rC.z, rC.w}; \
            _Pragma("unroll") for (int i_ = 0; i_ < 4; ++i_) { qa[2 * i_] = bf2f(ua[i_] & 0xffffu); qa[2 * i_ + 1] = bf2f(ua[i_] >> 16); ka[2 * i_] = bf2f(ub[i_] & 0xffffu); ka[2 * i_ + 1] = bf2f(ub[i_] >> 16); \
                va[2 * i_] = bf2f(uc[i_] & 0xffffu); va[2 * i_ + 1] = bf2f(uc[i_] >> 16); } \
            if (mix == 0) { const float zf_[8] = {rF0[0], rF0[1], rF0[2], rF0[3], rF1[0], rF1[1], rF1[2], rF1[3]}; \
                _Pragma("unroll") for (int i_ = 0; i_ < 8; ++i_) { const float sg_ = sigmoid_acc(zf_[i_]); da[i_] = lbv[i_] + (1.0f - lbv[i_]) * sg_; ka[i_] = (1.0f - lbv[i_]) * (1.0f - sg_); qa[i_] = silu_acc(qa[i_]); } \
                if (c0 == 0) { As[sdir * 32 + sr] = 0.f; Bs[sdir * 32 + sr] = 0.f; } } \
            else if (mix == 1) { const float av_ = expf(-alog * softplus_acc(rs0 + dtb)); _Pragma("unroll") for (int i_ = 0; i_ < 8; ++i_) da[i_] = av_; \
                if (c0 == 0) { As[sdir * 32 + sr] = av_; Bs[sdir * 32 + sr] = sigmoid_acc(rs1); } } \
            else { const float dt_ = softplus_acc(rs0 + dtb); const float av_ = expf(-alog * dt_); _Pragma("unroll") for (int i_ = 0; i_ < 8; ++i_) { da[i_] = av_; va[i_] *= dt_; } \
                if (c0 == 0) { As[sdir * 32 + sr] = av_; Bs[sdir * 32 + sr] = 0.f; } } \
            *(LAS f32x4*)(Qs + o_) = (f32x4){qa[0], qa[1], qa[2], qa[3]}; *(LAS f32x4*)(Qs + o_ + 4) = (f32x4){qa[4], qa[5], qa[6], qa[7]}; \
            *(LAS f32x4*)(Ks + o_) = (f32x4){ka[0], ka[1], ka[2], ka[3]}; *(LAS f32x4*)(Ks + o_ + 4) = (f32x4){ka[4], ka[5], ka[6], ka[7]}; \
            *(LAS f32x4*)(Dd + o_) = (f32x4){da[0], da[1], da[2], da[3]}; *(LAS f32x4*)(Dd + o_ + 4) = (f32x4){da[4], da[5], da[6], da[7]}; \
            *(LAS f32x4*)(Vs + o_) = (f32x4){va[0], va[1], va[2], va[3]}; *(LAS f32x4*)(Vs + o_ + 4) = (f32x4){va[4], va[5], va[6], va[7]}; } while (0)
        SCAN_LOAD(0); SCAN_STORE(); __syncthreads();
        for (int tb = 0; tb < 72; ++tb) {
            if (tb + 1 < 72) SCAN_LOAD(tb + 1);
            for (int s = 0; s < 32; ++s) {
                const int base = (cdir * 32 + s) * 64 + dq * 16;
                f32x4 q4[4], k4[4], d4[4];
#pragma unroll
                for (int i = 0; i < 4; ++i) { q4[i] = *(const LAS f32x4*)(Qs + base + 4 * i); k4[i] = *(const LAS f32x4*)(Ks + base + 4 * i); d4[i] = *(const LAS f32x4*)(Dd + base + 4 * i); }
                float vv = Vs[(cdir * 32 + s) * 64 + eg * 16 + el];
                if (mix == 1) { const float av = As[cdir * 32 + s], be = Bs[cdir * 32 + s]; float ks = 0.f;
#pragma unroll
                    for (int i = 0; i < 16; ++i) ks += k4[i >> 2][i & 3] * S[i];
                    ks = red4(ks); vv = be * (vv - av * ks); }
                float o = 0.f;
#pragma unroll
                for (int i = 0; i < 16; ++i) { S[i] = d4[i >> 2][i & 3] * S[i] + k4[i >> 2][i & 3] * vv; o += q4[i >> 2][i & 3] * S[i]; }
                o = red4(o);
                if (dq == 0) Os[(w.wave * 32 + s) * 16 + el] = (bf16)f2bf(o);
            }
            LDS_WAIT();
            { const int r = w.lane >> 1, hf = w.lane & 1; const int row = SCAN_ROW(cdir, tb * 32 + r);
              const v4u ov = *(const LAS v4u*)(Os + (w.wave * 32 + r) * 16 + hf * 8);
              *(v4u*)(SO + ((size_t)(mix * 2 + cdir) * MT + row) * 256 + h * 64 + eg * 16 + hf * 8) = ov; }
            __syncthreads();
            if (tb + 1 < 72) SCAN_STORE();
            __syncthreads();
        }
#undef SCAN_ROW
#undef SCAN_LOAD
#undef SCAN_STORE
    }
}

__device__ __forceinline__ f32x4 ld_bf4(const bf16* p) { const v2u u = *(const v2u*)p; return (f32x4){bf2f(u.x & 0xffffu), bf2f(u.x >> 16), bf2f(u.y & 0xffffu), bf2f(u.y >> 16)}; }
__device__ __forceinline__ void st_bf4(bf16* p, f32x4 v) { v2u w; w.x = cvt_pk_bf16(v[0], v[1]); w.y = cvt_pk_bf16(v[2], v[3]); *(v2u*)p = w; }
__device__ __forceinline__ f32x4 silu4(f32x4 x) { return (f32x4){silu_acc(x[0]), silu_acc(x[1]), silu_acc(x[2]), silu_acc(x[3])}; }
__device__ __forceinline__ void phase_finish(const Args& a, const WCtx& w, int l, int nrows) {
    const bf16* ZB = (const bf16*)(a.ws + WS_ZB); const bf16* PB = (const bf16*)(a.ws + WS_PB); const bf16* SO = (const bf16*)(a.ws + WS_SO); const float* FO = (const float*)(a.ws + WS_FO);
    bf16* OUTS = (bf16*)(a.ws + WS_OUTS);
    const int ch = 4 * w.lane, hd = w.lane >> 4;
    const f32x4 nwa = *(const f32x4*)(a.in[I_HGRN_NW] + l * 256 + ch), nwb = *(const f32x4*)(a.in[I_GDN_NW] + l * 256 + ch), nwd = *(const f32x4*)(a.in[I_SSD_NW] + l * 256 + ch);
    const float dsk = a.in[I_SSD_D][l * 4 + hd];
    for (int row = w.gw; row < nrows; row += w.NGW) {
        bf16* orow = OUTS + (size_t)row * 1024 + ch;
        { f32x4 o = ld_bf4(SO + ((size_t)0 * MT + row) * 256 + ch) + ld_bf4(SO + ((size_t)1 * MT + row) * 256 + ch);
          float ss = (o[0] * o[0] + o[1] * o[1]) + (o[2] * o[2] + o[3] * o[3]); ss += __shfl_xor(ss, 1); ss += __shfl_xor(ss, 2); ss += __shfl_xor(ss, 4); ss += __shfl_xor(ss, 8);
          const float r = 1.0f / sqrtf(ss * (1.f / 64.f) + LN_EPS); const f32x4 g = silu4(ld_bf4(ZB + (size_t)row * NZB + 512 + ch));
          st_bf4(orow, o * r * nwa * g); }
        { f32x4 o = ld_bf4(SO + ((size_t)2 * MT + row) * 256 + ch) + ld_bf4(SO + ((size_t)3 * MT + row) * 256 + ch);
          float ss = (o[0] * o[0] + o[1] * o[1]) + (o[2] * o[2] + o[3] * o[3]); ss += __shfl_xor(ss, 1); ss += __shfl_xor(ss, 2); ss += __shfl_xor(ss, 4); ss += __shfl_xor(ss, 8);
          const float r = 1.0f / sqrtf(ss * (1.f / 64.f) + LN_EPS); const f32x4 g = silu4(ld_bf4(ZB + (size_t)row * NZB + 1536 + ch));
          st_bf4(orow + 256, o * r * nwb * g); }
        { f32x4 o = *(const f32x4*)(FO + (size_t)row * 256 + ch); if (row < ML) o += *(const f32x4*)(FO + ((size_t)MT + row) * 256 + ch);
          st_bf4(orow + 512, o); }
        { f32x4 o = ld_bf4(SO + ((size_t)4 * MT + row) * 256 + ch) + ld_bf4(SO + ((size_t)5 * MT + row) * 256 + ch);
          const f32x4 xh = ld_bf4(PB + (size_t)row * NPB + 768 + ch); const f32x4 z = silu4(ld_bf4(ZB + (size_t)row * NZB + 2560 + ch));
          f32x4 y = (o + xh * dsk) * z; const float ss = wave_sum((y[0] * y[0] + y[1] * y[1]) + (y[2] * y[2] + y[3] * y[3]));
          const float r = 1.0f / sqrtf(ss * (1.f / 256.f) + LN_EPS);
          st_bf4(orow + 768, y * r * nwd); }
    }
}

__device__ __forceinline__ void phase_ln1(const Args& a, LAS unsigned char* lds, const WCtx& w, int l, int nrows) {
    LAS float* WRT = (LAS float*)lds;
    for (int i = w.tid; i < 16384; i += NTHREADS) { const int d = i >> 4, e = i & 15; WRT[e * 1024 + d] = a.in[I_WROUTER][(size_t)l * 16384 + i]; }
    __syncthreads();
    float* X = (float*)(a.ws + WS_X); const float* Y = (const float*)(a.ws + WS_Y); bf16* H = (bf16*)(a.ws + WS_H); float* AFF = (float*)(a.ws + WS_AFF);
    const float* lg_ = a.in[I_LN1G] + l * 1024; const float* lb_ = a.in[I_LN1B] + l * 1024;
    for (int row = w.gw; row < nrows; row += w.NGW) {
        f32x4 x[4], y[4], hv[4]; row_load(X + (size_t)row * 1024, w.lane, x); row_load(Y + (size_t)row * 1024, w.lane, y);
        const float* g1 = mod_ptr(a, l, row, 2);
#pragma unroll
        for (int j = 0; j < 4; ++j) x[j] = x[j] * ALPHA + *((const f32x4*)g1 + w.lane + 64 * j) * y[j];
        float mean, rstd; ln_stats(x, mean, rstd);
#pragma unroll
        for (int j = 0; j < 4; ++j) x[j] = (x[j] - mean) * rstd * *((const f32x4*)lg_ + w.lane + 64 * j) + *((const f32x4*)lb_ + w.lane + 64 * j);
        row_store(X + (size_t)row * 1024, w.lane, x);
        modulate_row(x, mod_ptr(a, l, row, 3), mod_ptr(a, l, row, 4), H + (size_t)row * 1024, w.lane, hv);
        float lgt[16];
#pragma unroll
        for (int e = 0; e < 16; ++e) { float p = 0.f;
#pragma unroll
            for (int j = 0; j < 4; ++j) { const f32x4 wv = *(const LAS f32x4*)(WRT + e * 1024 + 256 * j + 4 * w.lane); p += (hv[j][0] * wv[0] + hv[j][1] * wv[1]) + (hv[j][2] * wv[2] + hv[j][3] * wv[3]); }
            lgt[e] = wave_sum(p); }
        float mx = lgt[0];
#pragma unroll
        for (int e = 1; e < 16; ++e) mx = fmaxf(mx, lgt[e]);
        float s = 0.f;
#pragma unroll
        for (int e = 0; e < 16; ++e) { lgt[e] = expf(lgt[e] - mx); s += lgt[e]; }
        float mine = lgt[0];
#pragma unroll
        for (int e = 1; e < 16; ++e) mine = (w.lane == e) ? lgt[e] : mine;
        if (w.lane < 16) AFF[(size_t)row * 16 + w.lane] = mine / s;
    }
}

__device__ __forceinline__ void phase_topk(const Args& a, LAS unsigned char* lds, const WCtx& w, int nitems) {
    LAS int* CNT = (LAS int*)lds;
    LAS int* WS1 = CNT + 16;
    LAS int* WS2 = WS1 + 8;
    LAS int* SEL = WS2 + 8;
    const float* AFF = (const float*)(a.ws + WS_AFF); int* SLOT = (int*)(a.ws + WS_SLOT); float* ROWW = (float*)(a.ws + WS_ROWW);
    const bf16* H = (const bf16*)(a.ws + WS_H); bf16* XE = (bf16*)(a.ws + WS_XE);
    for (int item = w.bid; item < nitems; item += w.G) {
        int b, e, n, cap, rowbase, xebase;
        if (item < 256) { b = item >> 4; e = item & 15; n = 2048; cap = CAP_L; rowbase = b * 2048; xebase = e * 4096 + b * 256; }
        else { const int it2 = item - 256; b = it2 >> 4; e = it2 & 15; n = 256; cap = CAP_C; rowbase = ML + b * 256; xebase = 65536 + e * 512 + b * 32; }
        unsigned key[4];
#pragma unroll
        for (int j = 0; j < 4; ++j) { const int t = w.tid * 4 + j; key[j] = t < n ? __float_as_uint(AFF[(size_t)(rowbase + t) * 16 + e]) : 0u; }
        unsigned T = 0u;
        for (int bit = 30; bit >= 0; --bit) {
            const unsigned trial = T | (1u << bit); int c = 0;
#pragma unroll
            for (int j = 0; j < 4; ++j) c += (key[j] >= trial) ? 1 : 0;
#pragma unroll
            for (int o = 1; o < 64; o <<= 1) c += __shfl_xor(c, o);
            LAS int* cb = CNT + (bit & 1) * 8;
            if (w.lane == 0) cb[w.wave] = c;
            __syncthreads();
            int tot = 0;
#pragma unroll
            for (int q = 0; q < 8; ++q) tot += cb[q];
            if (tot >= cap) T = trial;
        }
        int ngt = 0, ceq = 0;
#pragma unroll
        for (int j = 0; j < 4; ++j) { ngt += (key[j] > T) ? 1 : 0; ceq += (key[j] == T && key[j] != 0u) ? 1 : 0; }
        int xg = ngt, xe = ceq;
#pragma unroll
        for (int o = 1; o < 64; o <<= 1) { const int yg = __shfl_up(xg, o), ye = __shfl_up(xe, o); if (w.lane >= o) { xg += yg; xe += ye; } }
        __syncthreads();
        if (w.lane == 63) { WS1[w.wave] = xg; WS2[w.wave] = xe; }
        __syncthreads();
        int totg = 0, offe = 0;
#pragma unroll
        for (int q = 0; q < 8; ++q) { totg += WS1[q]; if (q < w.wave) offe += WS2[q]; }
        const int need_eq = cap - totg; int eqrank = offe + xe - ceq;
        int sel[4], csel = 0;
#pragma unroll
        for (int j = 0; j < 4; ++j) { const bool iseq = (key[j] == T && key[j] != 0u); sel[j] = (key[j] > T) || (iseq && eqrank < need_eq); if (iseq) ++eqrank; csel += sel[j]; }
        int xs = csel;
#pragma unroll
        for (int o = 1; o < 64; o <<= 1) { const int ys = __shfl_up(xs, o); if (w.lane >= o) xs += ys; }
        __syncthreads();
        if (w.lane == 63) WS1[w.wave] = xs;
        __syncthreads();
        int offs = 0;
#pragma unroll
        for (int q = 0; q < 8; ++q) if (q < w.wave) offs += WS1[q];
        int slot = offs + xs - csel;
#pragma unroll
        for (int j = 0; j < 4; ++j) { const int t = w.tid * 4 + j; if (t < n) { int sv = -1; if (sel[j]) { sv = slot; if (slot < cap) { SEL[slot] = t; ROWW[xebase + slot] = __uint_as_float(key[j]); } ++slot; }
                SLOT[(size_t)(rowbase + t) * 16 + e] = (sv < cap) ? sv : -1; } }
        __syncthreads();
        for (int s = w.wave; s < cap; s += NWAVES) { const v4u* src = (const v4u*)(H + (size_t)(rowbase + SEL[s]) * 1024); v4u* dst = (v4u*)(XE + (size_t)(xebase + s) * 1024);
            dst[w.lane] = src[w.lane]; dst[w.lane + 64] = src[w.lane + 64]; }
        __syncthreads();
    }
}

__device__ __forceinline__ void phase_ln2(const Args& a, const WCtx& w, int l, int nrows) {
    float* X = (float*)(a.ws + WS_X); bf16* H = (bf16*)(a.ws + WS_H); const bf16* YE = (const bf16*)(a.ws + WS_YE); const int* SLOT = (const int*)(a.ws + WS_SLOT);
    const float* lg_ = a.in[I_LN2G] + l * 1024; const float* lb_ = a.in[I_LN2B] + l * 1024;
    for (int row = w.gw; row < nrows; row += w.NGW) {
        f32x4 x[4], mo[4], hv[4]; row_load(X + (size_t)row * 1024, w.lane, x);
#pragma unroll
        for (int j = 0; j < 4; ++j) mo[j] = (f32x4){0.f, 0.f, 0.f, 0.f};
        const int myslot = SLOT[(size_t)row * 16 + (w.lane & 15)];
        const int b = row < ML ? (row >> 11) : ((row - ML) >> 8);
        for (int e = 0; e < 16; ++e) { const int s = __shfl(myslot, e);
            if (s >= 0) { const size_t xr = row < ML ? (size_t)(e * 4096 + b * 256 + s) : (size_t)(65536 + e * 512 + b * 32 + s); const bf16* yr = YE + xr * 1024 + 4 * w.lane;
#pragma unroll
                for (int j = 0; j < 4; ++j) mo[j] += ld_bf4(yr + 256 * j); } }
        const float* g2 = mod_ptr(a, l, row, 5);
#pragma unroll
        for (int j = 0; j < 4; ++j) x[j] = x[j] * ALPHA + *((const f32x4*)g2 + w.lane + 64 * j) * mo[j];
        float mean, rstd; ln_stats(x, mean, rstd);
#pragma unroll
        for (int j = 0; j < 4; ++j) x[j] = (x[j] - mean) * rstd * *((const f32x4*)lg_ + w.lane + 64 * j) + *((const f32x4*)lb_ + w.lane + 64 * j);
        if (l == DEPTH - 1) row_store(a.out + (size_t)row * 1024, w.lane, x);
        else { row_store(X + (size_t)row * 1024, w.lane, x); modulate_row(x, mod_ptr(a, l + 1, row, 0), mod_ptr(a, l + 1, row, 1), H + (size_t)row * 1024, w.lane, hv); }
    }
}
constexpr int N_PHASES = 2 + 12 * DEPTH;
#ifndef PHMASK
#define PHMASK 0xFFFFu
#endif
#define EN(k) (((PHMASK) >> (k)) & 1u)
__global__ void __launch_bounds__(NTHREADS, 2) fwd_kernel(Args args) {
    extern __shared__ __attribute__((aligned(16))) unsigned char lds_raw[];
    LAS unsigned char* lds = (LAS unsigned char*)lds_raw;
#define MKW() WCtx w; { int t_ = threadIdx.x; asm volatile("" : "+v"(t_)); w.tid = t_; w.lane = t_ & 63; w.wave = __builtin_amdgcn_readfirstlane(t_ >> 6); w.bid = blockIdx.x; w.G = gridDim.x; w.gw = w.bid * NWAVES + w.wave; w.NGW = w.G * NWAVES; } \
              unsigned char* ws = args.ws; asm volatile("" : "+s"(ws)); const int c = w.bid; (void)c; (void)ws
    for (int u = threadIdx.x; u < (LDS_BYTES - LDSCTL_OFF) / 4; u += NTHREADS) ((LAS unsigned*)(lds + LDSCTL_OFF))[u] = 0u;
    __syncthreads();
    XcdBarrier bar = xcd_barrier_post((unsigned*)(args.ws + WS_CTL) + CW_BAR + args.li * XCD_BAR_WORDS, (volatile LAS unsigned*)(lds + MISC_OFF) + 8);
    const int lo = args.ph_lo, hi = args.ph_hi;
#define INP(k) (lo <= (k) && (k) < hi)
#define SEAM(k) do { if (INP(k) && INP((k) + 1)) xcd_barrier(bar); } while (0)
    if (EN(12) && INP(0)) { MKW(); phase_prologue(args, lds, w); }
    SEAM(0);
    if (EN(13) && INP(1)) { MKW(); phase_mod_rows(args, w, 0); }
    SEAM(1);
    for (int l = 0; l < DEPTH; ++l) {
        const int pb = 2 + 12 * l;
        const bool lastl = (l == DEPTH - 1);
        const int nrows = lastl ? ML : MT, nMr = nrows / 256;
        if (EN(0) && INP(pb + 0)) { MKW();
            { pg8::Order<MapPlain> S; S.init(MT / 256, 11, w.G, c); S.map = MapPlain{(const char*)(ws + WS_H), (const char*)(ws + WS_WIN), (size_t)256 * 1024 * 2, (size_t)256 * 1024 * 2};
              EpiBf E{(bf16*)(ws + WS_ZB), NZB, nullptr};
              pg8::gemm_phase<EpiBf, pg8::Order<MapPlain>>(lds, pg8::Gemm{1024, 1024, 1024}, S, E); }
            { pg8::Order<MapPlain> S; S.init(MT / 256, 3, w.G, c); S.map = MapPlain{(const char*)(ws + WS_H), (const char*)(ws + WS_WIN) + (size_t)11 * 256 * 1024 * 2, (size_t)256 * 1024 * 2, (size_t)256 * 1024 * 2};
              EpiF32 E{(float*)(ws + WS_ZF), NZF};
              pg8::gemm_phase<EpiF32, pg8::Order<MapPlain>>(lds, pg8::Gemm{1024, 1024, 1024}, S, E); }
        }
        SEAM(pb + 0);
        if (EN(1) && INP(pb + 1)) { MKW();
            pg8::Order<MapPlain> S; S.init(2, MT / 256, w.G, c); S.map = MapPlain{(const char*)(ws + WS_DFT64), (const char*)(ws + WS_ZB) + 1792 * 2, (size_t)256 * 256 * 2, (size_t)256 * NZB * 2};
            EpiFour1 E{(bf16*)(ws + WS_VTL), (bf16*)(ws + WS_VTC)};
            pg8::gemm_phase<EpiFour1, pg8::Order<MapPlain>>(lds, pg8::Gemm{256, 256, NZB}, S, E);
            if (EN(15)) phase_prep(args, w, l);
        }
        SEAM(pb + 1);
        if (EN(2) && INP(pb + 2)) { MKW();
            { pg8::Order<MapFourT> S; S.init(8, 32, w.G, c); S.map = MapFourT{(const char*)(ws + WS_DFTL), (const char*)(ws + WS_VTL)};
              EpiFourT E{(float*)(ws + WS_FO), 0};
              pg8::gemm_phase<EpiFourT, pg8::Order<MapFourT>>(lds, pg8::Gemm{2048, 4096, 4096}, S, E); }
            { pg8::Order<MapPlain> S; S.init(1, 16, w.G, c); S.map = MapPlain{(const char*)(ws + WS_DFTC), (const char*)(ws + WS_VTC), 0, (size_t)256 * 512 * 2};
              EpiFourT E{(float*)(ws + WS_FO), 1};
              pg8::gemm_phase<EpiFourT, pg8::Order<MapPlain>>(lds, pg8::Gemm{512, 512, 512}, S, E); }
            if (EN(14)) phase_scan(args, lds, w, l);
        }
        SEAM(pb + 2);
        if (EN(3) && INP(pb + 3)) { MKW(); phase_finish(args, w, l, nrows); }
        SEAM(pb + 3);
        if (EN(4) && INP(pb + 4)) { MKW();
            pg8::Order<MapP> S; S.init(nMr, 16, w.G, c); S.map = MapP{(const char*)(ws + WS_OUTS), (const char*)(ws + WS_WBR)};
            EpiBf E{(bf16*)(ws + WS_P), 4096, nullptr};
            pg8::gemm_phase<EpiBf, pg8::Order<MapP>>(lds, pg8::Gemm{256, 1024, 256}, S, E);
        }
        SEAM(pb + 4);
        if (EN(5) && INP(pb + 5)) { MKW();
            pg8::Order<MapPlain> S; S.init(nMr, 16, w.G, c); S.map = MapPlain{(const char*)(ws + WS_H), (const char*)(ws + WS_WG), (size_t)256 * 1024 * 2, (size_t)256 * 1024 * 2};
            EpiMerge E{(const bf16*)(ws + WS_P), (bf16*)(ws + WS_T), args.in[I_BGATE] + (size_t)l * 4096};
            pg8::gemm_phase<EpiMerge, pg8::Order<MapPlain>>(lds, pg8::Gemm{1024, 1024, 1024}, S, E);
        }
        SEAM(pb + 5);
        if (EN(6) && INP(pb + 6)) { MKW();
            pg8::Order<MapPlain> S; S.init(nMr, 4, w.G, c); S.map = MapPlain{(const char*)(ws + WS_T), (const char*)(ws + WS_WOUT), (size_t)256 * 1024 * 2, (size_t)256 * 1024 * 2};
            EpiF32 E{(float*)(ws + WS_Y), 1024};
            pg8::gemm_phase<EpiF32, pg8::Order<MapPlain>>(lds, pg8::Gemm{1024, 1024, 1024}, S, E);
        }
        SEAM(pb + 6);
        if (EN(7) && INP(pb + 7)) { MKW(); phase_ln1(args, lds, w, l, nrows); }
        SEAM(pb + 7);
        if (EN(8) && INP(pb + 8)) { MKW(); phase_topk(args, lds, w, lastl ? 256 : 512); }
        SEAM(pb + 8);
        const int nMe = lastl ? 256 : 288;
        if (EN(9) && INP(pb + 9)) { MKW();
            pg8::Order<MapMoE> S; S.init(nMe, 8, w.G, c); S.map = MapMoE{(const char*)(ws + WS_XE), (const char*)(ws + WS_WGU), (size_t)2048 * 1024 * 2};
            EpiSwiGLU E{(bf16*)(ws + WS_HID)};
            pg8::gemm_phase<EpiSwiGLU, pg8::Order<MapMoE>>(lds, pg8::Gemm{1024, 1024, 1024}, S, E);
        }
        SEAM(pb + 9);
        if (EN(10) && INP(pb + 10)) { MKW();
            pg8::Order<MapMoE> S; S.init(nMe, 4, w.G, c); S.map = MapMoE{(const char*)(ws + WS_HID), (const char*)(ws + WS_WDN), (size_t)1024 * 1024 * 2};
            EpiBf E{(bf16*)(ws + WS_YE), 1024, (const float*)(ws + WS_ROWW)};
            pg8::gemm_phase<EpiBf, pg8::Order<MapMoE>>(lds, pg8::Gemm{1024, 1024, 1024}, S, E);
        }
        SEAM(pb + 10);
        if (EN(11) && INP(pb + 11)) { MKW(); phase_ln2(args, w, l, nrows); if (!lastl) { __syncthreads(); convert_weights(args, lds, w, l + 1); } }
        SEAM(pb + 11);
    }
#undef INP
#undef SEAM
}

#ifndef MK_SPLIT
#define MK_SPLIT 0
#endif
extern "C" void kernel_launch(void* const* d_in, const int* in_sizes, int n_in, void* d_out, int out_size, void* d_ws, size_t ws_size, hipStream_t stream) {
    static int grid = 0;
    if (grid == 0) {
        if (n_in != 31 || out_size != ML * D || ws_size < WS_END) { fprintf(stderr, "kernel_launch: unexpected problem (n_in %d, out %d, ws %zu, need %zu)\n", n_in, out_size, ws_size, (size_t)WS_END); grid = -1; return; }
        int dev = 0, cus = 0, per_cu = 0;
        if (hipGetDevice(&dev) != hipSuccess || hipDeviceGetAttribute(&cus, hipDeviceAttributeMultiprocessorCount, dev) != hipSuccess) { grid = -1; return; }
        if (hipFuncSetAttribute((const void*)fwd_kernel, hipFuncAttributeMaxDynamicSharedMemorySize, LDS_BYTES) != hipSuccess) { fprintf(stderr, "kernel_launch: hipFuncSetAttribute failed\n"); grid = -1; return; }
        if (hipOccupancyMaxActiveBlocksPerMultiprocessor(&per_cu, (const void*)fwd_kernel, NTHREADS, LDS_BYTES) != hipSuccess || per_cu < 1) fprintf(stderr, "kernel_launch: occupancy query says %d\n", per_cu);
        (void)hipGetLastError();
        grid = cus;
    }
    if (grid < 0) return;
    if (hipMemsetAsync((char*)d_ws + WS_CTL, 0, CTL_ZERO_BYTES, stream) != hipSuccess) return;
    Args a{};
    for (int i = 0; i < 31; ++i) a.in[i] = (const float*)d_in[i];
    a.out = (float*)d_out; a.ws = (unsigned char*)d_ws;
#if MK_SPLIT
    for (int p = 0; p < N_PHASES; ++p) { a.ph_lo = p; a.ph_hi = p + 1; a.li = p; a.pad = 0; hipLaunchKernelGGL(fwd_kernel, dim3(grid), dim3(NTHREADS), LDS_BYTES, stream, a); }
#else
    a.ph_lo = 0; a.ph_hi = N_PHASES; a.li = 0; a.pad = 0;
    hipLaunchKernelGGL(fwd_kernel, dim3(grid), dim3(NTHREADS), LDS_BYTES, stream, a);
#endif
    const hipError_t le = hipPeekAtLastError();
    if (le != hipSuccess) fprintf(stderr, "kernel_launch: launch failed: %s\n", hipGetErrorName(le));
}
```

```cpp
#include <hip/hip_runtime.h>
#include <cstdio>
#include <cstdint>

#define LAS __attribute__((address_space(3)))
typedef unsigned short bf16;
typedef short bf16x8 __attribute__((ext_vector_type(8)));
typedef float f32x4 __attribute__((ext_vector_type(4)));
typedef float f32x2 __attribute__((ext_vector_type(2)));
typedef unsigned v4u __attribute__((ext_vector_type(4)));
typedef unsigned v2u __attribute__((ext_vector_type(2)));

constexpr int D = 1024, BATCH = 16, SEQ = 2048, CTXL = 256, DEPTH = 4, BW = 256, NH = 4, HD = 64, NE = 16, FF = 1024;
constexpr int ML = BATCH * SEQ, MC = BATCH * CTXL, MT = ML + MC;
constexpr int IN_COLS = 3352;
constexpr int NZB = 2816, NZF = 768;
constexpr int NPB = 1280;
constexpr float LN_EPS = 1e-6f;
constexpr float ALPHA = 1.681792830507429f;
constexpr int CAP_L = 256, CAP_C = 32;
constexpr int NWAVES = 8, NTHREADS = 512;

constexpr size_t MiB = 1u << 20;
constexpr size_t WS_CTL = 0, CTL_ZERO_BYTES = 1 * MiB;
constexpr size_t WS_MOD = 1 * MiB;
constexpr size_t WS_LB = 3 * MiB;
constexpr size_t WS_DFT64 = 4 * MiB;
constexpr size_t WS_DFTC = 5 * MiB;
constexpr size_t WS_DFTL = 6 * MiB;
constexpr size_t WS_AFF = 22 * MiB;
constexpr size_t WS_SLOT = 25 * MiB;
constexpr size_t WS_ROWW = 28 * MiB;
constexpr size_t WS_WIN = 32 * MiB;
constexpr size_t WS_WG = 39 * MiB;
constexpr size_t WS_WBR = 47 * MiB;
constexpr size_t WS_WOUT = 49 * MiB;
constexpr size_t WS_WGU = 51 * MiB;
constexpr size_t WS_WDN = 115 * MiB;
constexpr size_t WS_X = 147 * MiB;
constexpr size_t WS_H = 291 * MiB;
constexpr size_t WS_R1 = 364 * MiB;
constexpr size_t WS_ZB = WS_R1;
constexpr size_t WS_ZF = WS_R1 + 198 * MiB;
constexpr size_t WS_PB = WS_R1 + 306 * MiB;
constexpr size_t WS_SO = WS_R1 + 396 * MiB;
constexpr size_t WS_VTL = WS_R1 + 504 * MiB;
constexpr size_t WS_VTC = WS_R1 + 536 * MiB;
constexpr size_t WS_FO = WS_R1 + 540 * MiB;
constexpr size_t WS_OUTS = WS_R1 + 612 * MiB;
constexpr size_t WS_P = WS_R1;
constexpr size_t WS_T = WS_R1 + 288 * MiB;
constexpr size_t WS_Y = WS_R1 + 360 * MiB;
constexpr size_t WS_XE = WS_R1;
constexpr size_t WS_HID = WS_R1 + 144 * MiB;
constexpr size_t WS_YE = WS_R1 + 288 * MiB;
constexpr size_t WS_H8 = WS_R1 + 756 * MiB;
constexpr size_t WS_END = WS_R1 + 792 * MiB;
constexpr int CW_BAR = 4096;

constexpr int RING_BYTES = 131072;
constexpr int LDSCTL_OFF = 145408, MISC_OFF = LDSCTL_OFF + 320;
constexpr int LDS_BYTES = 147456;

__device__ __forceinline__ float bf2f(unsigned b) { return __uint_as_float(b << 16); }
__device__ __forceinline__ unsigned f2bf(float f) { unsigned u = __float_as_uint(f); return (u + 0x7fffu + ((u >> 16) & 1u)) >> 16; }
__device__ __forceinline__ unsigned pk2(float lo, float hi) { return f2bf(lo) | (f2bf(hi) << 16); }
__device__ __forceinline__ unsigned cvt_pk_bf16(float lo, float hi) { unsigned r; asm volatile("v_cvt_pk_bf16_f32 %0, %1, %2" : "=v"(r) : "v"(lo), "v"(hi)); return r; }
__device__ __forceinline__ float wave_sum(float v) {
#pragma unroll
    for (int o = 1; o < 64; o <<= 1) v += __shfl_xor(v, o);
    return v;
}
__device__ __forceinline__ float sigmoid_fast(float x) { return __builtin_amdgcn_rcpf(1.0f + __expf(-x)); }
__device__ __forceinline__ float sigmoid_acc(float x) { return 1.0f / (1.0f + expf(-x)); }
__device__ __forceinline__ float silu_acc(float x) { return x / (1.0f + expf(-x)); }
__device__ __forceinline__ float softplus_acc(float x) { return x > 20.f ? x : log1pf(expf(x)); }
#define LDS_WAIT() asm volatile("s_waitcnt lgkmcnt(0)" ::: "memory")
#define VM_WAIT() asm volatile("s_waitcnt vmcnt(0)" ::: "memory")

namespace pg8 {
constexpr int BM = 256, BK = 64, HALF = 128, HTB = HALF * BK * 2, STAGE_BYTES = 8 * HTB, NXCD = 8, WGM = 8;
__host__ __device__ __forceinline__ int lds_byte(int r, int c) { const int st = (r >> 4) * 2 + (c >> 5), rr = r & 15, cc = c & 31, ob = rr * 64 + cc * 2; return st * 1024 + (ob ^ (((ob >> 9) & 1) << 5)); }
__host__ __device__ __forceinline__ void stage_rc(int b, int& R, int& C) { const int st = b / 1024, sb = b % 1024, swz = sb ^ (((sb >> 9) & 1) << 5); R = (st >> 1) * 16 + swz / 64; C = (st & 1) * 32 + (swz % 64) / 2; }
__host__ __device__ __forceinline__ int perm32(int rho) { const int n = rho >> 4, i = rho & 15; return 8 * (i >> 2) + 4 * n + (i & 3); }

struct Unit { int pm, pn; const char* A; const char* B; };
struct Gemm { int K, lda, ldb; int sw = 0x7F7F7F7F, sx = 0x7F7F7F7F; };
typedef int v8i __attribute__((ext_vector_type(8)));
typedef int v4i __attribute__((ext_vector_type(4)));

template <class Map> struct Order {
    int nM, nN, nwg, G, c; Map map;
    __device__ __forceinline__ void init(int nM_, int nN_, int G_, int c_) { nM = nM_; nN = nN_; nwg = nM * nN; G = G_; c = c_; }
    __device__ __forceinline__ bool next(int i, Unit& u) const {
        const long L = (long)i * G + c; if (L >= nwg) return false;
        int wgid = (int)L; { const int q = nwg / NXCD, r = nwg % NXCD, xcd = wgid % NXCD, off = wgid / NXCD; wgid = (xcd < r ? xcd * (q + 1) : r * (q + 1) + (xcd - r) * q) + off; }
        const int nig = WGM * nN, gid = wgid / nig, fm = gid * WGM, gsz = (nM - fm) < WGM ? (nM - fm) : WGM;
        u.pm = fm + ((wgid % nig) % gsz); u.pn = (wgid % nig) / gsz; map(u); return true;
    }
    __device__ __forceinline__ void a_ready(const Unit&) const {}
    __device__ __forceinline__ void done(const Unit&) const {}
};

template <class Epi, class Sched, bool ALIGN_EPI = true, bool SP2 = true, bool GATHER = false, int ESZ = 2>
__device__ __forceinline__ void gemm_phase(LAS unsigned char* lds, const Gemm g, const Sched& S, const Epi& E, const int* selrow = nullptr) {
    int tid_ = threadIdx.x; asm volatile("" : "+v"(tid_));
    const int tid = tid_, wid = __builtin_amdgcn_readfirstlane(tid >> 6), lane = tid & 63, wr = wid >> 2, wc = wid & 3, fr = lane & 15, fq = lane >> 4;
    constexpr bool FP8 = (ESZ == 1);
    const int K = g.K, nt = K * ESZ / (BK * 2);
    unsigned voffA[2], voffB[2]; int gR[2]; unsigned gC2[2];
#pragma unroll
    for (int i = 0; i < 2; ++i) { int R, C; stage_rc(tid * 16 + i * 8192, R, C); const int Rb = Epi::PERM ? ((R & ~31) + perm32(R & 31)) : R;
        voffA[i] = (unsigned)(R * g.lda * ESZ + C * 2); voffB[i] = (unsigned)(Rb * g.ldb * ESZ + C * 2); gR[i] = R; gC2[i] = (unsigned)C * 2u; }
    unsigned gc0[2] = {voffA[0], voffA[1]}, gc1[2] = {voffA[0], voffA[1]};
    int gn0r[2] = {0, 0}, gn1r[2] = {0, 0};
    const size_t kstep = (size_t)(BK * 2);
    const size_t hstepA = GATHER ? (size_t)0 : (size_t)HALF * g.lda * ESZ, hstepB = (size_t)HALF * g.ldb * ESZ;
    const unsigned ldsw = (unsigned)wid * 1024u;
    const int aoff = lds_byte(wr * 64 + fr, FP8 ? fq * 16 : fq * 8), boff = lds_byte(wc * 32 + fr, FP8 ? fq * 16 : fq * 8);
    const int sel8 = FP8 ? ((fq & 1) << 4) : 0; const int aoff1 = aoff + sel8, aoff2 = aoff + 16 - sel8, boff1 = boff + sel8, boff2 = boff + 16 - sel8;
#define PG8_SA(b, h) (((b) * 2 + (h)) * HTB)
#define PG8_SB(b, h) ((4 + (b) * 2 + (h)) * HTB)
#define PG8_STAGE(bufoff, gbase, voff) do { _Pragma("unroll") for (int _i = 0; _i < 2; ++_i) \
        __builtin_amdgcn_global_load_lds((const unsigned*)((const char*)(gbase) + (voff)[_i]), (LAS unsigned*)(lds + (bufoff) + ldsw + _i * 8192), 16, 0, 0); } while (0)
#define PG8_CAT(p_, q_) __builtin_shufflevector(*(const LAS v4i*)(p_), *(const LAS v4i*)(q_), 0, 1, 2, 3, 4, 5, 6, 7)
#define PG8_LDA(dst, b, h) do { if constexpr (FP8) { _Pragma("unroll") for (int m = 0; m < 4; ++m) dst##8[m] = PG8_CAT(lds + PG8_SA(b, h) + aoff1 + m * 2048, lds + PG8_SA(b, h) + aoff2 + m * 2048); } \
        else { _Pragma("unroll") for (int m = 0; m < 4; ++m) _Pragma("unroll") for (int k = 0; k < 2; ++k) dst[m][k] = *(const LAS bf16x8*)(lds + PG8_SA(b, h) + aoff + m * 2048 + k * 1024); } } while (0)
#define PG8_LDB(dst, b, h) do { if constexpr (FP8) { _Pragma("unroll") for (int n = 0; n < 2; ++n) dst##8[n] = PG8_CAT(lds + PG8_SB(b, h) + boff1 + n * 2048, lds + PG8_SB(b, h) + boff2 + n * 2048); } \
        else { _Pragma("unroll") for (int n = 0; n < 2; ++n) _Pragma("unroll") for (int k = 0; k < 2; ++k) dst[n][k] = *(const LAS bf16x8*)(lds + PG8_SB(b, h) + boff + n * 2048 + k * 1024); } } while (0)
#define PG8_MMA(ai, bj, At, Bt) do { __builtin_amdgcn_s_setprio(1); \
        if constexpr (FP8) { _Pragma("unroll") for (int m = 0; m < 4; ++m) _Pragma("unroll") for (int n = 0; n < 2; ++n) \
            asm volatile("v_mfma_scale_f32_16x16x128_f8f6f4 %0, %1, %2, %0, %3, %4 op_sel_hi:[0,0,0]" : "+v"(acc[ai][bj][m][n]) : "v"(Bt##8[n]), "v"(At##8[m]), "v"(vsw), "v"(vsx)); } \
        else { _Pragma("unroll") for (int m = 0; m < 4; ++m) _Pragma("unroll") for (int n = 0; n < 2; ++n) _Pragma("unroll") for (int k = 0; k < 2; ++k) \
            acc[ai][bj][m][n] = __builtin_amdgcn_mfma_f32_16x16x32_bf16(Bt[n][k], At[m][k], acc[ai][bj][m][n], 0, 0, 0); } \
        __builtin_amdgcn_s_setprio(0); } while (0)
#define PG8_WAIT_V(n) asm volatile("s_waitcnt vmcnt(" #n ")" ::: "memory")
#define PG8_WAIT_L(n) asm volatile("s_waitcnt lgkmcnt(" #n ")" ::: "memory")
#define PG8_BAR __builtin_amdgcn_s_barrier()
#define PG8_SCHED __builtin_amdgcn_sched_barrier(0)
    Unit cur, nxt; int ui = 0;
    if (!S.next(0, cur)) return;
    f32x4 acc[2][2][4][2];
#pragma unroll
    for (int a = 0; a < 2; ++a)
#pragma unroll
        for (int b = 0; b < 2; ++b)
#pragma unroll
            for (int m = 0; m < 4; ++m)
#pragma unroll
                for (int n = 0; n < 2; ++n) acc[a][b][m][n] = (f32x4){0.f, 0.f, 0.f, 0.f};
    bf16x8 At[4][2], B0[2][2], B1[2][2];
    v8i At8[4], B08[2], B18[2];
    const int vsw = g.sw, vsx = g.sx;
    const char* cA = cur.A; const char* cB = cur.B;
    S.a_ready(cur);
    if constexpr (GATHER) {
#pragma unroll
        for (int i = 0; i < 2; ++i) { gc0[i] = (unsigned)selrow[cur.pm * 256 + gR[i]] * (unsigned)(g.lda * ESZ) + gC2[i]; gc1[i] = (unsigned)selrow[cur.pm * 256 + 128 + gR[i]] * (unsigned)(g.lda * ESZ) + gC2[i]; } }
    if constexpr (SP2) {
        PG8_STAGE(PG8_SB(0, 0), cB, voffB); PG8_STAGE(PG8_SB(0, 1), cB + hstepB, voffB); PG8_STAGE(PG8_SA(0, 0), cA, gc0); PG8_STAGE(PG8_SA(0, 1), cA + hstepA, gc1);
        if (wr == 1) PG8_BAR;
        PG8_WAIT_V(2); PG8_BAR;
        PG8_STAGE(PG8_SB(1, 0), cB + kstep, voffB); PG8_STAGE(PG8_SA(1, 0), cA + kstep, gc0); PG8_STAGE(PG8_SB(1, 1), cB + hstepB + kstep, voffB);
        PG8_WAIT_V(6); PG8_BAR;
    } else {
        PG8_STAGE(PG8_SB(0, 0), cB, voffB); PG8_STAGE(PG8_SA(0, 0), cA, voffA); PG8_STAGE(PG8_SB(0, 1), cB + hstepB, voffB); PG8_STAGE(PG8_SA(0, 1), cA + hstepA, voffA);
        if (wr == 1) PG8_BAR;
        PG8_WAIT_V(4); PG8_BAR;
        PG8_STAGE(PG8_SB(1, 0), cB + kstep, voffB); PG8_STAGE(PG8_SA(1, 0), cA + kstep, voffA); PG8_STAGE(PG8_SB(1, 1), cB + hstepB + kstep, voffB);
        PG8_WAIT_V(6); PG8_BAR;
    }
    for (;;) {
        const bool has_next = S.next(ui + 1, nxt);
        if constexpr (GATHER) { if (has_next) {
#pragma unroll
            for (int i = 0; i < 2; ++i) { gn0r[i] = selrow[nxt.pm * 256 + gR[i]]; gn1r[i] = selrow[nxt.pm * 256 + 128 + gR[i]]; } } }
        const char* nA = has_next ? nxt.A : cA; const char* nB = has_next ? nxt.B : cB;
#pragma unroll 1
        for (int t = 0; t < nt; t += 2) {
            const bool last = (t == nt - 2);
            const char* a1 = cA + (size_t)(t + 1) * kstep;
            const char* a2 = last ? nA : cA + (size_t)(t + 2) * kstep; const char* b2 = last ? nB : cB + (size_t)(t + 2) * kstep;
            const char* a3 = a2 + kstep; const char* b3 = b2 + kstep;
            if (last && has_next) S.a_ready(nxt);
            unsigned s0[2] = {gc0[0], gc0[1]}, s1[2] = {gc1[0], gc1[1]};
            if constexpr (GATHER) { if (last && has_next) { asm volatile("" : "+v"(gn0r[0]), "+v"(gn0r[1]), "+v"(gn1r[0]), "+v"(gn1r[1]));
#pragma unroll
                for (int i = 0; i < 2; ++i) { s0[i] = (unsigned)gn0r[i] * (unsigned)(g.lda * ESZ) + gC2[i]; s1[i] = (unsigned)gn1r[i] * (unsigned)(g.lda * ESZ) + gC2[i]; } } }
            if constexpr (SP2) {
            PG8_LDB(B0, 0, 0); PG8_LDB(B1, 0, 1); PG8_SCHED; PG8_LDA(At, 0, 0); PG8_STAGE(PG8_SA(1, 1), a1 + hstepA, gc1);
            PG8_WAIT_V(8); PG8_WAIT_L(0); PG8_BAR; PG8_MMA(0, 0, At, B0); PG8_MMA(0, 1, At, B1); PG8_BAR; PG8_SCHED;
            PG8_LDA(At, 0, 1); PG8_STAGE(PG8_SB(0, 0), b2, voffB); PG8_STAGE(PG8_SB(0, 1), b2 + hstepB, voffB); PG8_STAGE(PG8_SA(0, 0), a2, s0);
            PG8_WAIT_V(8); PG8_WAIT_L(0); PG8_BAR; PG8_MMA(1, 0, At, B0); PG8_MMA(1, 1, At, B1); PG8_BAR; PG8_SCHED;
            PG8_LDB(B0, 1, 0); PG8_LDB(B1, 1, 1); PG8_SCHED; PG8_LDA(At, 1, 0); PG8_STAGE(PG8_SA(0, 1), a2 + hstepA, s1);
            PG8_WAIT_V(8); PG8_WAIT_L(0); PG8_BAR; PG8_MMA(0, 0, At, B0); PG8_MMA(0, 1, At, B1); PG8_BAR; PG8_SCHED;
            PG8_LDA(At, 1, 1); PG8_STAGE(PG8_SB(1, 0), b3, voffB); PG8_STAGE(PG8_SB(1, 1), b3 + hstepB, voffB); PG8_STAGE(PG8_SA(1, 0), a3, s0);
            PG8_WAIT_V(8); PG8_WAIT_L(0); PG8_BAR; PG8_MMA(1, 0, At, B0); PG8_MMA(1, 1, At, B1); PG8_BAR; PG8_SCHED;
            } else {
            PG8_LDB(B0, 0, 0); PG8_SCHED; PG8_LDA(At, 0, 0); PG8_STAGE(PG8_SA(1, 1), a1 + hstepA, voffA);
            PG8_WAIT_L(8); PG8_BAR; PG8_WAIT_L(0); PG8_MMA(0, 0, At, B0); PG8_BAR; PG8_SCHED;
            PG8_LDB(B1, 0, 1); PG8_STAGE(PG8_SB(0, 0), b2, voffB);
            PG8_BAR; PG8_WAIT_L(0); PG8_MMA(0, 1, At, B1); PG8_BAR;
            PG8_LDA(At, 0, 1); PG8_STAGE(PG8_SA(0, 0), a2, voffA);
            PG8_BAR; PG8_WAIT_L(0); PG8_MMA(1, 0, At, B0); PG8_BAR; PG8_SCHED;
            PG8_STAGE(PG8_SB(0, 1), b2 + hstepB, voffB);
            PG8_WAIT_V(6); PG8_BAR; PG8_MMA(1, 1, At, B1); PG8_BAR;
            PG8_LDB(B0, 1, 0); PG8_SCHED; PG8_LDA(At, 1, 0); PG8_STAGE(PG8_SA(0, 1), a2 + hstepA, voffA);
            PG8_WAIT_L(8); PG8_BAR; PG8_WAIT_L(0); PG8_MMA(0, 0, At, B0); PG8_BAR; PG8_SCHED;
            PG8_LDB(B1, 1, 1); PG8_STAGE(PG8_SB(1, 0), b3, voffB);
            PG8_BAR; PG8_WAIT_L(0); PG8_MMA(0, 1, At, B1); PG8_BAR;
            PG8_LDA(At, 1, 1); PG8_STAGE(PG8_SA(1, 0), a3, voffA);
            PG8_BAR; PG8_WAIT_L(0); PG8_MMA(1, 0, At, B0); PG8_BAR; PG8_SCHED;
            PG8_STAGE(PG8_SB(1, 1), b3 + hstepB, voffB);
            PG8_WAIT_V(6); PG8_BAR; PG8_MMA(1, 1, At, B1); PG8_BAR;
            }
        }
        if constexpr (ALIGN_EPI) { if (wr == 0) PG8_BAR; }
        if constexpr (FP8) asm volatile("s_nop 7\n\ts_nop 7\n\ts_nop 3" ::: "memory");
        E(acc, cur, wr, wc, fr, fq); S.done(cur);
        if (!has_next) break;
#pragma unroll
        for (int a = 0; a < 2; ++a)
#pragma unroll
            for (int b = 0; b < 2; ++b)
#pragma unroll
                for (int m = 0; m < 4; ++m)
#pragma unroll
                    for (int n = 0; n < 2; ++n) acc[a][b][m][n] = (f32x4){0.f, 0.f, 0.f, 0.f};
        cur = nxt; cA = nA; cB = nB; ++ui;
        if constexpr (GATHER) {
#pragma unroll
            for (int i = 0; i < 2; ++i) { gc0[i] = (unsigned)gn0r[i] * (unsigned)(g.lda * ESZ) + gC2[i]; gc1[i] = (unsigned)gn1r[i] * (unsigned)(g.lda * ESZ) + gC2[i]; } }
        if constexpr (ALIGN_EPI) { if (wr == 1) PG8_BAR; }
    }
    PG8_WAIT_V(0);
    if constexpr (!ALIGN_EPI) { if (wr == 0) PG8_BAR; }
    PG8_BAR;
#undef PG8_SA
#undef PG8_SB
#undef PG8_STAGE
#undef PG8_LDA
#undef PG8_LDB
#undef PG8_MMA
#undef PG8_CAT
#undef PG8_WAIT_V
#undef PG8_WAIT_L
#undef PG8_BAR
#undef PG8_SCHED
}
}
using pg8::Unit;

#define XB_TMO      128
#define XB_XCNT(j)  (256  + 64 * (j))
#define XB_XSUB(j)  (1280 + 64 * (j))
#define XB_XGEN(j)  (2304 + 64 * (j))
#define XB_TOP      3328
#define XB_TOPGEN   3392
#define XCD_BAR_WORDS 3456
#define XB_SPIN_CAP (1u << 18)

__device__ __forceinline__ unsigned xb_ld(unsigned* p)              { return __hip_atomic_load(p, __ATOMIC_RELAXED, __HIP_MEMORY_SCOPE_AGENT); }
__device__ __forceinline__ unsigned xb_add(unsigned* p, unsigned v) { return __hip_atomic_fetch_add(p, v, __ATOMIC_RELAXED, __HIP_MEMORY_SCOPE_AGENT); }
__device__ __forceinline__ unsigned xb_xcc_id() { return (unsigned)__builtin_amdgcn_s_getreg((3 << 11) | 20) & 0xFu; }
#define XB_SPIN(cond, bar) do { unsigned _sp = 0; while (cond) { __builtin_amdgcn_s_sleep(1); \
    if ((++_sp & 255u) == 0u) { if (xb_ld(&(bar)[XB_TMO])) break; if (_sp > XB_SPIN_CAP) { atomicAdd(&(bar)[XB_TMO], 1u); break; } } } } while (0)

struct XcdBarrier {
    unsigned* bar; unsigned x;
    volatile LAS unsigned* st;
};

__device__ __forceinline__ XcdBarrier xcd_barrier_post(unsigned* bar, volatile LAS unsigned* st) {
    XcdBarrier b; b.bar = bar; b.x = xb_xcc_id(); b.st = st;
    if (threadIdx.x == 0) (void)xb_add(&bar[XB_XCNT(b.x)], 1u);
    return b;
}
__device__ __forceinline__ void xcd_barrier_complete(unsigned* bar, unsigned x, unsigned& nloc, unsigned& nx) {
    const unsigned G = gridDim.x * gridDim.y * gridDim.z;
    unsigned sum, cnt, mine, sp = 0u;
    for (;;) {
        sum = 0u; cnt = 0u; mine = 0u;
#pragma unroll
        for (unsigned j = 0; j < 16; ++j) { const unsigned c = xb_ld(&bar[XB_XCNT(j)]); sum += c; cnt += (c > 0u) ? 1u : 0u; mine = (j == x) ? c : mine; }
        if (sum == G) break;
        __builtin_amdgcn_s_sleep(1);
        if ((++sp & 255u) == 0u) { if (xb_ld(&bar[XB_TMO])) break; if (sp > XB_SPIN_CAP) { atomicAdd(&bar[XB_TMO], 1u); break; } }
    }
    nloc = mine > 0u ? mine : 1u; nx = cnt > 0u ? cnt : 1u;
}

__device__ __forceinline__ void xcd_barrier(const XcdBarrier& b) {
    asm volatile("s_waitcnt vmcnt(0)" ::: "memory");
    __syncthreads();
    if (threadIdx.x == 0) {
        unsigned* bar = b.bar;
        __builtin_amdgcn_s_waitcnt(0);
        unsigned nloc = b.st[0], nx = b.st[1];
        if (nloc == 0u) { xcd_barrier_complete(bar, b.x, nloc, nx); b.st[0] = nloc; b.st[1] = nx; }
        const unsigned old = xb_add(&bar[XB_XSUB(b.x)], 1u);
        const unsigned gen = old / nloc;
        if (old + 1u == (gen + 1u) * nloc) {
            __builtin_amdgcn_fence(__ATOMIC_RELEASE, "agent");
            asm volatile("s_waitcnt vmcnt(0)" ::: "memory");
            const unsigned og = xb_add(&bar[XB_TOP], 1u);
            const unsigned tg = og / nx;
            if (og + 1u == (tg + 1u) * nx) xb_add(&bar[XB_TOPGEN], 1u);
            else XB_SPIN(xb_ld(&bar[XB_TOPGEN]) == tg, bar);
            __builtin_amdgcn_fence(__ATOMIC_ACQUIRE, "agent");
            xb_add(&bar[XB_XGEN(b.x)], 1u);
            asm volatile("s_waitcnt vmcnt(0)" ::: "memory");
        } else {
            XB_SPIN(xb_ld(&bar[XB_XGEN(b.x)]) == gen, bar);
            __builtin_amdgcn_fence(__ATOMIC_ACQUIRE, "agent");
            asm volatile("s_waitcnt vmcnt(0)" ::: "memory");
        }
    }
    __syncthreads();
}

__device__ __forceinline__ unsigned pk4_fp8(float a, float b, float c, float d) { int w = 0; w = __builtin_amdgcn_cvt_pk_fp8_f32(a, b, w, false); w = __builtin_amdgcn_cvt_pk_fp8_f32(c, d, w, true); return (unsigned)w; }
#define EPI_SIG const f32x4 (&acc)[2][2][4][2], const Unit& u, int wr, int wc, int fr, int fq
struct EpiZ { static constexpr bool PERM = true; bf16* ZB; float* ZF;
    __device__ __forceinline__ void operator()(EPI_SIG) const {
        const int row0 = u.pm * 256 + wr * 64 + fr;
        if (u.pn < 11) {
            const int col0 = u.pn * 256 + wc * 32 + 8 * fq;
#pragma unroll
            for (int ai = 0; ai < 2; ++ai)
#pragma unroll
                for (int m = 0; m < 4; ++m) { bf16* rowp = ZB + (size_t)(row0 + ai * 128 + m * 16) * NZB + col0;
#pragma unroll
                    for (int bj = 0; bj < 2; ++bj) { const f32x4 v0 = acc[ai][bj][m][0], v1 = acc[ai][bj][m][1]; v4u w; w.x = cvt_pk_bf16(v0[0], v0[1]); w.y = cvt_pk_bf16(v0[2], v0[3]); w.z = cvt_pk_bf16(v1[0], v1[1]); w.w = cvt_pk_bf16(v1[2], v1[3]);
                        *(v4u*)(rowp + bj * 128) = w; } }
        } else {
            const int col0 = (u.pn - 11) * 256 + wc * 32 + 8 * fq;
#pragma unroll
            for (int ai = 0; ai < 2; ++ai)
#pragma unroll
                for (int m = 0; m < 4; ++m) { float* rowp = ZF + (size_t)(row0 + ai * 128 + m * 16) * NZF + col0;
#pragma unroll
                    for (int bj = 0; bj < 2; ++bj) { *(f32x4*)(rowp + bj * 128) = acc[ai][bj][m][0]; *(f32x4*)(rowp + bj * 128 + 4) = acc[ai][bj][m][1]; } }
        }
    }
};
struct EpiBf { static constexpr bool PERM = true; bf16* O; int ldc; const float* roww;
    __device__ __forceinline__ void operator()(EPI_SIG) const {
        const int row0 = u.pm * 256 + wr * 64 + fr, col0 = u.pn * 256 + wc * 32 + 8 * fq;
#pragma unroll
        for (int ai = 0; ai < 2; ++ai)
#pragma unroll
            for (int m = 0; m < 4; ++m) { const int row = row0 + ai * 128 + m * 16; const float s = roww ? roww[row] : 1.0f; bf16* rowp = O + (size_t)row * ldc + col0;
#pragma unroll
                for (int bj = 0; bj < 2; ++bj) { const f32x4 v0 = acc[ai][bj][m][0] * s, v1 = acc[ai][bj][m][1] * s; v4u w; w.x = cvt_pk_bf16(v0[0], v0[1]); w.y = cvt_pk_bf16(v0[2], v0[3]); w.z = cvt_pk_bf16(v1[0], v1[1]); w.w = cvt_pk_bf16(v1[2], v1[3]);
                    *(v4u*)(rowp + bj * 128) = w; } }
    }
};
struct EpiFour1 { static constexpr bool PERM = true; bf16* VTL; bf16* VTC;
    __device__ __forceinline__ void operator()(EPI_SIG) const {
        bf16* base; int ldc;
        if (u.pn < 128) { const int b = u.pn >> 3, t0 = (u.pn & 7) * 256; base = VTL + (size_t)b * 256 * 4096 + u.pm * 2048 + t0; ldc = 4096; }
        else { const int b = u.pn - 128; base = VTC + (size_t)b * 256 * 512 + u.pm * 256; ldc = 512; }
        const int r0 = wr * 64 + fr, col0 = wc * 32 + 8 * fq;
#pragma unroll
        for (int ai = 0; ai < 2; ++ai)
#pragma unroll
            for (int m = 0; m < 4; ++m) { bf16* rowp = base + (size_t)(r0 + ai * 128 + m * 16) * ldc + col0;
#pragma unroll
                for (int bj = 0; bj < 2; ++bj) { const f32x4 v0 = acc[ai][bj][m][0], v1 = acc[ai][bj][m][1]; v4u w; w.x = cvt_pk_bf16(v0[0], v0[1]); w.y = cvt_pk_bf16(v0[2], v0[3]); w.z = cvt_pk_bf16(v1[0], v1[1]); w.w = cvt_pk_bf16(v1[2], v1[3]);
                    *(v4u*)(rowp + bj * 128) = w; } }
    }
};
struct EpiF32 { static constexpr bool PERM = false; float* C; int ldc;
    __device__ __forceinline__ void operator()(EPI_SIG) const {
        const int row0 = u.pm * 256 + wr * 64 + fr, col0 = u.pn * 256 + wc * 32 + 4 * fq;
#pragma unroll
        for (int ai = 0; ai < 2; ++ai)
#pragma unroll
            for (int m = 0; m < 4; ++m) { float* rowp = C + (size_t)(row0 + ai * 128 + m * 16) * ldc + col0;
#pragma unroll
                for (int bj = 0; bj < 2; ++bj)
#pragma unroll
                    for (int n = 0; n < 2; ++n) *(f32x4*)(rowp + bj * 128 + n * 16) = acc[ai][bj][m][n]; }
    }
};
struct EpiFourT { static constexpr bool PERM = false; float* FO; int ctx;
    __device__ __forceinline__ void operator()(EPI_SIG) const {
        float* base = ctx ? FO + (size_t)(ML + u.pn * 256) * 256 : FO + (size_t)(u.pn & 1) * MT * 256 + (size_t)((u.pn >> 1) * 2048 + u.pm * 256) * 256;
        const int r0 = wr * 64 + fr, col0 = wc * 32 + 4 * fq;
#pragma unroll
        for (int ai = 0; ai < 2; ++ai)
#pragma unroll
            for (int m = 0; m < 4; ++m) { float* rowp = base + (size_t)(r0 + ai * 128 + m * 16) * 256 + col0;
#pragma unroll
                for (int bj = 0; bj < 2; ++bj)
#pragma unroll
                    for (int n = 0; n < 2; ++n) *(f32x4*)(rowp + bj * 128 + n * 16) = acc[ai][bj][m][n]; }
    }
};
struct EpiP { static constexpr bool PERM = true; bf16* P2;
    __device__ __forceinline__ void operator()(EPI_SIG) const {
        const int g = u.pn >> 2, ct = u.pn & 3;
#pragma unroll
        for (int ai = 0; ai < 2; ++ai)
#pragma unroll
            for (int m = 0; m < 4; ++m)
#pragma unroll
                for (int bj = 0; bj < 2; ++bj) { const int pn = ct * 4 + bj * 2 + (wc >> 1), wave_m = wr * 4 + (wc & 1) * 2 + (fq >> 1);
#pragma unroll
                    for (int n = 0; n < 2; ++n) { const int lane_m = ((fq & 1) * 2 + n) * 16 + fr; const f32x4 v = acc[ai][bj][m][n];
                        v2u w; w.x = cvt_pk_bf16(v[0], v[1]); w.y = cvt_pk_bf16(v[2], v[3]);
                        *(v2u*)(P2 + ((((((size_t)u.pm * 16 + pn) * 2 + ai) * 4 + m) * 8 + wave_m) * 4 + g) * 256 + lane_m * 4) = w; } }
    }
};
struct EpiMerge { static constexpr bool PERM = false; const bf16* P; bf16* T; const float* bg;
    __device__ __forceinline__ void operator()(EPI_SIG) const {
        const int row0 = u.pm * 256 + wr * 64 + fr, oc = u.pn * 64 + wc * 16 + 4 * fq;
        f32x4 bv[4];
#pragma unroll
        for (int g = 0; g < 4; ++g) bv[g] = *(const f32x4*)(bg + g * 1024 + oc);
#pragma unroll
        for (int ai = 0; ai < 2; ++ai)
#pragma unroll
            for (int m = 0; m < 4; ++m) { const int row = row0 + ai * 128 + m * 16; const bf16* prow = P + (((((size_t)u.pm * 16 + u.pn) * 2 + ai) * 4 + m) * 8 + (wr * 4 + wc)) * 1024 + (fq * 16 + fr) * 4;
                v2u pw[4];
#pragma unroll
                for (int g = 0; g < 4; ++g) pw[g] = *(const v2u*)(prow + g * 256);
                f32x4 t = (f32x4){0.f, 0.f, 0.f, 0.f};
#pragma unroll
                for (int bj = 0; bj < 2; ++bj)
#pragma unroll
                    for (int n = 0; n < 2; ++n) { const int g = 2 * bj + n; const f32x4 a = acc[ai][bj][m][n] + bv[g];
                        t[0] += sigmoid_fast(a[0]) * bf2f(pw[g].x & 0xffffu); t[1] += sigmoid_fast(a[1]) * bf2f(pw[g].x >> 16);
                        t[2] += sigmoid_fast(a[2]) * bf2f(pw[g].y & 0xffffu); t[3] += sigmoid_fast(a[3]) * bf2f(pw[g].y >> 16); }
                v2u w; w.x = cvt_pk_bf16(t[0], t[1]); w.y = cvt_pk_bf16(t[2], t[3]);
                *(v2u*)(T + (size_t)row * 1024 + oc) = w; }
    }
};
struct EpiSwiGLU { static constexpr bool PERM = true; unsigned char* HID;
    __device__ __forceinline__ void operator()(EPI_SIG) const {
        const int row0 = u.pm * 256 + wr * 64 + fr, col0 = u.pn * 128 + wc * 32 + 8 * fq;
#pragma unroll
        for (int ai = 0; ai < 2; ++ai)
#pragma unroll
            for (int m = 0; m < 4; ++m) { unsigned char* rowp = HID + (size_t)(row0 + ai * 128 + m * 16) * 1024 + col0; float o[8];
#pragma unroll
                for (int n = 0; n < 2; ++n)
#pragma unroll
                    for (int j = 0; j < 4; ++j) { const float gv = acc[ai][0][m][n][j], uv = acc[ai][1][m][n][j]; o[4 * n + j] = fminf(fmaxf(gv * sigmoid_fast(gv) * uv, -448.f), 448.f); }
                v2u w; w.x = pk4_fp8(o[0], o[1], o[2], o[3]); w.y = pk4_fp8(o[4], o[5], o[6], o[7]);
                *(v2u*)rowp = w; }
    }
};
struct EpiZB { static constexpr bool PERM = true; bf16* O;
    __device__ __forceinline__ void operator()(EPI_SIG) const {
        const int row0 = u.pm * 256 + wr * 64 + fr, col0 = u.pn * 256 + wc * 32 + 8 * fq; const bool sl = (u.pn == 0);
#pragma unroll
        for (int ai = 0; ai < 2; ++ai)
#pragma unroll
            for (int m = 0; m < 4; ++m) { bf16* rowp = O + (size_t)(row0 + ai * 128 + m * 16) * NZB + col0;
#pragma unroll
                for (int bj = 0; bj < 2; ++bj) { f32x4 v0 = acc[ai][bj][m][0], v1 = acc[ai][bj][m][1];
                    if (sl) {
#pragma unroll
                        for (int t = 0; t < 4; ++t) { v0[t] *= sigmoid_fast(v0[t]); v1[t] *= sigmoid_fast(v1[t]); } }
                    v4u w; w.x = cvt_pk_bf16(v0[0], v0[1]); w.y = cvt_pk_bf16(v0[2], v0[3]); w.z = cvt_pk_bf16(v1[0], v1[1]); w.w = cvt_pk_bf16(v1[2], v1[3]);
                    *(v4u*)(rowp + bj * 128) = w; } }
    }
};
struct EpiZF { static constexpr bool PERM = false; float* C; const float* lb;
    __device__ __forceinline__ void operator()(EPI_SIG) const {
        const int row0 = u.pm * 256 + wr * 64 + fr, cc = wc * 32 + 4 * fq;
        f32x4 lbv[2][2];
#pragma unroll
        for (int bj = 0; bj < 2; ++bj)
#pragma unroll
            for (int n = 0; n < 2; ++n) lbv[bj][n] = (u.pn < 2) ? *(const f32x4*)(lb + u.pn * 1024 + cc + bj * 128 + n * 16) : (f32x4){0.f, 0.f, 0.f, 0.f};
#pragma unroll
        for (int ai = 0; ai < 2; ++ai)
#pragma unroll
            for (int m = 0; m < 4; ++m) { float* rowp = C + (size_t)(row0 + ai * 128 + m * 16) * NZF + u.pn * 256 + cc;
#pragma unroll
                for (int bj = 0; bj < 2; ++bj)
#pragma unroll
                    for (int n = 0; n < 2; ++n) { f32x4 v = acc[ai][bj][m][n];
                        if (u.pn < 2) {
#pragma unroll
                            for (int t = 0; t < 4; ++t) v[t] = __logf(fmaxf(lbv[bj][n][t] + (1.0f - lbv[bj][n][t]) * sigmoid_fast(v[t]), 1e-30f)); }
                        if (u.pn < 2 || (bj == 0 && wc == 0 && (n == 0 || fq < 2))) *(f32x4*)(rowp + bj * 128 + n * 16) = v; } }
    }
};
struct EpiF8 { static constexpr bool PERM = true; unsigned char* O; const float* roww;
    __device__ __forceinline__ void operator()(EPI_SIG) const {
        const int row0 = u.pm * 256 + wr * 64 + fr, col0 = u.pn * 256 + wc * 32 + 8 * fq;
#pragma unroll
        for (int ai = 0; ai < 2; ++ai)
#pragma unroll
            for (int m = 0; m < 4; ++m) { const int row = row0 + ai * 128 + m * 16; const float s = roww[row] * 64.0f; unsigned char* rowp = O + (size_t)row * 1024 + col0;
#pragma unroll
                for (int bj = 0; bj < 2; ++bj) { const f32x4 v0 = acc[ai][bj][m][0] * s, v1 = acc[ai][bj][m][1] * s; v2u w;
                    w.x = pk4_fp8(fminf(fmaxf(v0[0], -448.f), 448.f), fminf(fmaxf(v0[1], -448.f), 448.f), fminf(fmaxf(v0[2], -448.f), 448.f), fminf(fmaxf(v0[3], -448.f), 448.f));
                    w.y = pk4_fp8(fminf(fmaxf(v1[0], -448.f), 448.f), fminf(fmaxf(v1[1], -448.f), 448.f), fminf(fmaxf(v1[2], -448.f), 448.f), fminf(fmaxf(v1[3], -448.f), 448.f));
                    *(v2u*)(rowp + bj * 128) = w; } }
    }
};
struct MapPlain { const char* A; const char* B; size_t sa, sb; __device__ __forceinline__ void operator()(Unit& u) const { u.A = A + (size_t)u.pm * sa; u.B = B + (size_t)u.pn * sb; } };
struct MapP { const char* OUTS; const char* WBR; __device__ __forceinline__ void operator()(Unit& u) const { const int g = u.pn >> 2; u.A = OUTS + (size_t)u.pm * (256 * 1024 * 2) + g * 512; u.B = WBR + (size_t)g * (1024 * 256 * 2) + (size_t)(u.pn & 3) * (256 * 256 * 2); } };
struct MapFourT { const char* DFTL; const char* VTL; __device__ __forceinline__ void operator()(Unit& u) const { const int kh = u.pn & 1; u.A = DFTL + (size_t)u.pm * (256 * 4096 * 2) + kh * 4096; u.B = VTL + (size_t)(u.pn >> 1) * (256 * 4096 * 2) + kh * 4096; } };
struct MapMoE { const char* A; const char* W; size_t se, st; __device__ __forceinline__ void operator()(Unit& u) const { const int e = u.pm < 256 ? (u.pm >> 4) : ((u.pm - 256) >> 1); u.A = A + (size_t)u.pm * st; u.B = W + (size_t)e * se + (size_t)u.pn * st; } };
struct MapMoEG { const char* A; const char* W; size_t se, st; __device__ __forceinline__ void operator()(Unit& u) const { const int e = u.pm < 256 ? (u.pm >> 4) : ((u.pm - 256) >> 1); u.A = A; u.B = W + (size_t)e * se + (size_t)u.pn * st; } };
struct Args { const float* in[31]; float* out; unsigned char* ws; int ph_lo, ph_hi, li, pad; };
enum { I_X = 0, I_C, I_CTX, I_CCTX, I_ADAW, I_ADAB, I_WIN, I_LBLOG, I_HGRN_NW, I_GDN_CW, I_GDN_ALOG, I_GDN_DTB, I_GDN_NW, I_SSD_CW, I_SSD_CB, I_SSD_ALOG, I_SSD_DTB, I_SSD_D, I_SSD_NW,
       I_WGATE, I_BGATE, I_WBR, I_WOUT, I_LN1G, I_LN1B, I_WROUTER, I_WFFG, I_WFFU, I_WFFD, I_LN2G, I_LN2B };
struct WCtx { int tid, lane, wave, bid, G, gw, NGW; };

__device__ __forceinline__ float dpp_xor1(float x) { return __int_as_float(__builtin_amdgcn_mov_dpp(__float_as_int(x), 0xB1, 0xf, 0xf, true)); }
__device__ __forceinline__ float dpp_xor2(float x) { return __int_as_float(__builtin_amdgcn_mov_dpp(__float_as_int(x), 0x4E, 0xf, 0xf, true)); }
__device__ __forceinline__ int zrow(int n) {
    if (n < 256) return n;
    if (n < 512) return 11 * 256 + (n - 256);
    if (n < 768) return 12 * 256 + (n - 512);
    if (n < 1024) return 1 * 256 + (n - 768);
    if (n < 1280) return 2 * 256 + (n - 1024);
    if (n < 2048) return 3 * 256 + (n - 1280);
    if (n < 2304) return 6 * 256 + (n - 2048);
    if (n < 2312) return 13 * 256 + (n - 2304);
    if (n < 2320) return 13 * 256 + 8 + (n - 2312);
    if (n < 2576) return 7 * 256 + (n - 2320);
    if (n < 3088) return 8 * 256 + (n - 2576);
    if (n < 3344) return 10 * 256 + (n - 3088);
    return 13 * 256 + 16 + (n - 3344);
}
__device__ __forceinline__ int rowmap(int mode, int aux, int n) {
    if (mode == 0) return n;
    if (mode == 1) return zrow(n);
    if (mode == 2) return 256 * (n >> 6) + 128 * (aux >> 1) + 32 * ((n & 63) >> 4) + 16 * (aux & 1) + (n & 15);
    if (mode == 3) return 256 * (n >> 7) + (n & 127);
    return 256 * (n >> 7) + 128 + (n & 127);
}
__device__ __forceinline__ void transpose_item(const float* W, int N, bf16* WT, int ldt, LAS unsigned* scr, int item, int lane, int mode, int aux) {
    const int nblk = (N + 63) >> 6, kb = item / nblk, nb = item - kb * nblk, k0 = 64 * kb, n0 = 64 * nb;
    const int ncol = n0 + lane; const bool okc = ncol < N;
    const float* wp = W + (size_t)k0 * N + (okc ? ncol : 0);
    float v[64];
#pragma unroll
    for (int i = 0; i < 64; ++i) v[i] = wp[(size_t)i * N];
#pragma unroll
    for (int i = 0; i < 32; ++i) scr[i * 65 + lane] = okc ? pk2(v[2 * i], v[2 * i + 1]) : 0u;
    LDS_WAIT();
    const int c = lane & 7;
#pragma unroll
    for (int j = 0; j < 8; ++j) { const int nn = (lane >> 3) + 8 * j, n = n0 + nn;
        v4u o; o.x = scr[(4 * c + 0) * 65 + nn]; o.y = scr[(4 * c + 1) * 65 + nn]; o.z = scr[(4 * c + 2) * 65 + nn]; o.w = scr[(4 * c + 3) * 65 + nn];
        if (n < N) *(v4u*)(WT + (size_t)rowmap(mode, aux, n) * ldt + k0 + 8 * c) = o; }
    LDS_WAIT();
}
__device__ __forceinline__ void transpose_item8(const float* W, int N, unsigned char* WT, int ldt, int item, int lane, int mode, int aux) {
    const int nblk = (N + 63) >> 6, kb = item / nblk, nb = item - kb * nblk, k0 = 64 * kb, n0 = 64 * nb;
    const int ncol = n0 + lane;
    const float* wp = W + (size_t)k0 * N + ncol;
    float v[64];
#pragma unroll
    for (int i = 0; i < 64; ++i) v[i] = wp[(size_t)i * N];
    unsigned o[16];
#pragma unroll
    for (int q = 0; q < 16; ++q) o[q] = pk4_fp8(fminf(fmaxf(v[4 * q] * 64.f, -448.f), 448.f), fminf(fmaxf(v[4 * q + 1] * 64.f, -448.f), 448.f), fminf(fmaxf(v[4 * q + 2] * 64.f, -448.f), 448.f), fminf(fmaxf(v[4 * q + 3] * 64.f, -448.f), 448.f));
    v4u* dst = (v4u*)(WT + (size_t)rowmap(mode, aux, ncol) * ldt + k0);
#pragma unroll
    for (int q = 0; q < 4; ++q) dst[q] = (v4u){o[4 * q], o[4 * q + 1], o[4 * q + 2], o[4 * q + 3]};
}
constexpr int WI_IN = 16 * 53, WI_G = 4 * 256, WI_BR = 4 * 64, WI_OUT = 256, WI_FF = 16 * 256;
constexpr int WI_REST = WI_G + WI_BR + WI_OUT + 3 * WI_FF;
constexpr int WI_XA = 9216, WI_XB = 10368;
__device__ __forceinline__ void convert_win(const Args& a, LAS unsigned char* lds, int wave, int lane, int gw, int ngw, int l) {
    LAS unsigned* scr = (LAS unsigned*)(lds + wave * 8448);
    for (int it = gw; it < WI_IN; it += ngw) transpose_item(a.in[I_WIN] + (size_t)l * 1024 * IN_COLS, IN_COLS, (bf16*)(a.ws + WS_WIN), 1024, scr, it, lane, 1, 0);
}
__device__ __forceinline__ void convert_rest(const Args& a, LAS unsigned char* lds, int wave, int lane, int gw, int ngw, int l, int it0, int it1) {
    LAS unsigned* scr = (LAS unsigned*)(lds + wave * 8448);
    unsigned char* ws = a.ws;
    for (int it = it0 + gw; it < it1; it += ngw) {
        int r = it;
        if (r < WI_G) { const int g = r >> 8; transpose_item8(a.in[I_WGATE] + (size_t)(l * 4 + g) * 1024 * 1024, 1024, ws + WS_WG, 1024, r & 255, lane, 2, g); continue; } r -= WI_G;
        if (r < WI_BR) { const int g = r >> 6; transpose_item(a.in[I_WBR] + (size_t)(l * 4 + g) * 256 * 1024, 1024, (bf16*)(ws + WS_WBR) + (size_t)g * 1024 * 256, 256, scr, r & 63, lane, 0, 0); continue; } r -= WI_BR;
        if (r < WI_OUT) { transpose_item(a.in[I_WOUT] + (size_t)l * 1024 * 1024, 1024, (bf16*)(ws + WS_WOUT), 1024, scr, r, lane, 0, 0); continue; } r -= WI_OUT;
        if (r < WI_FF) { const int e = r >> 8; transpose_item8(a.in[I_WFFG] + (size_t)(l * 16 + e) * 1024 * 1024, 1024, ws + WS_WGU + (size_t)e * 2048 * 1024, 1024, r & 255, lane, 3, 0); continue; } r -= WI_FF;
        if (r < WI_FF) { const int e = r >> 8; transpose_item8(a.in[I_WFFU] + (size_t)(l * 16 + e) * 1024 * 1024, 1024, ws + WS_WGU + (size_t)e * 2048 * 1024, 1024, r & 255, lane, 4, 0); continue; } r -= WI_FF;
        { const int e = r >> 8; transpose_item8(a.in[I_WFFD] + (size_t)(l * 16 + e) * 1024 * 1024, 1024, ws + WS_WDN + (size_t)e * 1024 * 1024, 1024, r & 255, lane, 0, 0); }
    }
}

__device__ __forceinline__ void row_load(const float* p, int lane, f32x4 (&v)[4]) { const f32x4* xr = (const f32x4*)p + lane;
#pragma unroll
    for (int j = 0; j < 4; ++j) v[j] = xr[64 * j]; }
__device__ __forceinline__ void row_store(float* p, int lane, const f32x4 (&v)[4]) { f32x4* xr = (f32x4*)p + lane;
#pragma unroll
    for (int j = 0; j < 4; ++j) xr[64 * j] = v[j]; }
__device__ __forceinline__ void ln_stats(const f32x4 (&v)[4], float& mean, float& rstd) {
    float s = 0.f;
#pragma unroll
    for (int j = 0; j < 4; ++j) s += (v[j][0] + v[j][1]) + (v[j][2] + v[j][3]);
    mean = wave_sum(s) * (1.f / 1024.f); float q = 0.f;
#pragma unroll
    for (int j = 0; j < 4; ++j) { const f32x4 d = v[j] - mean; q += (d[0] * d[0] + d[1] * d[1]) + (d[2] * d[2] + d[3] * d[3]); }
    rstd = 1.0f / sqrtf(wave_sum(q) * (1.f / 1024.f) + LN_EPS);
}
__device__ __forceinline__ unsigned pk4c_fp8(f32x4 v) { return pk4_fp8(fminf(fmaxf(v[0], -448.f), 448.f), fminf(fmaxf(v[1], -448.f), 448.f), fminf(fmaxf(v[2], -448.f), 448.f), fminf(fmaxf(v[3], -448.f), 448.f)); }
__device__ __forceinline__ void modulate_row(const f32x4 (&v)[4], const float* sh, const float* sc, bf16* hrow, unsigned* h8row, int lane, f32x4 (&hv)[4]) {
    float mean, rstd; ln_stats(v, mean, rstd);
#pragma unroll
    for (int j = 0; j < 4; ++j) { const f32x4 s = *((const f32x4*)sc + lane + 64 * j), t = *((const f32x4*)sh + lane + 64 * j);
        hv[j] = (v[j] - mean) * rstd * (s + 1.0f) + t;
        v2u w; w.x = cvt_pk_bf16(hv[j][0], hv[j][1]); w.y = cvt_pk_bf16(hv[j][2], hv[j][3]); *((v2u*)hrow + lane + 64 * j) = w; h8row[lane + 64 * j] = pk4c_fp8(hv[j]); }
}
__device__ __forceinline__ const float* mod_ptr(const Args& a, int l, int row, int chunk) { const int r = row < ML ? (row >> 11) : 16; return (const float*)(a.ws + WS_MOD) + ((size_t)(l * 17 + r) * 6144 + chunk * 1024); }

__device__ __forceinline__ void phase_prologue(const Args& a, LAS unsigned char* lds, const WCtx& w) {
    {
        LAS float* SC = (LAS float*)lds; LAS float* RED = (LAS float*)(lds + 17 * 1024 * 4);
        for (int i = w.tid; i < 17 * 1024; i += NTHREADS) { const int r = i >> 10, k = i & 1023; const float v = r < 16 ? a.in[I_C][r * 1024 + k] : a.in[I_CCTX][k]; SC[i] = silu_acc(v); }
        __syncthreads();
        float* MOD = (float*)(a.ws + WS_MOD);
        for (int it = w.bid; it < 4 * 96; it += w.G) {
            const int l = it / 96, cg = it - l * 96;
            const float* wp = a.in[I_ADAW] + (size_t)l * 1024 * 6144 + cg * 64 + w.lane;
            float acc[17];
#pragma unroll
            for (int r = 0; r < 17; ++r) acc[r] = 0.f;
            const int k0 = w.wave * 128;
            const float* wq = wp + (size_t)k0 * 6144;
            float a0 = wq[0], a1 = wq[6144], a2 = wq[2 * 6144], a3 = wq[3 * 6144], b0 = wq[4 * 6144], b1 = wq[5 * 6144], b2 = wq[6 * 6144], b3 = wq[7 * 6144];
#pragma unroll 1
            for (int k = k0; k < k0 + 128; k += 4) {
                const float w0 = a0, w1 = a1, w2 = a2, w3 = a3; a0 = b0; a1 = b1; a2 = b2; a3 = b3;
                if (k + 8 < k0 + 128) { const float* wn = wp + (size_t)(k + 8) * 6144; b0 = wn[0]; b1 = wn[6144]; b2 = wn[2 * 6144]; b3 = wn[3 * 6144]; }
#pragma unroll
                for (int r = 0; r < 17; ++r) { const f32x4 s = *(const LAS f32x4*)(SC + r * 1024 + k); acc[r] += (s[0] * w0 + s[1] * w1) + (s[2] * w2 + s[3] * w3); }
            }
#pragma unroll
            for (int r = 0; r < 17; ++r) RED[(w.wave * 17 + r) * 64 + w.lane] = acc[r];
            __syncthreads();
            for (int i = w.tid; i < 17 * 64; i += NTHREADS) { const int r = i >> 6, col = i & 63; float s = 0.f;
#pragma unroll
                for (int q = 0; q < 8; ++q) s += RED[(q * 17 + r) * 64 + col];
                MOD[(size_t)(l * 17 + r) * 6144 + cg * 64 + col] = s + a.in[I_ADAB][l * 6144 + cg * 64 + col]; }
            __syncthreads();
        }
    }
    {
        float* X = (float*)(a.ws + WS_X);
        float om[4];
#pragma unroll
        for (int e = 0; e < 4; ++e) om[e] = 1.0f / powf(10000.0f, (float)(4 * w.lane + e) * (1.0f / 256.0f));
        int tcur = -1; f32x4 pos[4];
#pragma unroll
        for (int j = 0; j < 4; ++j) pos[j] = (f32x4){0.f, 0.f, 0.f, 0.f};
        for (int row = w.gw; row < MT; row += w.NGW) {
            f32x4 v[4];
            if (row < ML) { row_load(a.in[I_X] + (size_t)row * 1024, w.lane, v); const int t = row & 2047;
                if (t != tcur) { tcur = t; const float pr = (float)(t >> 6), pc = (float)(t & 63);
#pragma unroll
                    for (int e = 0; e < 4; ++e) { pos[0][e] = sinf(pr * om[e]); pos[1][e] = cosf(pr * om[e]); pos[2][e] = sinf(pc * om[e]); pos[3][e] = cosf(pc * om[e]); } }
#pragma unroll
                for (int j = 0; j < 4; ++j) v[j] += pos[j]; }
            else row_load(a.in[I_CTX] + (size_t)(row - ML) * 1024, w.lane, v);
            row_store(X + (size_t)row * 1024, w.lane, v);
        }
    }
    {
        { float* TWg = (float*)(a.ws + WS_LB + 65536);
          for (int i = w.bid * NTHREADS + w.tid; i < 1024; i += w.G * NTHREADS) { float s, c; sincospif((float)i * (1.0f / 1024.0f), &s, &c); TWg[2 * i] = c; TWg[2 * i + 1] = -s; } }
        bf16* D6 = (bf16*)(a.ws + WS_DFT64);
        for (int i = w.bid * NTHREADS + w.tid; i < 512 * 256; i += w.G * NTHREADS) { const int j = i >> 8, k = i & 255; const int g = (j & 255) >> 6, kc = j & 63; float val = 0.f;
            if ((k >> 6) == g) { const int m = (kc * (k & 63)) & 63; float s, c; sincospif((float)m * (1.0f / 32.0f), &s, &c); val = (j >> 8) ? -s : c; }
            D6[i] = (bf16)f2bf(val); }
        if (w.bid == 0) { float* LB = (float*)(a.ws + WS_LB); const int d = w.tid >> 8, ch = w.tid & 255; float lg[4], mx = -1e30f;
#pragma unroll
            for (int l = 0; l < 4; ++l) { lg[l] = a.in[I_LBLOG][(d * 4 + l) * 256 + ch]; mx = fmaxf(mx, lg[l]); }
            float s = 0.f;
#pragma unroll
            for (int l = 0; l < 4; ++l) { lg[l] = expf(lg[l] - mx); s += lg[l]; }
            float cum = 0.f;
#pragma unroll
            for (int l = 0; l < 4; ++l) { if (l > 0) cum += lg[l] / s; LB[(d * 4 + l) * 256 + ch] = cum; } }
    }
    __syncthreads();
    convert_win(a, lds, w.wave, w.lane, w.gw, w.NGW, 0);
}
__device__ __forceinline__ void phase_mod_rows(const Args& a, const WCtx& w, int l) {
    const float* X = (const float*)(a.ws + WS_X); bf16* H = (bf16*)(a.ws + WS_H);
    for (int row = w.gw; row < MT; row += w.NGW) { f32x4 v[4], hv[4]; row_load(X + (size_t)row * 1024, w.lane, v);
        modulate_row(v, mod_ptr(a, l, row, 0), mod_ptr(a, l, row, 1), H + (size_t)row * 1024, (unsigned*)(a.ws + WS_H8 + (size_t)row * 1024), w.lane, hv); }
}

__device__ __forceinline__ f32x4 ld_bf4(const bf16* p) { const v2u u = *(const v2u*)p; return (f32x4){bf2f(u.x & 0xffffu), bf2f(u.x >> 16), bf2f(u.y & 0xffffu), bf2f(u.y >> 16)}; }
__device__ __forceinline__ void st_bf4(bf16* p, f32x4 v) { v2u w; w.x = cvt_pk_bf16(v[0], v[1]); w.y = cvt_pk_bf16(v[2], v[3]); *(v2u*)p = w; }
__device__ __forceinline__ void phase_prep(const Args& a, const WCtx& w, int l) {
    const bf16* ZB = (const bf16*)(a.ws + WS_ZB); bf16* PB = (bf16*)(a.ws + WS_PB);
    constexpr int NSEG = 16 * 128 + 16 * 16;
    for (int it = w.gw; it < NSEG * 3; it += w.NGW) {
        const int seg = it / 3, bg = it - seg * 3;
        int T, t0, rowbase;
        if (seg < 2048) { const int b = seg >> 7; t0 = (seg & 127) * 16; T = 2048; rowbase = b * 2048; } else { const int s2 = seg - 2048; const int b = s2 >> 4; t0 = (s2 & 15) * 16; T = 256; rowbase = ML + b * 256; }
        const int blk = bg * 8 + (w.lane >> 3), c8 = (w.lane & 7) * 8;
        if (blk < 20) {
            int zcol, pcol; float cw[5][8], bias[8];
            if (blk < 12) { const int c = blk * 64 + c8; zcol = 768 + c; pcol = c;
#pragma unroll
                for (int k = 0; k < 5; ++k) { const f32x4 w0 = *(const f32x4*)(a.in[I_GDN_CW] + (size_t)(l * 5 + k) * 768 + c), w1 = *(const f32x4*)(a.in[I_GDN_CW] + (size_t)(l * 5 + k) * 768 + c + 4);
#pragma unroll
                    for (int i = 0; i < 4; ++i) { cw[k][i] = w0[i]; cw[k][4 + i] = w1[i]; } }
#pragma unroll
                for (int i = 0; i < 8; ++i) bias[i] = 0.f; }
            else { const int c = (blk - 12) * 64 + c8; zcol = 2048 + c; pcol = 768 + c;
#pragma unroll
                for (int k = 0; k < 5; ++k) { const f32x4 w0 = *(const f32x4*)(a.in[I_SSD_CW] + (size_t)(l * 5 + k) * 512 + c), w1 = *(const f32x4*)(a.in[I_SSD_CW] + (size_t)(l * 5 + k) * 512 + c + 4);
#pragma unroll
                    for (int i = 0; i < 4; ++i) { cw[k][i] = w0[i]; cw[k][4 + i] = w1[i]; } }
                const f32x4 b0 = *(const f32x4*)(a.in[I_SSD_CB] + l * 512 + c), b1 = *(const f32x4*)(a.in[I_SSD_CB] + l * 512 + c + 4);
#pragma unroll
                for (int i = 0; i < 4; ++i) { bias[i] = b0[i]; bias[4 + i] = b1[i]; } }
            const bf16* zp = ZB + (size_t)rowbase * NZB + zcol;
            v4u raw[20];
#pragma unroll
            for (int r = 0; r < 20; ++r) { const int t = t0 - 2 + r; raw[r] = (t >= 0 && t < T) ? *(const v4u*)(zp + (size_t)t * NZB) : (v4u){0u, 0u, 0u, 0u}; }
#pragma unroll
            for (int i = 0; i < 16; ++i) {
                float y[8];
#pragma unroll
                for (int q = 0; q < 8; ++q) y[q] = bias[q];
#pragma unroll
                for (int k = 0; k < 5; ++k) { const v4u rr = raw[i + k]; const unsigned uu[4] = {rr.x, rr.y, rr.z, rr.w};
#pragma unroll
                    for (int q = 0; q < 4; ++q) { y[2 * q] += cw[k][2 * q] * bf2f(uu[q] & 0xffffu); y[2 * q + 1] += cw[k][2 * q + 1] * bf2f(uu[q] >> 16); } }
                float ss = 0.f;
#pragma unroll
                for (int q = 0; q < 8; ++q) { y[q] = y[q] * sigmoid_fast(y[q]); ss += y[q] * y[q]; }
                if (blk < 8) { ss += dpp_xor1(ss); ss += dpp_xor2(ss); ss += __shfl_xor(ss, 4); float r = __builtin_amdgcn_rsqf(ss + LN_EPS); if (blk < 4) r *= 0.125f;
#pragma unroll
                    for (int q = 0; q < 8; ++q) y[q] *= r; }
                v4u o; o.x = cvt_pk_bf16(y[0], y[1]); o.y = cvt_pk_bf16(y[2], y[3]); o.z = cvt_pk_bf16(y[4], y[5]); o.w = cvt_pk_bf16(y[6], y[7]);
                *(v4u*)(PB + (size_t)(rowbase + t0 + i) * NPB + pcol) = o;
            }
        }
    }
}

__device__ __forceinline__ float red4(float x) { x += dpp_xor1(x); x += dpp_xor2(x); return x; }
__device__ __forceinline__ void phase_scan(const Args& a, LAS unsigned char* lds, const WCtx& w, int l) {
    LAS float* Qs = (LAS float*)lds; LAS float* Ks = Qs + 4096; LAS float* Dd = Qs + 8192; LAS float* Vs = Qs + 12288; LAS float* As = Qs + 16384; LAS float* Bs = As + 64;
    LAS bf16* Os = (LAS bf16*)(lds + 66048);
    const bf16* ZB = (const bf16*)(a.ws + WS_ZB); const float* ZF = (const float*)(a.ws + WS_ZF); const bf16* PB = (const bf16*)(a.ws + WS_PB); bf16* SO = (bf16*)(a.ws + WS_SO);
    const int sdir = w.tid >> 8, sr = (w.tid & 255) >> 3, c0 = (w.tid & 7) * 8;
    const int cdir = w.wave >> 2, eg = w.wave & 3, el = w.lane >> 2, dq = w.lane & 3;
    for (int pi = w.bid; pi < 192; pi += w.G) {
        const int mix = pi >> 6, b = (pi & 63) >> 2, h = pi & 3;
        float lbv[8]; float alog = 0.f, dtb = 0.f;
#pragma unroll
        for (int i = 0; i < 8; ++i) lbv[i] = 0.f;
        if (mix == 0) {
#pragma unroll
            for (int i = 0; i < 8; ++i) lbv[i] = ((const float*)(a.ws + WS_LB))[(sdir * 4 + l) * 256 + h * 64 + c0 + i]; }
        else if (mix == 1) { alog = expf(a.in[I_GDN_ALOG][(l * 2 + sdir) * 4 + h]); dtb = a.in[I_GDN_DTB][(l * 2 + sdir) * 4 + h]; }
        else { alog = expf(a.in[I_SSD_ALOG][(l * 2 + sdir) * 4 + h]); dtb = a.in[I_SSD_DTB][(l * 2 + sdir) * 4 + h]; }
        float S[16];
#pragma unroll
        for (int i = 0; i < 16; ++i) S[i] = 0.f;
        v4u rA, rB, rC; f32x4 rF0, rF1; float rs0 = 0.f, rs1 = 0.f;
        rA = rB = rC = (v4u){0u, 0u, 0u, 0u}; rF0 = rF1 = (f32x4){0.f, 0.f, 0.f, 0.f};
#define SCAN_ROW(dir_, sg_) (((sg_) < 256) ? (ML + b * 256 + ((dir_) ? 255 - (sg_) : (sg_))) : (b * 2048 + ((dir_) ? 2047 - ((sg_) - 256) : ((sg_) - 256))))
#define SCAN_LOAD(tb_) do { const int row_ = SCAN_ROW(sdir, (tb_) * 32 + sr); \
            if (mix == 0) { rA = *(const v4u*)(ZB + (size_t)row_ * NZB + h * 64 + c0); rC = *(const v4u*)(ZB + (size_t)row_ * NZB + 256 + h * 64 + c0); \
                            rF0 = *(const f32x4*)(ZF + (size_t)row_ * NZF + sdir * 256 + h * 64 + c0); rF1 = *(const f32x4*)(ZF + (size_t)row_ * NZF + sdir * 256 + h * 64 + c0 + 4); } \
            else if (mix == 1) { rA = *(const v4u*)(PB + (size_t)row_ * NPB + h * 64 + c0); rB = *(const v4u*)(PB + (size_t)row_ * NPB + 256 + h * 64 + c0); rC = *(const v4u*)(PB + (size_t)row_ * NPB + 512 + h * 64 + c0); \
                            rs0 = ZF[(size_t)row_ * NZF + 512 + sdir * 4 + h]; rs1 = ZF[(size_t)row_ * NZF + 520 + sdir * 4 + h]; } \
            else { rA = *(const v4u*)(PB + (size_t)row_ * NPB + 768 + 384 + (h >> 1) * 64 + c0); rB = *(const v4u*)(PB + (size_t)row_ * NPB + 768 + 256 + (h >> 1) * 64 + c0); rC = *(const v4u*)(PB + (size_t)row_ * NPB + 768 + h * 64 + c0); \
                            rs0 = ZF[(size_t)row_ * NZF + 528 + sdir * 4 + h]; } } while (0)
#define SCAN_STORE() do { const int o_ = (sdir * 32 + sr) * 64 + c0; float qa[8], ka[8], va[8], da[8]; \
            const unsigned ua[4] = {rA.x, rA.y, rA.z, rA.w}, ub[4] = {rB.x, rB.y, rB.z, rB.w}, uc[4] = {rC.x, rC.y, rC.z, rC.w}; \
            _Pragma("unroll") for (int i_ = 0; i_ < 4; ++i_) { qa[2 * i_] = bf2f(ua[i_] & 0xffffu); qa[2 * i_ + 1] = bf2f(ua[i_] >> 16); ka[2 * i_] = bf2f(ub[i_] & 0xffffu); ka[2 * i_ + 1] = bf2f(ub[i_] >> 16); \
                va[2 * i_] = bf2f(uc[i_] & 0xffffu); va[2 * i_ + 1] = bf2f(uc[i_] >> 16); } \
            if (mix == 0) { const float zf_[8] = {rF0[0], rF0[1], rF0[2], rF0[3], rF1[0], rF1[1], rF1[2], rF1[3]}; \
                _Pragma("unroll") for (int i_ = 0; i_ < 8; ++i_) { const float sg_ = sigmoid_acc(zf_[i_]); da[i_] = lbv[i_] + (1.0f - lbv[i_]) * sg_; ka[i_] = (1.0f - lbv[i_]) * (1.0f - sg_); qa[i_] = silu_acc(qa[i_]); } \
                if (c0 == 0) { As[sdir * 32 + sr] = 0.f; Bs[sdir * 32 + sr] = 0.f; } } \
            else if (mix == 1) { const float av_ = expf(-alog * softplus_acc(rs0 + dtb)); _Pragma("unroll") for (int i_ = 0; i_ < 8; ++i_) da[i_] = av_; \
                if (c0 == 0) { As[sdir * 32 + sr] = av_; Bs[sdir * 32 + sr] = sigmoid_acc(rs1); } } \
            else { const float dt_ = softplus_acc(rs0 + dtb); const float av_ = expf(-alog * dt_); _Pragma("unroll") for (int i_ = 0; i_ < 8; ++i_) { da[i_] = av_; va[i_] *= dt_; } \
                if (c0 == 0) { As[sdir * 32 + sr] = av_; Bs[sdir * 32 + sr] = 0.f; } } \
            *(LAS f32x4*)(Qs + o_) = (f32x4){qa[0], qa[1], qa[2], qa[3]}; *(LAS f32x4*)(Qs + o_ + 4) = (f32x4){qa[4], qa[5], qa[6], qa[7]}; \
            *(LAS f32x4*)(Ks + o_) = (f32x4){ka[0], ka[1], ka[2], ka[3]}; *(LAS f32x4*)(Ks + o_ + 4) = (f32x4){ka[4], ka[5], ka[6], ka[7]}; \
            *(LAS f32x4*)(Dd + o_) = (f32x4){da[0], da[1], da[2], da[3]}; *(LAS f32x4*)(Dd + o_ + 4) = (f32x4){da[4], da[5], da[6], da[7]}; \
            *(LAS f32x4*)(Vs + o_) = (f32x4){va[0], va[1], va[2], va[3]}; *(LAS f32x4*)(Vs + o_ + 4) = (f32x4){va[4], va[5], va[6], va[7]}; } while (0)
        SCAN_LOAD(0); SCAN_STORE(); __syncthreads();
        for (int tb = 0; tb < 72; ++tb) {
            if (tb + 1 < 72) SCAN_LOAD(tb + 1);
#pragma unroll 2
            for (int s = 0; s < 32; ++s) {
                const int base = (cdir * 32 + s) * 64 + dq * 16;
                f32x4 q4[4], k4[4];
#pragma unroll
                for (int i = 0; i < 4; ++i) { q4[i] = *(const LAS f32x4*)(Qs + base + 4 * i); k4[i] = *(const LAS f32x4*)(Ks + base + 4 * i); }
                float vv = Vs[(cdir * 32 + s) * 64 + eg * 16 + el];
                const float av = As[cdir * 32 + s];
                float o0 = 0.f, o1 = 0.f, o2 = 0.f, o3 = 0.f;
                if (mix == 0) {
                    f32x4 d4[4];
#pragma unroll
                    for (int i = 0; i < 4; ++i) d4[i] = *(const LAS f32x4*)(Dd + base + 4 * i);
#pragma unroll
                    for (int i = 0; i < 4; ++i) {
                        S[4 * i + 0] = d4[i][0] * S[4 * i + 0] + k4[i][0] * vv; o0 += q4[i][0] * S[4 * i + 0];
                        S[4 * i + 1] = d4[i][1] * S[4 * i + 1] + k4[i][1] * vv; o1 += q4[i][1] * S[4 * i + 1];
                        S[4 * i + 2] = d4[i][2] * S[4 * i + 2] + k4[i][2] * vv; o2 += q4[i][2] * S[4 * i + 2];
                        S[4 * i + 3] = d4[i][3] * S[4 * i + 3] + k4[i][3] * vv; o3 += q4[i][3] * S[4 * i + 3]; }
                } else {
                    if (mix == 1) { const float be = Bs[cdir * 32 + s]; float k0 = 0.f, k1 = 0.f, k2 = 0.f, k3 = 0.f;
#pragma unroll
                        for (int i = 0; i < 4; ++i) { k0 += k4[i][0] * S[4 * i + 0]; k1 += k4[i][1] * S[4 * i + 1]; k2 += k4[i][2] * S[4 * i + 2]; k3 += k4[i][3] * S[4 * i + 3]; }
                        const float ks = red4((k0 + k1) + (k2 + k3)); vv = be * (vv - av * ks); }
#pragma unroll
                    for (int i = 0; i < 4; ++i) {
                        S[4 * i + 0] = av * S[4 * i + 0] + k4[i][0] * vv; o0 += q4[i][0] * S[4 * i + 0];
                        S[4 * i + 1] = av * S[4 * i + 1] + k4[i][1] * vv; o1 += q4[i][1] * S[4 * i + 1];
                        S[4 * i + 2] = av * S[4 * i + 2] + k4[i][2] * vv; o2 += q4[i][2] * S[4 * i + 2];
                        S[4 * i + 3] = av * S[4 * i + 3] + k4[i][3] * vv; o3 += q4[i][3] * S[4 * i + 3]; }
                }
                const float o = red4((o0 + o1) + (o2 + o3));
                if (dq == 0) Os[(w.wave * 32 + s) * 16 + el] = (bf16)f2bf(o);
            }
            LDS_WAIT();
            { const int r = w.lane >> 1, hf = w.lane & 1; const int row = SCAN_ROW(cdir, tb * 32 + r);
              const v4u ov = *(const LAS v4u*)(Os + (w.wave * 32 + r) * 16 + hf * 8);
              *(v4u*)(SO + ((size_t)(mix * 2 + cdir) * MT + row) * 256 + h * 64 + eg * 16 + hf * 8) = ov; }
            __syncthreads();
            if (tb + 1 < 72) SCAN_STORE();
            __syncthreads();
        }
#undef SCAN_ROW
#undef SCAN_LOAD
#undef SCAN_STORE
    }
}

__device__ __forceinline__ f32x4 silu4(f32x4 x) { return (f32x4){silu_acc(x[0]), silu_acc(x[1]), silu_acc(x[2]), silu_acc(x[3])}; }
__device__ __forceinline__ f32x4 silu4f(f32x4 x) { return (f32x4){x[0] * sigmoid_fast(x[0]), x[1] * sigmoid_fast(x[1]), x[2] * sigmoid_fast(x[2]), x[3] * sigmoid_fast(x[3])}; }
__device__ __forceinline__ f32x4 bf4(v2u u) { return (f32x4){bf2f(u.x & 0xffffu), bf2f(u.x >> 16), bf2f(u.y & 0xffffu), bf2f(u.y >> 16)}; }
struct FinRow { v2u so[6], zg[3], px; f32x4 fo0, fo1; };
__device__ __forceinline__ void fin_load(FinRow& R, const bf16* ZB, const bf16* PB, const bf16* SO, const float* FO, int row, int ch) {
#pragma unroll
    for (int k = 0; k < 6; ++k) R.so[k] = *(const v2u*)(SO + ((size_t)k * MT + row) * 256 + ch);
    R.zg[0] = *(const v2u*)(ZB + (size_t)row * NZB + 512 + ch); R.zg[1] = *(const v2u*)(ZB + (size_t)row * NZB + 1536 + ch); R.zg[2] = *(const v2u*)(ZB + (size_t)row * NZB + 2560 + ch);
    R.px = *(const v2u*)(PB + (size_t)row * NPB + 768 + ch);
    R.fo0 = *(const f32x4*)(FO + (size_t)row * 256 + ch); R.fo1 = (f32x4){0.f, 0.f, 0.f, 0.f};
}
__device__ __forceinline__ void phase_finish(const Args& a, const WCtx& w, int l, int nrows) {
    const bf16* ZB = (const bf16*)(a.ws + WS_ZB); const bf16* PB = (const bf16*)(a.ws + WS_PB); const bf16* SO = (const bf16*)(a.ws + WS_SO); const float* FO = (const float*)(a.ws + WS_FO);
    bf16* OUTS = (bf16*)(a.ws + WS_OUTS);
    const int ch = 4 * w.lane, hd = w.lane >> 4;
    const f32x4 nwa = *(const f32x4*)(a.in[I_HGRN_NW] + l * 256 + ch), nwb = *(const f32x4*)(a.in[I_GDN_NW] + l * 256 + ch), nwd = *(const f32x4*)(a.in[I_SSD_NW] + l * 256 + ch);
    const float dsk = a.in[I_SSD_D][l * 4 + hd];
    int row = w.gw; FinRow R, Rn;
    if (row < nrows) fin_load(R, ZB, PB, SO, FO, row, ch);
    while (row < nrows) {
        const int nrow = row + w.NGW;
        if (nrow < nrows) fin_load(Rn, ZB, PB, SO, FO, nrow, ch);
        asm volatile("" ::: "memory");
        bf16* orow = OUTS + (size_t)row * 1024 + ch;
        { f32x4 o = bf4(R.so[0]) + bf4(R.so[1]);
          float ss = (o[0] * o[0] + o[1] * o[1]) + (o[2] * o[2] + o[3] * o[3]); ss += dpp_xor1(ss); ss += dpp_xor2(ss); ss += __shfl_xor(ss, 4); ss += __shfl_xor(ss, 8);
          const float r = __builtin_amdgcn_rsqf(ss * (1.f / 64.f) + LN_EPS); st_bf4(orow, o * r * nwa * silu4f(bf4(R.zg[0]))); }
        { f32x4 o = bf4(R.so[2]) + bf4(R.so[3]);
          float ss = (o[0] * o[0] + o[1] * o[1]) + (o[2] * o[2] + o[3] * o[3]); ss += dpp_xor1(ss); ss += dpp_xor2(ss); ss += __shfl_xor(ss, 4); ss += __shfl_xor(ss, 8);
          const float r = __builtin_amdgcn_rsqf(ss * (1.f / 64.f) + LN_EPS); st_bf4(orow + 256, o * r * nwb * silu4f(bf4(R.zg[1]))); }
        st_bf4(orow + 512, R.fo0 + R.fo1);
        { f32x4 o = bf4(R.so[4]) + bf4(R.so[5]); f32x4 y = (o + bf4(R.px) * dsk) * silu4f(bf4(R.zg[2]));
          const float ss = wave_sum((y[0] * y[0] + y[1] * y[1]) + (y[2] * y[2] + y[3] * y[3]));
          const float r = __builtin_amdgcn_rsqf(ss * (1.f / 256.f) + LN_EPS); st_bf4(orow + 768, y * r * nwd); }
        R = Rn; row = nrow;
    }
}

__device__ __forceinline__ int row_batch(int row) { return row < ML ? (row >> 11) : 16; }
__device__ __forceinline__ void phase_ln1(const Args& a, LAS unsigned char* lds, const WCtx& w, int l, int nrows) {
    LAS float* WRT = (LAS float*)lds;
    LAS float* LNG = WRT + 16384; LAS float* LNB = LNG + 1024; LAS float* BV = LNB + 1024;
    const int rpb = (nrows + w.G - 1) / w.G, r0 = w.bid * rpb, r1 = (r0 + rpb < nrows) ? r0 + rpb : nrows;
    const int b_lo = row_batch(r0 < nrows ? r0 : 0), b_hi = row_batch(r1 > r0 ? r1 - 1 : 0);
    for (int i = w.tid; i < 16384; i += NTHREADS) { const int d = i >> 4, e = i & 15; WRT[e * 1024 + d] = a.in[I_WROUTER][(size_t)l * 16384 + i]; }
    for (int i = w.tid; i < 1024; i += NTHREADS) { LNG[i] = a.in[I_LN1G][l * 1024 + i]; LNB[i] = a.in[I_LN1B][l * 1024 + i];
#pragma unroll
        for (int s = 0; s < 2; ++s) { const float* mp = (const float*)(a.ws + WS_MOD) + (size_t)(l * 17 + (s ? b_hi : b_lo)) * 6144;
            BV[(s * 3 + 0) * 1024 + i] = mp[2048 + i]; BV[(s * 3 + 1) * 1024 + i] = mp[3072 + i]; BV[(s * 3 + 2) * 1024 + i] = mp[4096 + i]; } }
    __syncthreads();
    float* X = (float*)(a.ws + WS_X); const bf16* Y = (const bf16*)(a.ws + WS_Y); bf16* H = (bf16*)(a.ws + WS_H); float* AFF = (float*)(a.ws + WS_AFF);
    int row = r0 + w.wave;
    f32x4 x[4]; v2u yb[4];
#pragma unroll
    for (int j = 0; j < 4; ++j) { x[j] = (f32x4){0.f, 0.f, 0.f, 0.f}; yb[j] = (v2u){0u, 0u}; }
    if (row < r1) { row_load(X + (size_t)row * 1024, w.lane, x);
#pragma unroll
        for (int j = 0; j < 4; ++j) yb[j] = *((const v2u*)(Y + (size_t)row * 1024) + w.lane + 64 * j); }
    while (row < r1) {
        const int nrow = row + NWAVES; f32x4 xn[4]; v2u ybn[4];
#pragma unroll
        for (int j = 0; j < 4; ++j) { xn[j] = (f32x4){0.f, 0.f, 0.f, 0.f}; ybn[j] = (v2u){0u, 0u}; }
        if (nrow < r1) { row_load(X + (size_t)nrow * 1024, w.lane, xn);
#pragma unroll
            for (int j = 0; j < 4; ++j) ybn[j] = *((const v2u*)(Y + (size_t)nrow * 1024) + w.lane + 64 * j); }
        asm volatile("" ::: "memory");
        const LAS float* bv = BV + ((row_batch(row) != b_lo) ? 3 * 1024 : 0);
        f32x4 hv[4];
#pragma unroll
        for (int j = 0; j < 4; ++j) { const f32x4 g1 = *(const LAS f32x4*)(bv + 4 * w.lane + 256 * j);
            const f32x4 yv = (f32x4){bf2f(yb[j].x & 0xffffu), bf2f(yb[j].x >> 16), bf2f(yb[j].y & 0xffffu), bf2f(yb[j].y >> 16)};
            x[j] = x[j] * ALPHA + g1 * yv; }
        float mean, rstd; ln_stats(x, mean, rstd);
#pragma unroll
        for (int j = 0; j < 4; ++j) x[j] = (x[j] - mean) * rstd * *(const LAS f32x4*)(LNG + 4 * w.lane + 256 * j) + *(const LAS f32x4*)(LNB + 4 * w.lane + 256 * j);
        row_store(X + (size_t)row * 1024, w.lane, x);
        ln_stats(x, mean, rstd);
        { unsigned* hrow = (unsigned*)((unsigned char*)H + (size_t)row * 1024);
#pragma unroll
          for (int j = 0; j < 4; ++j) { const f32x4 sh = *(const LAS f32x4*)(bv + 1024 + 4 * w.lane + 256 * j), sc = *(const LAS f32x4*)(bv + 2048 + 4 * w.lane + 256 * j);
              hv[j] = (x[j] - mean) * rstd * (sc + 1.0f) + sh;
              hrow[w.lane + 64 * j] = pk4_fp8(fminf(fmaxf(hv[j][0], -448.f), 448.f), fminf(fmaxf(hv[j][1], -448.f), 448.f), fminf(fmaxf(hv[j][2], -448.f), 448.f), fminf(fmaxf(hv[j][3], -448.f), 448.f)); } }
        float pe[16];
#pragma unroll
        for (int e = 0; e < 16; ++e) { float p = 0.f;
#pragma unroll
            for (int j = 0; j < 4; ++j) { const f32x4 wv = *(const LAS f32x4*)(WRT + e * 1024 + 256 * j + 4 * w.lane); p += (hv[j][0] * wv[0] + hv[j][1] * wv[1]) + (hv[j][2] * wv[2] + hv[j][3] * wv[3]); }
            pe[e] = p; }
        float q8[8], q4[4], q2[2];
        { const bool hi = (w.lane & 32) != 0;
#pragma unroll
          for (int k = 0; k < 8; ++k) { const float mine = hi ? pe[k + 8] : pe[k], oth = hi ? pe[k] : pe[k + 8]; q8[k] = mine + __shfl_xor(oth, 32); } }
        { const bool hi = (w.lane & 16) != 0;
#pragma unroll
          for (int k = 0; k < 4; ++k) { const float mine = hi ? q8[k + 4] : q8[k], oth = hi ? q8[k] : q8[k + 4]; q4[k] = mine + __shfl_xor(oth, 16); } }
        { const bool hi = (w.lane & 8) != 0;
#pragma unroll
          for (int k = 0; k < 2; ++k) { const float mine = hi ? q4[k + 2] : q4[k], oth = hi ? q4[k] : q4[k + 2]; q2[k] = mine + __shfl_xor(oth, 8); } }
        float lg;
        { const bool hi = (w.lane & 4) != 0; const float mine = hi ? q2[1] : q2[0], oth = hi ? q2[0] : q2[1]; lg = mine + __shfl_xor(oth, 4); }
        lg += dpp_xor1(lg); lg += dpp_xor2(lg);
        float mx = lg;
        mx = fmaxf(mx, __shfl_xor(mx, 4)); mx = fmaxf(mx, __shfl_xor(mx, 8)); mx = fmaxf(mx, __shfl_xor(mx, 16)); mx = fmaxf(mx, __shfl_xor(mx, 32));
        const float ex = __expf(lg - mx); float s = ex;
        s += __shfl_xor(s, 4); s += __shfl_xor(s, 8); s += __shfl_xor(s, 16); s += __shfl_xor(s, 32);
        if ((w.lane & 3) == 0) AFF[(size_t)row * 16 + (w.lane >> 2)] = ex / s;
#pragma unroll
        for (int j = 0; j < 4; ++j) { x[j] = xn[j]; yb[j] = ybn[j]; }
        row = nrow;
    }
}

__device__ __forceinline__ void phase_topk(const Args& a, LAS unsigned char* lds, const WCtx& w, int nitems) {
    LAS int* CNT = (LAS int*)lds;
    LAS int* WS1 = CNT + 16;
    LAS int* WS2 = WS1 + 8;
    LAS int* SEL = WS2 + 8;
    LAS int* SELW = SEL + 256;
    const float* AFF = (const float*)(a.ws + WS_AFF); int* SLOT = (int*)(a.ws + WS_SLOT); float* ROWW = (float*)(a.ws + WS_ROWW);
    int* SELROW = (int*)(a.ws + WS_ROWW + 512 * 1024);
    for (int it2 = w.gw; it2 < nitems - 256; it2 += w.NGW) {
        const int b = it2 >> 4, e = it2 & 15, rowbase = ML + b * 256, xebase = 65536 + e * 512 + b * 32;
        unsigned key[4];
#pragma unroll
        for (int j = 0; j < 4; ++j) key[j] = __float_as_uint(AFF[(size_t)(rowbase + w.lane * 4 + j) * 16 + e]);
        unsigned T = 0u;
        for (int bit = 29; bit >= 0; --bit) { const unsigned trial = T | (1u << bit); int tot = 0;
#pragma unroll
            for (int j = 0; j < 4; ++j) tot += __popcll(__ballot(key[j] >= trial));
            if (tot >= CAP_C) T = trial; }
        int ngt = 0, ceq = 0;
#pragma unroll
        for (int j = 0; j < 4; ++j) { ngt += (key[j] > T) ? 1 : 0; ceq += (key[j] == T) ? 1 : 0; }
        int xg = ngt, xq = ceq;
#pragma unroll
        for (int o = 1; o < 64; o <<= 1) { const int yg = __shfl_up(xg, o), yq = __shfl_up(xq, o); if (w.lane >= o) { xg += yg; xq += yq; } }
        const int need_eq = CAP_C - __shfl(xg, 63); int eqrank = xq - ceq;
        int sel[4], csel = 0;
#pragma unroll
        for (int j = 0; j < 4; ++j) { const bool iseq = key[j] == T; sel[j] = (key[j] > T) || (iseq && eqrank < need_eq); if (iseq) ++eqrank; csel += sel[j]; }
        int xs = csel;
#pragma unroll
        for (int o = 1; o < 64; o <<= 1) { const int ys = __shfl_up(xs, o); if (w.lane >= o) xs += ys; }
        int slot = xs - csel;
#pragma unroll
        for (int j = 0; j < 4; ++j) { const int t = w.lane * 4 + j; int sv = -1; if (sel[j] && slot < CAP_C) { sv = slot; ROWW[xebase + slot] = __uint_as_float(key[j]); ++slot; }
            SLOT[(size_t)(rowbase + t) * 16 + e] = sv;
            if (sv >= 0) SELW[w.wave * 32 + sv] = t; }
        LDS_WAIT();
        if (w.lane < CAP_C) SELROW[xebase + w.lane] = rowbase + SELW[w.wave * 32 + w.lane];
        LDS_WAIT();
    }
    __syncthreads();
    for (int item = w.bid; item < (nitems < 256 ? nitems : 256); item += w.G) {
        int b, e, n, cap, rowbase, xebase;
        if (item < 256) { b = item >> 4; e = item & 15; n = 2048; cap = CAP_L; rowbase = b * 2048; xebase = e * 4096 + b * 256; }
        else { const int it2 = item - 256; b = it2 >> 4; e = it2 & 15; n = 256; cap = CAP_C; rowbase = ML + b * 256; xebase = 65536 + e * 512 + b * 32; }
        unsigned key[4];
#pragma unroll
        for (int j = 0; j < 4; ++j) { const int t = w.tid * 4 + j; key[j] = t < n ? __float_as_uint(AFF[(size_t)(rowbase + t) * 16 + e]) : 0u; }
        unsigned T = 0u;
        for (int bit = 29; bit >= 0; --bit) {
            const unsigned trial = T | (1u << bit); int c = 0;
#pragma unroll
            for (int j = 0; j < 4; ++j) c += (key[j] >= trial) ? 1 : 0;
#pragma unroll
            for (int o = 1; o < 64; o <<= 1) c += __shfl_xor(c, o);
            LAS int* cb = CNT + (bit & 1) * 8;
            if (w.lane == 0) cb[w.wave] = c;
            __syncthreads();
            int tot = 0;
#pragma unroll
            for (int q = 0; q < 8; ++q) tot += cb[q];
            if (tot >= cap) T = trial;
        }
        int ngt = 0, ceq = 0;
#pragma unroll
        for (int j = 0; j < 4; ++j) { ngt += (key[j] > T) ? 1 : 0; ceq += (key[j] == T && key[j] != 0u) ? 1 : 0; }
        int xg = ngt, xe = ceq;
#pragma unroll
        for (int o = 1; o < 64; o <<= 1) { const int yg = __shfl_up(xg, o), ye = __shfl_up(xe, o); if (w.lane >= o) { xg += yg; xe += ye; } }
        __syncthreads();
        if (w.lane == 63) { WS1[w.wave] = xg; WS2[w.wave] = xe; }
        __syncthreads();
        int totg = 0, offe = 0;
#pragma unroll
        for (int q = 0; q < 8; ++q) { totg += WS1[q]; if (q < w.wave) offe += WS2[q]; }
        const int need_eq = cap - totg; int eqrank = offe + xe - ceq;
        int sel[4], csel = 0;
#pragma unroll
        for (int j = 0; j < 4; ++j) { const bool iseq = (key[j] == T && key[j] != 0u); sel[j] = (key[j] > T) || (iseq && eqrank < need_eq); if (iseq) ++eqrank; csel += sel[j]; }
        int xs = csel;
#pragma unroll
        for (int o = 1; o < 64; o <<= 1) { const int ys = __shfl_up(xs, o); if (w.lane >= o) xs += ys; }
        __syncthreads();
        if (w.lane == 63) WS1[w.wave] = xs;
        __syncthreads();
        int offs = 0;
#pragma unroll
        for (int q = 0; q < 8; ++q) if (q < w.wave) offs += WS1[q];
        int slot = offs + xs - csel;
#pragma unroll
        for (int j = 0; j < 4; ++j) { const int t = w.tid * 4 + j; if (t < n) { int sv = -1; if (sel[j]) { sv = slot; if (slot < cap) { SEL[slot] = t; ROWW[xebase + slot] = __uint_as_float(key[j]); } ++slot; }
                SLOT[(size_t)(rowbase + t) * 16 + e] = (sv < cap) ? sv : -1; } }
        __syncthreads();
        for (int s = w.tid; s < cap; s += NTHREADS) SELROW[xebase + s] = rowbase + SEL[s];
        __syncthreads();
    }
}

__device__ __forceinline__ void phase_ln2(const Args& a, LAS unsigned char* lds, const WCtx& w, int l, int nrows) {
    LAS float* LNG = (LAS float*)lds; LAS float* LNB = LNG + 1024; LAS float* BV = LNB + 1024;
    const int rpb = (nrows + w.G - 1) / w.G, r0 = w.bid * rpb, r1 = (r0 + rpb < nrows) ? r0 + rpb : nrows;
    const int b_lo = row_batch(r0 < nrows ? r0 : 0), b_hi = row_batch(r1 > r0 ? r1 - 1 : 0);
    const int ln = (l + 1 < DEPTH) ? l + 1 : l;
    for (int i = w.tid; i < 1024; i += NTHREADS) { LNG[i] = a.in[I_LN2G][l * 1024 + i]; LNB[i] = a.in[I_LN2B][l * 1024 + i];
#pragma unroll
        for (int s = 0; s < 2; ++s) { const int bb = s ? b_hi : b_lo; const float* mp = (const float*)(a.ws + WS_MOD) + (size_t)(l * 17 + bb) * 6144; const float* mn = (const float*)(a.ws + WS_MOD) + (size_t)(ln * 17 + bb) * 6144;
            BV[(s * 3 + 0) * 1024 + i] = mp[5120 + i]; BV[(s * 3 + 1) * 1024 + i] = mn[i]; BV[(s * 3 + 2) * 1024 + i] = mn[1024 + i]; } }
    __syncthreads();
    float* X = (float*)(a.ws + WS_X); bf16* H = (bf16*)(a.ws + WS_H); const unsigned char* YE = (const unsigned char*)(a.ws + WS_YE);   const int* SLOT = (const int*)(a.ws + WS_SLOT);
    int row = r0 + w.wave;
    f32x4 x[4]; int myslot = -1;
#pragma unroll
    for (int j = 0; j < 4; ++j) x[j] = (f32x4){0.f, 0.f, 0.f, 0.f};
    if (row < r1) { row_load(X + (size_t)row * 1024, w.lane, x); myslot = SLOT[(size_t)row * 16 + (w.lane & 15)]; }
    while (row < r1) {
        const int nrow = row + NWAVES; f32x4 xn[4]; int nslot = -1;
#pragma unroll
        for (int j = 0; j < 4; ++j) xn[j] = (f32x4){0.f, 0.f, 0.f, 0.f};
        f32x4 mo[4];
#pragma unroll
        for (int j = 0; j < 4; ++j) mo[j] = (f32x4){0.f, 0.f, 0.f, 0.f};
        const int b = row < ML ? (row >> 11) : ((row - ML) >> 8);
        unsigned m = (unsigned)(__ballot(myslot >= 0) & 0xFFFFull);
        while (m) {
            unsigned t[4][4];
#pragma unroll
            for (int k = 0; k < 4; ++k) {
#pragma unroll
                for (int j = 0; j < 4; ++j) t[k][j] = 0u;
                if (m) { const int e = __builtin_ctz(m); m &= m - 1u; const int s = __shfl(myslot, e);
                    const size_t xr = row < ML ? (size_t)(e * 4096 + b * 256 + s) : (size_t)(65536 + e * 512 + b * 32 + s); const unsigned* yr = (const unsigned*)(YE + xr * 1024) + w.lane;
#pragma unroll
                    for (int j = 0; j < 4; ++j) t[k][j] = yr[64 * j]; } }
#pragma unroll
            for (int k = 0; k < 4; ++k)
#pragma unroll
                for (int j = 0; j < 4; ++j) { const f32x2 lo = __builtin_amdgcn_cvt_pk_f32_fp8((int)t[k][j], false), hi = __builtin_amdgcn_cvt_pk_f32_fp8((int)t[k][j], true); mo[j][0] += lo[0]; mo[j][1] += lo[1]; mo[j][2] += hi[0]; mo[j][3] += hi[1]; }
        }
#pragma unroll
        for (int j = 0; j < 4; ++j) mo[j] = mo[j] * (1.0f / 64.0f);
        if (nrow < r1) { row_load(X + (size_t)nrow * 1024, w.lane, xn); nslot = SLOT[(size_t)nrow * 16 + (w.lane & 15)]; }
        asm volatile("" ::: "memory");
        const LAS float* bv = BV + ((row_batch(row) != b_lo) ? 3 * 1024 : 0);
#pragma unroll
        for (int j = 0; j < 4; ++j) x[j] = x[j] * ALPHA + *(const LAS f32x4*)(bv + 4 * w.lane + 256 * j) * mo[j];
        float mean, rstd; ln_stats(x, mean, rstd);
#pragma unroll
        for (int j = 0; j < 4; ++j) x[j] = (x[j] - mean) * rstd * *(const LAS f32x4*)(LNG + 4 * w.lane + 256 * j) + *(const LAS f32x4*)(LNB + 4 * w.lane + 256 * j);
        if (l == DEPTH - 1) row_store(a.out + (size_t)row * 1024, w.lane, x);
        else { row_store(X + (size_t)row * 1024, w.lane, x);
            ln_stats(x, mean, rstd); bf16* hrow = H + (size_t)row * 1024;
#pragma unroll
            for (int j = 0; j < 4; ++j) { const f32x4 sh = *(const LAS f32x4*)(bv + 1024 + 4 * w.lane + 256 * j), sc = *(const LAS f32x4*)(bv + 2048 + 4 * w.lane + 256 * j);
                const f32x4 hv = (x[j] - mean) * rstd * (sc + 1.0f) + sh;
                v2u wv; wv.x = cvt_pk_bf16(hv[0], hv[1]); wv.y = cvt_pk_bf16(hv[2], hv[3]); *((v2u*)hrow + w.lane + 64 * j) = wv;
                ((unsigned*)(a.ws + WS_H8 + (size_t)row * 1024))[w.lane + 64 * j] = pk4c_fp8(hv); } }
#pragma unroll
        for (int j = 0; j < 4; ++j) x[j] = xn[j];
        myslot = nslot; row = nrow;
    }
}
typedef float f32x16 __attribute__((ext_vector_type(16)));
constexpr int TS = 72, TILE_BYTES = 64 * TS * 2;
constexpr int SCG_BYTES = 7 * TILE_BYTES + 2048;
constexpr size_t WS_UT = WS_R1 + 684 * MiB;
constexpr size_t WS_WW = WS_R1 + 720 * MiB;
__device__ __forceinline__ f32x16 mma64(f32x16 acc, const LAS bf16* A, const LAS bf16* BT, int lane) {
    const int r = lane & 31, h = lane >> 5;
    const LAS bf16* ap = A + r * TS + 8 * h; const LAS bf16* bp = BT + r * TS + 8 * h;
#pragma unroll
    for (int ks = 0; ks < 4; ++ks) { const bf16x8 av = *(const LAS bf16x8*)(ap + ks * 16), bv = *(const LAS bf16x8*)(bp + ks * 16); acc = __builtin_amdgcn_mfma_f32_32x32x16_bf16(av, bv, acc, 0, 0, 0); }
    return acc;
}
__device__ __forceinline__ int swz(int row, int col) { return row * TS + ((((col >> 3) ^ ((row >> 4) & 3)) << 3) | (col & 7)); }
template <bool SWA, bool SWB>
__device__ __forceinline__ f32x16 mma64s(f32x16 acc, const LAS bf16* A, int ablk, const LAS bf16* BT, int bblk, int lane) {
    const int r = lane & 31, h = lane >> 5;
    const int sa = SWA ? ((2 * ablk + (r >> 4)) & 3) : 0, sb = SWB ? ((2 * bblk + (r >> 4)) & 3) : 0;
    const LAS bf16* ap = A + (32 * ablk + r) * TS; const LAS bf16* bp = BT + (32 * bblk + r) * TS;
#pragma unroll
    for (int ks = 0; ks < 4; ++ks) { const bf16x8 av = *(const LAS bf16x8*)(ap + (((2 * ks + h) ^ sa) << 3)), bv = *(const LAS bf16x8*)(bp + (((2 * ks + h) ^ sb) << 3)); acc = __builtin_amdgcn_mfma_f32_32x32x16_bf16(av, bv, acc, 0, 0, 0); }
    return acc;
}
__device__ __forceinline__ f32x16 zero16() { f32x16 z;
#pragma unroll
    for (int i = 0; i < 16; ++i) z[i] = 0.f;
    return z; }
__device__ __forceinline__ int chain_row(int b, int dir, int c, int i) {
    if (c < 4) { const int p = 64 * c + i; return ML + b * 256 + (dir ? 255 - p : p); }
    const int p = 64 * (c - 4) + i; return b * 2048 + (dir ? 2047 - p : p);
}
__device__ __forceinline__ float expc(float x) { return __expf(fminf(x, 80.f)); }
__device__ __forceinline__ bf16 bfr(float x) { return (bf16)cvt_pk_bf16(x, x); }
__device__ __forceinline__ void st4bf(LAS bf16* p, float a, float b, float c, float d) { v2u w; w.x = cvt_pk_bf16(a, b); w.y = cvt_pk_bf16(c, d); *(LAS v2u*)p = w; }
__device__ __forceinline__ void unpack8(const v4u u, float (&f)[8]) { f[0] = bf2f(u.x & 0xffffu); f[1] = bf2f(u.x >> 16); f[2] = bf2f(u.y & 0xffffu); f[3] = bf2f(u.y >> 16); f[4] = bf2f(u.z & 0xffffu); f[5] = bf2f(u.z >> 16); f[6] = bf2f(u.w & 0xffffu); f[7] = bf2f(u.w >> 16); }
__device__ __forceinline__ void store_state_T(LAS bf16* TST, const f32x16& S, int wm, int wn, int r, int hh) {
#pragma unroll
    for (int q = 0; q < 4; ++q) st4bf(TST + (32 * wn + r) * TS + 32 * wm + 8 * q + 4 * hh, S[4 * q], S[4 * q + 1], S[4 * q + 2], S[4 * q + 3]);
}

__device__ __forceinline__ void phase_gdn_solve(const Args& a, LAS unsigned char* lds, const WCtx& w, int l) {
    const int sub = w.wave >> 1, wv = w.wave & 1, t2 = w.tid & 127, lane = w.lane, r = lane & 31, hh = lane >> 5;
    LAS unsigned char* gb = lds + sub * 27648;
    LAS bf16* TK = (LAS bf16*)gb; LAS float* AMT = (LAS float*)(gb + TILE_BYTES); LAS float* G = (LAS float*)(gb + TILE_BYTES + 64 * 68 * 4); LAS float* BETA = G + 64;
    const bf16* PB = (const bf16*)(a.ws + WS_PB); const float* ZF = (const float*)(a.ws + WS_ZF);
    bf16* UT = (bf16*)(a.ws + WS_UT); bf16* WW = (bf16*)(a.ws + WS_WW);
    const int rounds = (128 * 36 + 4 * w.G - 1) / (4 * w.G);
    for (int k = 0; k < rounds; ++k) {
        const int it = k * 4 * w.G + w.bid * 4 + sub;
        const bool live = it < 128 * 36;
        const int chain = live ? it / 36 : 0, c = live ? it - chain * 36 : 0; const int b = chain >> 3, h = (chain >> 1) & 3, dir = chain & 1;
        const int row0 = chain_row(b, dir, c, 0); const long sg = dir ? -1 : 1;
        float x[64];
        { const bf16* xp = PB + (size_t)row0 * NPB + (wv == 0 ? 512 : 256) + h * 64 + lane;
#pragma unroll
          for (int i = 0; i < 64; ++i) x[i] = bf2f(xp[sg * i * NPB]); }
        { const int i = t2 >> 1, hf = t2 & 1; const v4u* src = (const v4u*)(PB + (size_t)(row0 + sg * i) * NPB + 256 + h * 64 + 32 * hf);
          const v4u k0 = src[0], k1 = src[1], k2 = src[2], k3 = src[3]; LAS v4u* dst = (LAS v4u*)(TK + i * TS + 32 * hf); dst[0] = k0; dst[1] = k1; dst[2] = k2; dst[3] = k3; }
        if (wv == 0) { const int row = row0 + (int)sg * lane;
            const float al = expf(a.in[I_GDN_ALOG][(l * 2 + dir) * 4 + h]), dtb = a.in[I_GDN_DTB][(l * 2 + dir) * 4 + h];
            float g = -al * softplus_acc(ZF[(size_t)row * NZF + 512 + dir * 4 + h] + dtb);
#pragma unroll
            for (int o = 1; o < 64; o <<= 1) { const float y = __shfl_up(g, o); if (lane >= o) g += y; }
            G[lane] = g; BETA[lane] = sigmoid_acc(ZF[(size_t)row * NZF + 520 + dir * 4 + h]); }
        __syncthreads();
#pragma unroll
        for (int bi = 0; bi < 2; ++bi) { if (wv == 1 && bi == 1) break;
            const int wm = (wv == 1) ? 1 : bi, wn = (wv == 1) ? 0 : bi;
            f32x16 acc = zero16(); acc = mma64(acc, TK + 32 * wm * TS, TK + 32 * wn * TS, lane);
            const int j = 32 * wn + r; const float gj = G[j];
#pragma unroll
            for (int q = 0; q < 4; ++q) { const int i0 = 32 * wm + 8 * q + 4 * hh; const f32x4 gi = *(const LAS f32x4*)(G + i0), bi4 = *(const LAS f32x4*)(BETA + i0); f32x4 o;
#pragma unroll
                for (int t = 0; t < 4; ++t) o[t] = (j < i0 + t) ? bi4[t] * acc[4 * q + t] * __expf(gi[t] - gj) : 0.f;
                *(LAS f32x4*)(AMT + j * 68 + i0) = o; } }
        __syncthreads();
        {
#pragma unroll
            for (int i = 0; i < 64; i += 4) { const f32x4 gi = *(const LAS f32x4*)(G + i), bi4 = *(const LAS f32x4*)(BETA + i);
#pragma unroll
                for (int t = 0; t < 4; ++t) x[i + t] *= (wv == 0) ? bi4[t] : bi4[t] * __expf(gi[t]); }
#pragma unroll
            for (int j = 0; j < 63; ++j) { const float xj = x[j];
#pragma unroll
                for (int i4 = ((j + 1) >> 2) << 2; i4 < 64; i4 += 4) { const f32x4 av = *(const LAS f32x4*)(AMT + j * 68 + i4);
#pragma unroll
                    for (int t = 0; t < 4; ++t) if (i4 + t > j) x[i4 + t] -= av[t] * xj; } }
            if (live) {
                if (wv == 0) { bf16* dst = UT + ((size_t)(chain * 36 + c) * 64 + lane) * 64;
#pragma unroll
                    for (int q = 0; q < 8; ++q) { v4u o; o.x = cvt_pk_bf16(x[8 * q], x[8 * q + 1]); o.y = cvt_pk_bf16(x[8 * q + 2], x[8 * q + 3]); o.z = cvt_pk_bf16(x[8 * q + 4], x[8 * q + 5]); o.w = cvt_pk_bf16(x[8 * q + 6], x[8 * q + 7]); *(v4u*)(dst + 8 * q) = o; } }
                else { bf16* dst = WW + (size_t)(chain * 36 + c) * 4096 + lane;
#pragma unroll
                    for (int j = 0; j < 64; ++j) dst[j * 64] = (bf16)f2bf(x[j]); }
            }
        }
        __syncthreads();
    }
}
#define LBAR() asm volatile("s_waitcnt lgkmcnt(0)\n\ts_barrier" ::: "memory")
__device__ __forceinline__ void phase_scan_chunk(const Args& a, LAS unsigned char* lds, const WCtx& w, int l) {
    const int grp = w.tid >> 8, tl = w.tid & 255, gw4 = w.wave & 3, wm = gw4 >> 1, wn = gw4 & 1, lane = w.lane, r = lane & 31, hh = lane >> 5;
    const int dir = grp;
    LAS unsigned char* gb = lds + grp * SCG_BYTES;
    LAS bf16* TQ = (LAS bf16*)gb; LAS bf16* TK = TQ + 64 * TS; LAS bf16* TX = TK + 64 * TS; LAS bf16* TKD = TX + 64 * TS; LAS bf16* TVT = TKD + 64 * TS; LAS bf16* TST = TVT + 64 * TS; LAS bf16* TP = TST + 64 * TS;
    LAS float* G = (LAS float*)(gb + 7 * TILE_BYTES); LAS float* EG = G + 64; LAS float* DEC = G + 128; LAS float* BD = G + 192; LAS float* QSUM = G + 256;
    const bf16* ZB = (const bf16*)(a.ws + WS_ZB); const float* ZF = (const float*)(a.ws + WS_ZF); const bf16* PB = (const bf16*)(a.ws + WS_PB); bf16* SO = (bf16*)(a.ws + WS_SO);
    const bf16* UT = (const bf16*)(a.ws + WS_UT); const bf16* WW = (const bf16*)(a.ws + WS_WW);
    for (int pi = w.bid; pi < 64; pi += w.G) {
        const int mix = 0, b = (pi & 63) >> 2, h = pi & 3;
        f32x16 S = zero16();
        bf16* so = SO + (size_t)(mix * 2 + dir) * MT * 256 + h * 64 + 32 * wn + r;
        {
            const int d = tl & 63, iq = tl >> 6;
            unsigned short rq[16], rv[16]; float rz[16];
#define GLA_LOAD(c_) do { const int row0_ = chain_row(b, dir, (c_), 16 * iq); const long sg_ = dir ? -1 : 1; \
                const bf16* pq_ = ZB + (size_t)row0_ * NZB + h * 64 + d; const float* pz_ = ZF + (size_t)row0_ * NZF + dir * 256 + h * 64 + d; \
                _Pragma("unroll") for (int ii = 0; ii < 16; ++ii) rq[ii] = pq_[sg_ * ii * NZB]; asm volatile("" ::: "memory"); \
                _Pragma("unroll") for (int ii = 0; ii < 16; ++ii) rv[ii] = pq_[sg_ * ii * NZB + 256]; asm volatile("" ::: "memory"); \
                _Pragma("unroll") for (int ii = 0; ii < 16; ++ii) rz[ii] = pz_[sg_ * ii * NZF]; asm volatile("" ::: "memory"); } while (0)
            GLA_LOAD(0);
            for (int c = 0; c < 36; ++c) {
                float lc[16], kk[16], qq[16], vvv[16]; float run = 0.f;
#pragma unroll
                for (int ii = 0; ii < 16; ++ii) { kk[ii] = 1.0f - __expf(rz[ii]); run += rz[ii]; lc[ii] = run; qq[ii] = bf2f(rq[ii]); vvv[ii] = bf2f(rv[ii]); }
                QSUM[iq * 64 + d] = run;
                LBAR();
                const float s0 = QSUM[d], s1 = QSUM[64 + d], s2 = QSUM[128 + d], s3 = QSUM[192 + d];
                const float off = (iq > 0 ? s0 : 0.f) + (iq > 1 ? s1 : 0.f) + (iq > 2 ? s2 : 0.f), g31 = s0 + s1, g63 = g31 + s2 + s3;
                { float kd[16];
                  const float e2 = __expf(g63 - g31);
#pragma unroll
                  for (int ii = 0; ii < 16; ++ii) { const int i = 16 * iq + ii; const float gi = off + lc[ii]; const float ea = __expf(gi), eb = expc(g31 - gi);
                      TQ[i * TS + d] = bfr(qq[ii] * ea);
                      TK[i * TS + d] = bfr(kk[ii] * eb);
                      if (iq >= 2) TX[(i - 32) * TS + d] = bfr(qq[ii] * __builtin_amdgcn_rcpf(eb));
                      else TX[(32 + i) * TS + d] = bfr(kk[ii] * __builtin_amdgcn_rcpf(fmaxf(ea, 1e-35f)));
                      kd[ii] = kk[ii] * eb * e2; }
                  v4u o0, o1; o0.x = cvt_pk_bf16(kd[0], kd[1]); o0.y = cvt_pk_bf16(kd[2], kd[3]); o0.z = cvt_pk_bf16(kd[4], kd[5]); o0.w = cvt_pk_bf16(kd[6], kd[7]);
                  o1.x = cvt_pk_bf16(kd[8], kd[9]); o1.y = cvt_pk_bf16(kd[10], kd[11]); o1.z = cvt_pk_bf16(kd[12], kd[13]); o1.w = cvt_pk_bf16(kd[14], kd[15]);
                  *(LAS v4u*)(TKD + swz(d, 16 * iq)) = o0; *(LAS v4u*)(TKD + swz(d, 16 * iq + 8)) = o1;
                  o0.x = cvt_pk_bf16(vvv[0], vvv[1]); o0.y = cvt_pk_bf16(vvv[2], vvv[3]); o0.z = cvt_pk_bf16(vvv[4], vvv[5]); o0.w = cvt_pk_bf16(vvv[6], vvv[7]);
                  o1.x = cvt_pk_bf16(vvv[8], vvv[9]); o1.y = cvt_pk_bf16(vvv[10], vvv[11]); o1.z = cvt_pk_bf16(vvv[12], vvv[13]); o1.w = cvt_pk_bf16(vvv[14], vvv[15]);
                  *(LAS v4u*)(TVT + swz(d, 16 * iq)) = o0; *(LAS v4u*)(TVT + swz(d, 16 * iq + 8)) = o1;
                  if (iq == 0) DEC[d] = __expf(g63); }
                store_state_T(TST, S, wm, wn, r, hh);
                if (c + 1 < 36) GLA_LOAD(c + 1);
                LBAR();
                { f32x16 acc = zero16();
                  if (wn >= wm) { const LAS bf16* Ap = (wm == 0 && wn == 0) ? TX + 32 * TS : TK + 32 * wm * TS; const LAS bf16* Bp = (wn == 0) ? TQ : TX;
                      acc = mma64(acc, Ap, Bp, lane); }
                  const int i = 32 * wn + r;
#pragma unroll
                  for (int q = 0; q < 4; ++q) { const int j0 = 32 * wm + 8 * q + 4 * hh;
                      st4bf(TP + i * TS + j0, (j0 <= i) ? acc[4 * q] : 0.f, (j0 + 1 <= i) ? acc[4 * q + 1] : 0.f, (j0 + 2 <= i) ? acc[4 * q + 2] : 0.f, (j0 + 3 <= i) ? acc[4 * q + 3] : 0.f); } }
                LBAR();
                { bf16* sop = so + (size_t)chain_row(b, dir, c, 32 * wm + 4 * hh) * 256; const long sstep = dir ? -256 : 256;
                  f32x16 o = zero16(); o = mma64s<false, true>(o, TP, wm, TVT, wn, lane); o = mma64(o, TQ + 32 * wm * TS, TST + 32 * wn * TS, lane);
                  f32x16 ds = zero16(); ds = mma64s<true, true>(ds, TKD, wm, TVT, wn, lane);
#pragma unroll
                  for (int q = 0; q < 4; ++q) { const f32x4 dv = *(const LAS f32x4*)(DEC + 32 * wm + 8 * q + 4 * hh);
#pragma unroll
                      for (int t = 0; t < 4; ++t) { S[4 * q + t] = dv[t] * S[4 * q + t] + ds[4 * q + t]; sop[(long)(8 * q + t) * sstep] = bfr(o[4 * q + t]); } } }
                LBAR();
            }
#undef GLA_LOAD
        }
    }
    for (int pi = w.bid; pi < 192; pi += w.G) {
        if (pi < 64) continue;
        const int mix = pi >> 6, b = (pi & 63) >> 2, h = pi & 3;
        const int chain = (b * 4 + h) * 2 + dir;
        f32x16 S = zero16();
        bf16* so = SO + (size_t)(mix * 2 + dir) * MT * 256 + h * 64 + 32 * wn + r;
        {
            const int i = tl >> 2, dq = tl & 3;
            const float al = expf(mix == 1 ? a.in[I_GDN_ALOG][(l * 2 + dir) * 4 + h] : a.in[I_SSD_ALOG][(l * 2 + dir) * 4 + h]);
            const float dtb = mix == 1 ? a.in[I_GDN_DTB][(l * 2 + dir) * 4 + h] : a.in[I_SSD_DTB][(l * 2 + dir) * 4 + h];
            v4u rq0s[2], rq1s[2], rk0s[2], rk1s[2], ra0s[2], ra1s[2], rb0s[2], rb1s[2]; float rs0s[2] = {0.f, 0.f}, rs1s[2] = {0.f, 0.f};
#pragma unroll
            for (int u = 0; u < 2; ++u) { rq0s[u] = rq1s[u] = rk0s[u] = rk1s[u] = ra0s[u] = ra1s[u] = rb0s[u] = rb1s[u] = (v4u){0u, 0u, 0u, 0u}; }
#define SD_LOAD(c_, u_) do { const int row_ = chain_row(b, dir, (c_), i); \
                if (mix == 1) { const v4u* pq_ = (const v4u*)(PB + (size_t)row_ * NPB + h * 64 + 16 * dq); const v4u* pk_ = (const v4u*)(PB + (size_t)row_ * NPB + 256 + h * 64 + 16 * dq); rq0s[u_] = pq_[0]; rq1s[u_] = pq_[1]; rk0s[u_] = pk_[0]; rk1s[u_] = pk_[1]; \
                    const v4u* pw_ = (const v4u*)(WW + (size_t)(chain * 36 + (c_)) * 4096 + i * 64 + 16 * dq); const v4u* pu_ = (const v4u*)(UT + (size_t)(chain * 36 + (c_)) * 4096 + i * 64 + 16 * dq); ra0s[u_] = pw_[0]; ra1s[u_] = pw_[1]; rb0s[u_] = pu_[0]; rb1s[u_] = pu_[1]; } \
                else { const v4u* pq_ = (const v4u*)(PB + (size_t)row_ * NPB + 768 + 384 + (h >> 1) * 64 + 16 * dq); const v4u* pk_ = (const v4u*)(PB + (size_t)row_ * NPB + 768 + 256 + (h >> 1) * 64 + 16 * dq); rq0s[u_] = pq_[0]; rq1s[u_] = pq_[1]; rk0s[u_] = pk_[0]; rk1s[u_] = pk_[1]; \
                    const v4u* pv_ = (const v4u*)(PB + (size_t)row_ * NPB + 768 + h * 64 + 16 * dq); ra0s[u_] = pv_[0]; ra1s[u_] = pv_[1]; } \
                if (gw4 == 0) { const int rj_ = chain_row(b, dir, (c_), lane); if (mix == 1) { rs0s[u_] = ZF[(size_t)rj_ * NZF + 512 + dir * 4 + h]; rs1s[u_] = ZF[(size_t)rj_ * NZF + 520 + dir * 4 + h]; } else rs0s[u_] = ZF[(size_t)rj_ * NZF + 528 + dir * 4 + h]; } } while (0)
            SD_LOAD(0, 0); SD_LOAD(1, 1);
            for (int c2 = 0; c2 < 36; c2 += 2) {
#pragma unroll
            for (int u = 0; u < 2; ++u) { const int c = c2 + u;
                if (gw4 == 0) { const float sp = softplus_acc(rs0s[u] + dtb); float g = -al * sp;
#pragma unroll
                    for (int o = 1; o < 64; o <<= 1) { const float y = __shfl_up(g, o); if (lane >= o) g += y; }
                    G[lane] = g; EG[lane] = __expf(g); BD[lane] = (mix == 1) ? sigmoid_acc(rs1s[u]) : sp; }
                LBAR();
                { const float gi = G[i], g63 = G[63]; const float kdsc = __expf(g63 - gi), vsc = (mix == 2) ? BD[i] : 1.0f;
                  const int colsw = ((((i >> 3) ^ dq) << 3) | (i & 7)); LAS bf16* kdb = TKD + 16 * dq * TS + colsw; LAS bf16* vtb = TVT + 16 * dq * TS + colsw;
                  *(LAS v4u*)(TQ + i * TS + 16 * dq) = rq0s[u]; *(LAS v4u*)(TQ + i * TS + 16 * dq + 8) = rq1s[u];
                  *(LAS v4u*)(TK + i * TS + 16 * dq) = rk0s[u]; *(LAS v4u*)(TK + i * TS + 16 * dq + 8) = rk1s[u];
                  float kf[8];
                  unpack8(rk0s[u], kf);
#pragma unroll
                  for (int t = 0; t < 8; ++t) kdb[t * TS] = bfr(kf[t] * kdsc);
                  unpack8(rk1s[u], kf);
#pragma unroll
                  for (int t = 0; t < 8; ++t) kdb[(8 + t) * TS] = bfr(kf[t] * kdsc);
                  if (mix == 2) { unpack8(ra0s[u], kf);
#pragma unroll
                      for (int t = 0; t < 8; ++t) vtb[t * TS] = bfr(kf[t] * vsc);
                      unpack8(ra1s[u], kf);
#pragma unroll
                      for (int t = 0; t < 8; ++t) vtb[(8 + t) * TS] = bfr(kf[t] * vsc); }
                  else { *(LAS v4u*)(TX + i * TS + 16 * dq) = ra0s[u]; *(LAS v4u*)(TX + i * TS + 16 * dq + 8) = ra1s[u];
                         *(LAS v4u*)(TVT + swz(i, 16 * dq)) = rb0s[u]; *(LAS v4u*)(TVT + swz(i, 16 * dq + 8)) = rb1s[u]; } }
                store_state_T(TST, S, wm, wn, r, hh);
                if (c + 2 < 36) SD_LOAD(c + 2, u);
                LBAR();
                { f32x16 acc = zero16();
                  if (wn >= wm) acc = mma64(acc, TK + 32 * wm * TS, TQ + 32 * wn * TS, lane);
                  const int ii = 32 * wn + r; const float gi = G[ii];
#pragma unroll
                  for (int q = 0; q < 4; ++q) { const int j0 = 32 * wm + 8 * q + 4 * hh; const f32x4 gj = *(const LAS f32x4*)(G + j0); float pv[4];
#pragma unroll
                      for (int t = 0; t < 4; ++t) pv[t] = (j0 + t <= ii) ? acc[4 * q + t] * __expf(gi - gj[t]) : 0.f;
                      st4bf(TP + ii * TS + j0, pv[0], pv[1], pv[2], pv[3]); }
                  if (mix == 1) { f32x16 ws_ = zero16(); ws_ = mma64(ws_, TX + 32 * wm * TS, TST + 32 * wn * TS, lane);
#pragma unroll
                      for (int q = 0; q < 4; ++q) { LAS bf16* up = TVT + swz(32 * wn + r, 32 * wm + 8 * q + 4 * hh); const v2u uu = *(const LAS v2u*)up;
                          st4bf(up, bf2f(uu.x & 0xffffu) - ws_[4 * q], bf2f(uu.x >> 16) - ws_[4 * q + 1], bf2f(uu.y & 0xffffu) - ws_[4 * q + 2], bf2f(uu.y >> 16) - ws_[4 * q + 3]); } } }
                LBAR();
                { bf16* sop = so + (size_t)chain_row(b, dir, c, 32 * wm + 4 * hh) * 256; const long sstep = dir ? -256 : 256;
                  f32x16 o = zero16(); o = mma64s<false, true>(o, TP, wm, TVT, wn, lane);
                  f32x16 qs = zero16(); qs = mma64(qs, TQ + 32 * wm * TS, TST + 32 * wn * TS, lane);
                  f32x16 ds = zero16(); ds = mma64s<true, true>(ds, TKD, wm, TVT, wn, lane);
                  const float dsc = EG[63];
#pragma unroll
                  for (int q = 0; q < 4; ++q) { const f32x4 eg = *(const LAS f32x4*)(EG + 32 * wm + 8 * q + 4 * hh);
#pragma unroll
                      for (int t = 0; t < 4; ++t) { S[4 * q + t] = dsc * S[4 * q + t] + ds[4 * q + t]; sop[(long)(8 * q + t) * sstep] = bfr(o[4 * q + t] + eg[t] * qs[4 * q + t]); } } }
                LBAR();
            } }
#undef SD_LOAD
        }
    }
}

constexpr size_t WS_TW = WS_LB + 65536;
__device__ __forceinline__ int fpad(int i) { return i + ((i >> 7) << 3); }
__device__ __forceinline__ void cst16(int k, float& c, float& s) {
    constexpr float C[8] = {1.0f, 0.92387953251128674f, 0.70710678118654752f, 0.38268343236508977f, 0.0f, -0.38268343236508977f, -0.70710678118654752f, -0.92387953251128674f};
    constexpr float S[8] = {0.0f, -0.38268343236508977f, -0.70710678118654752f, -0.92387953251128674f, -1.0f, -0.92387953251128674f, -0.70710678118654752f, -0.38268343236508977f};
    c = C[k]; s = S[k]; }
template <int LOGN, int S0, int R, int NCOL>
__device__ __forceinline__ void fft_pass(LAS float* XR, LAS float* XI, const float* TW, int tid) {
    constexpr int N = 1 << LOGN, G = 1 << R, STR = N >> (S0 + R), NGC = N / G, CS = N + 8 * (N / 128);
    for (int gi = tid; gi < NCOL * NGC; gi += NTHREADS) {
        const int col = gi / NGC, g = gi - col * NGC, lo = g & (STR - 1), hi = g / STR;
        const int i0 = hi * (STR * G) + lo;
        LAS float* xr = XR + col * CS; LAS float* xi = XI + col * CS;
        float er[G], ei[G];
        if constexpr (STR == 1) {
#pragma unroll
            for (int m = 0; m < G; m += 4) { const f32x4 a = *(const LAS f32x4*)(xr + fpad(i0) + m), b = *(const LAS f32x4*)(xi + fpad(i0) + m);
#pragma unroll
                for (int t = 0; t < 4; ++t) { er[m + t] = a[t]; ei[m + t] = b[t]; } }
        } else {
#pragma unroll
            for (int m = 0; m < G; ++m) { er[m] = xr[fpad(i0 + STR * m)]; ei[m] = xi[fpad(i0 + STR * m)]; }
        }
#pragma unroll
        for (int t = 0; t < R; ++t) {
            constexpr int dummy = 0; (void)dummy;
            const int hs = G >> (t + 1), s = S0 + t;
            float wlr = 1.0f, wli = 0.0f;
            if constexpr (STR > 1) { const int ti = (lo << s) * (2048 / N); wlr = TW[2 * ti]; wli = TW[2 * ti + 1]; }
#pragma unroll
            for (int blk = 0; blk < G; blk += 2 * hs)
#pragma unroll
                for (int q = 0; q < hs; ++q) {
                    const float ar = er[blk + q], ai = ei[blk + q], br = er[blk + q + hs], bi = ei[blk + q + hs];
                    const float dr = ar - br, di = ai - bi;
                    er[blk + q] = ar + br; ei[blk + q] = ai + bi;
                    float cr, ci; cst16((q << t) * (16 / G), cr, ci);
                    float tr, tim;
                    if (q == 0) { tr = wlr; tim = wli; } else if constexpr (STR == 1) { tr = cr; tim = ci; } else { tr = wlr * cr - wli * ci; tim = wlr * ci + wli * cr; }
                    er[blk + q + hs] = dr * tr - di * tim; ei[blk + q + hs] = dr * tim + di * tr;
                }
        }
        if constexpr (STR == 1) {
#pragma unroll
            for (int m = 0; m < G; m += 4) { *(LAS f32x4*)(xr + fpad(i0) + m) = (f32x4){er[m], er[m + 1], er[m + 2], er[m + 3]}; *(LAS f32x4*)(xi + fpad(i0) + m) = (f32x4){ei[m], ei[m + 1], ei[m + 2], ei[m + 3]}; }
        } else {
#pragma unroll
            for (int m = 0; m < G; ++m) { xr[fpad(i0 + STR * m)] = er[m]; xi[fpad(i0 + STR * m)] = ei[m]; }
        }
    }
}
template <int LOGN, int NCOL>
__device__ __forceinline__ void fft_items(const Args& a, LAS unsigned char* lds, const WCtx& w, const bf16* VT, float* FO, int rowbase0, float scale) {
    constexpr int N = 1 << LOGN, CS = N + 8 * (N / 128), NCG = 256 / NCOL, TPC = NTHREADS / NCOL;
    LAS float* XR = (LAS float*)lds; LAS float* XI = XR + NCOL * CS; const float* TW = (const float*)(a.ws + WS_TW);
    const int c = w.tid / TPC, j = w.tid - c * TPC;
    for (int it = w.bid; it < 16 * NCG; it += w.G) {
        const int b = it / NCG, cg = it - b * NCG, ch = cg * NCOL + c;
        const bf16* src = VT + (size_t)(b * 256 + ch) * (2 * N);
        for (int m = j; m < N / 8; m += TPC) {
            const v4u vr = *(const v4u*)(src + 8 * m), vi = *(const v4u*)(src + N + 8 * m); float f[8];
            unpack8(vr, f); *(LAS f32x4*)(XR + c * CS + fpad(8 * m)) = (f32x4){f[0], f[1], f[2], f[3]}; *(LAS f32x4*)(XR + c * CS + fpad(8 * m) + 4) = (f32x4){f[4], f[5], f[6], f[7]};
            unpack8(vi, f); *(LAS f32x4*)(XI + c * CS + fpad(8 * m)) = (f32x4){f[0], f[1], f[2], f[3]}; *(LAS f32x4*)(XI + c * CS + fpad(8 * m) + 4) = (f32x4){f[4], f[5], f[6], f[7]}; }
        __syncthreads();
        if constexpr (LOGN == 11) { fft_pass<11, 0, 4, NCOL>(XR, XI, TW, w.tid); __syncthreads(); fft_pass<11, 4, 4, NCOL>(XR, XI, TW, w.tid); __syncthreads(); fft_pass<11, 8, 3, NCOL>(XR, XI, TW, w.tid); }
        else { fft_pass<8, 0, 4, NCOL>(XR, XI, TW, w.tid); __syncthreads(); fft_pass<8, 4, 4, NCOL>(XR, XI, TW, w.tid); }
        __syncthreads();
        { const int oc = w.tid % NCOL, k0 = w.tid / NCOL; float* dst = FO + (size_t)(rowbase0 + b * N) * 256 + cg * NCOL + oc;
          for (int kt = k0; kt < N; kt += TPC) { const int br_ = (int)(__brev((unsigned)kt) >> (32 - LOGN)); dst[(size_t)kt * 256] = XR[oc * CS + fpad(br_)] * scale; } }
        __syncthreads();
    }
}
__device__ __forceinline__ void phase_fourier_time(const Args& a, LAS unsigned char* lds, const WCtx& w) {
    fft_items<11, 8>(a, lds, w, (const bf16*)(a.ws + WS_VTL), (float*)(a.ws + WS_FO), 0, 0.0027621358640099515f);
    fft_items<8, 32>(a, lds, w, (const bf16*)(a.ws + WS_VTC), (float*)(a.ws + WS_FO), ML, 0.0078125f);
}
constexpr int PPL = 13;
constexpr int N_PHASES = 2 + PPL * DEPTH;
#ifndef PHMASK
#define PHMASK 0xFFFFu
#endif
#define EN(k) (((PHMASK) >> (k)) & 1u)
__global__ void __launch_bounds__(NTHREADS, 2) fwd_kernel(Args args) {
    extern __shared__ __attribute__((aligned(16))) unsigned char lds_raw[];
    LAS unsigned char* lds = (LAS unsigned char*)lds_raw;
#define MKW() WCtx w; { int t_ = threadIdx.x; asm volatile("" : "+v"(t_)); w.tid = t_; w.lane = t_ & 63; w.wave = __builtin_amdgcn_readfirstlane(t_ >> 6); { int b_ = blockIdx.x; asm volatile("" : "+s"(b_)); w.bid = b_; } { int g_ = gridDim.x; asm volatile("" : "+s"(g_)); w.G = g_; } w.gw = w.bid * NWAVES + w.wave; w.NGW = w.G * NWAVES; } \
              unsigned char* ws = args.ws; asm volatile("" : "+s"(ws)); const int c = w.bid; (void)c; (void)ws
    for (int u = threadIdx.x; u < (LDS_BYTES - LDSCTL_OFF) / 4; u += NTHREADS) ((LAS unsigned*)(lds + LDSCTL_OFF))[u] = 0u;
    __syncthreads();
    XcdBarrier bar = xcd_barrier_post((unsigned*)(args.ws + WS_CTL) + CW_BAR + args.li * XCD_BAR_WORDS, (volatile LAS unsigned*)(lds + MISC_OFF) + 8);
    const int lo = args.ph_lo, hi = args.ph_hi;
#define INP(k) (lo <= (k) && (k) < hi)
#define SEAM(k) do { if (INP(k) && INP((k) + 1)) xcd_barrier(bar); } while (0)
#ifdef PROBE_MASK
    unsigned long long pr_prev = __builtin_amdgcn_s_memrealtime(), pr_acc = 0ull;
#define STAMP(slot) do { const unsigned long long n_ = __builtin_amdgcn_s_memrealtime(); if (((PROBE_MASK) >> (slot)) & 1u) pr_acc += n_ - pr_prev; pr_prev = n_; } while (0)
#else
#define STAMP(slot) do { } while (0)
#endif
    if (EN(12) && INP(0)) { MKW(); phase_prologue(args, lds, w); }
    SEAM(0); STAMP(12);
    if (EN(13) && INP(1)) { MKW(); phase_mod_rows(args, w, 0); }
    SEAM(1); STAMP(13);
    for (int l = 0; l < DEPTH; ++l) {
        const int pb = 2 + PPL * l;
        const bool lastl = (l == DEPTH - 1);
        const int nrows = lastl ? ML : MT, nMr = nrows / 256;
        if (EN(0) && INP(pb + 0)) { MKW();
            { pg8::Order<MapPlain> S; S.init(MT / 256, 11, w.G, c); S.map = MapPlain{(const char*)(ws + WS_H), (const char*)(ws + WS_WIN), (size_t)256 * 1024 * 2, (size_t)256 * 1024 * 2};
              EpiZB E{(bf16*)(ws + WS_ZB)};
              pg8::gemm_phase<EpiZB, pg8::Order<MapPlain>>(lds, pg8::Gemm{1024, 1024, 1024}, S, E); }
            { pg8::Order<MapPlain> S; S.init(MT / 256, 3, w.G, w.G - 1 - c); S.map = MapPlain{(const char*)(ws + WS_H), (const char*)(ws + WS_WIN) + (size_t)11 * 256 * 1024 * 2, (size_t)256 * 1024 * 2, (size_t)256 * 1024 * 2};
              EpiZF E{(float*)(ws + WS_ZF), (const float*)(ws + WS_LB) + l * 256};
              pg8::gemm_phase<EpiZF, pg8::Order<MapPlain>>(lds, pg8::Gemm{1024, 1024, 1024}, S, E); }
        }
        SEAM(pb + 0); STAMP(0);
        if (EN(1) && INP(pb + 1)) { MKW();
            pg8::Order<MapPlain> S; S.init(2, MT / 256, w.G, c); S.map = MapPlain{(const char*)(ws + WS_DFT64), (const char*)(ws + WS_ZB) + 1792 * 2, (size_t)256 * 256 * 2, (size_t)256 * NZB * 2};
            EpiFour1 E{(bf16*)(ws + WS_VTL), (bf16*)(ws + WS_VTC)};
            pg8::gemm_phase<EpiFour1, pg8::Order<MapPlain>>(lds, pg8::Gemm{256, 256, NZB}, S, E);
            if (EN(15)) phase_prep(args, w, l);
        }
        SEAM(pb + 1); STAMP(1);
        if (EN(2) && INP(pb + 2)) { MKW();
            phase_fourier_time(args, lds, w);
            __syncthreads();
            if (EN(14)) phase_gdn_solve(args, lds, w, l);
            __syncthreads(); convert_rest(args, lds, w.wave, w.lane, w.gw, w.NGW, l, WI_XA, WI_XB);
        }
        SEAM(pb + 2); STAMP(2);
        if (EN(14) && INP(pb + 3)) { MKW();
            if (w.G > 192) { if (w.bid >= 192) convert_rest(args, lds, w.wave, w.lane, (w.bid - 192) * NWAVES + w.wave, (w.G - 192) * NWAVES, l, 0, WI_XA); else phase_scan_chunk(args, lds, w, l); }
            else { phase_scan_chunk(args, lds, w, l); __syncthreads(); convert_rest(args, lds, w.wave, w.lane, w.gw, w.NGW, l, 0, WI_XA); } }
        SEAM(pb + 3); STAMP(14);
        if (EN(3) && INP(pb + 4)) { MKW(); phase_finish(args, w, l, nrows); }
        SEAM(pb + 4); STAMP(3);
        if (EN(4) && INP(pb + 5)) { MKW();
            pg8::Order<MapP> S; S.init(nMr, 16, w.G, c); S.map = MapP{(const char*)(ws + WS_OUTS), (const char*)(ws + WS_WBR)};
            EpiP E{(bf16*)(ws + WS_P)};
            pg8::gemm_phase<EpiP, pg8::Order<MapP>>(lds, pg8::Gemm{256, 1024, 256}, S, E);
        }
        SEAM(pb + 5); STAMP(4);
        if (EN(5) && INP(pb + 6)) { MKW();
            pg8::Order<MapPlain> S; S.init(nMr, 16, w.G, c); S.map = MapPlain{(const char*)(ws + WS_H8), (const char*)(ws + WS_WG), (size_t)256 * 1024, (size_t)256 * 1024};
            EpiMerge E{(const bf16*)(ws + WS_P), (bf16*)(ws + WS_T), args.in[I_BGATE] + (size_t)l * 4096};
            pg8::gemm_phase<EpiMerge, pg8::Order<MapPlain>, true, true, false, 1>(lds, pg8::Gemm{1024, 1024, 1024, 0x79797979, 0x7F7F7F7F}, S, E);
        }
        SEAM(pb + 6); STAMP(5);
        if (EN(6) && INP(pb + 7)) { MKW();
            pg8::Order<MapPlain> S; S.init(nMr, 4, w.G, c); S.map = MapPlain{(const char*)(ws + WS_T), (const char*)(ws + WS_WOUT), (size_t)256 * 1024 * 2, (size_t)256 * 1024 * 2};
            EpiBf E{(bf16*)(ws + WS_Y), 1024, nullptr};
            pg8::gemm_phase<EpiBf, pg8::Order<MapPlain>>(lds, pg8::Gemm{1024, 1024, 1024}, S, E);
        }
        SEAM(pb + 7); STAMP(6);
        if (EN(7) && INP(pb + 8)) { MKW(); phase_ln1(args, lds, w, l, nrows); }
        SEAM(pb + 8); STAMP(7);
        if (EN(8) && INP(pb + 9)) { MKW(); phase_topk(args, lds, w, lastl ? 256 : 512); __syncthreads(); convert_rest(args, lds, w.wave, w.lane, w.gw, w.NGW, l, WI_XB, WI_REST); }
        SEAM(pb + 9); STAMP(8);
        const int nMe = lastl ? 256 : 288;
        if (EN(9) && INP(pb + 10)) { MKW();
            pg8::Order<MapMoEG> S; S.init(nMe, 8, w.G, c); S.map = MapMoEG{(const char*)(ws + WS_H), (const char*)(ws + WS_WGU), (size_t)2048 * 1024, (size_t)256 * 1024};
            EpiSwiGLU E{(unsigned char*)(ws + WS_HID)};
            pg8::gemm_phase<EpiSwiGLU, pg8::Order<MapMoEG>, true, true, true, 1>(lds, pg8::Gemm{1024, 1024, 1024, 0x79797979, 0x7F7F7F7F}, S, E, (const int*)(ws + WS_ROWW + 512 * 1024));
        }
        SEAM(pb + 10); STAMP(9);
        if (EN(10) && INP(pb + 11)) { MKW();
            pg8::Order<MapMoE> S; S.init(nMe, 4, w.G, c); S.map = MapMoE{(const char*)(ws + WS_HID), (const char*)(ws + WS_WDN), (size_t)1024 * 1024, (size_t)256 * 1024};
            EpiF8 E{(unsigned char*)(ws + WS_YE), (const float*)(ws + WS_ROWW)};
            pg8::gemm_phase<EpiF8, pg8::Order<MapMoE>, true, true, false, 1>(lds, pg8::Gemm{1024, 1024, 1024, 0x79797979, 0x7F7F7F7F}, S, E);
        }
        SEAM(pb + 11); STAMP(10);
        if (EN(11) && INP(pb + 12)) { MKW(); phase_ln2(args, lds, w, l, nrows); if (!lastl) { __syncthreads(); convert_win(args, lds, w.wave, w.lane, w.gw, w.NGW, l + 1); } }
        SEAM(pb + 12); STAMP(11);
    }
#ifdef PROBE_MASK
    if (blockIdx.x == 0 && threadIdx.x == 0) { const unsigned long long t0_ = __builtin_amdgcn_s_memrealtime(); while (__builtin_amdgcn_s_memrealtime() - t0_ < 4ull * pr_acc) __builtin_amdgcn_s_sleep(8); }
#endif
#undef INP
#undef SEAM
}

#ifndef MK_SPLIT
#define MK_SPLIT 0
#endif
extern "C" void kernel_launch(void* const* d_in, const int* in_sizes, int n_in, void* d_out, int out_size, void* d_ws, size_t ws_size, hipStream_t stream) {
    static int grid = 0;
    if (grid == 0) {
        if (n_in != 31 || out_size != ML * D || ws_size < WS_END) { fprintf(stderr, "kernel_launch: unexpected problem (n_in %d, out %d, ws %zu, need %zu)\n", n_in, out_size, ws_size, (size_t)WS_END); grid = -1; return; }
        int dev = 0, cus = 0, per_cu = 0;
        if (hipGetDevice(&dev) != hipSuccess || hipDeviceGetAttribute(&cus, hipDeviceAttributeMultiprocessorCount, dev) != hipSuccess) { grid = -1; return; }
        if (hipFuncSetAttribute((const void*)fwd_kernel, hipFuncAttributeMaxDynamicSharedMemorySize, LDS_BYTES) != hipSuccess) { fprintf(stderr, "kernel_launch: hipFuncSetAttribute failed\n"); grid = -1; return; }
        if (hipOccupancyMaxActiveBlocksPerMultiprocessor(&per_cu, (const void*)fwd_kernel, NTHREADS, LDS_BYTES) != hipSuccess || per_cu < 1) fprintf(stderr, "kernel_launch: occupancy query says %d\n", per_cu);
        (void)hipGetLastError();
        grid = cus;
    }
    if (grid < 0) return;
    if (hipMemsetAsync((char*)d_ws + WS_CTL, 0, CTL_ZERO_BYTES, stream) != hipSuccess) return;
    Args a{};
    for (int i = 0; i < 31; ++i) a.in[i] = (const float*)d_in[i];
    a.out = (float*)d_out; a.ws = (unsigned char*)d_ws;
#if MK_SPLIT
    for (int p = 0; p < N_PHASES; ++p) { a.ph_lo = p; a.ph_hi = p + 1; a.li = p; a.pad = 0; hipLaunchKernelGGL(fwd_kernel, dim3(grid), dim3(NTHREADS), LDS_BYTES, stream, a); }
#else
    a.ph_lo = 0; a.ph_hi = N_PHASES; a.li = 0; a.pad = 0;
    hipLaunchKernelGGL(fwd_kernel, dim3(grid), dim3(NTHREADS), LDS_BYTES, stream, a);
#endif
    const hipError_t le = hipPeekAtLastError();
    if (le != hipSuccess) fprintf(stderr, "kernel_launch: launch failed: %s\n", hipGetErrorName(le));
}
```

```cpp
#include <hip/hip_runtime.h>
#include <cstdio>
#include <cstdint>

#define LAS __attribute__((address_space(3)))
typedef unsigned short bf16;
typedef short bf16x8 __attribute__((ext_vector_type(8)));
typedef float f32x4 __attribute__((ext_vector_type(4)));
typedef float f32x2 __attribute__((ext_vector_type(2)));
typedef unsigned v4u __attribute__((ext_vector_type(4)));
typedef unsigned v2u __attribute__((ext_vector_type(2)));

constexpr int D = 1024, BATCH = 16, SEQ = 2048, CTXL = 256, DEPTH = 4, BW = 256, NH = 4, HD = 64, NE = 16, FF = 1024;
constexpr int ML = BATCH * SEQ, MC = BATCH * CTXL, MT = ML + MC;
constexpr int IN_COLS = 3352;
constexpr int NZB = 2816, NZF = 768;
constexpr int NPB = 1280;
constexpr float LN_EPS = 1e-6f;
constexpr float ALPHA = 1.681792830507429f;
constexpr int CAP_L = 256, CAP_C = 32;
constexpr int NWAVES = 8, NTHREADS = 512;

constexpr size_t MiB = 1u << 20;
constexpr size_t WS_CTL = 0, CTL_ZERO_BYTES = 1 * MiB;
constexpr size_t WS_MOD = 1 * MiB;
constexpr size_t WS_LB = 3 * MiB;
constexpr size_t WS_DFT64 = 4 * MiB;
constexpr size_t WS_DFTC = 5 * MiB;
constexpr size_t WS_DFTL = 6 * MiB;
constexpr size_t WS_AFF = 22 * MiB;
constexpr size_t WS_SLOT = 25 * MiB;
constexpr size_t WS_ROWW = 28 * MiB;
constexpr size_t WS_WIN = 32 * MiB;
constexpr size_t WS_WG = 39 * MiB;
constexpr size_t WS_WBR = 47 * MiB;
constexpr size_t WS_WOUT = 49 * MiB;
constexpr size_t WS_WGU = 51 * MiB;
constexpr size_t WS_WDN = 115 * MiB;
constexpr size_t WS_X = 147 * MiB;
constexpr size_t WS_H = 291 * MiB;
constexpr size_t WS_R1 = 364 * MiB;
constexpr size_t WS_ZB = WS_R1;
constexpr size_t WS_ZF = WS_R1 + 198 * MiB;
constexpr size_t WS_PB = WS_R1 + 306 * MiB;
constexpr size_t WS_SO = WS_R1 + 396 * MiB;
constexpr size_t WS_VTL = WS_R1 + 504 * MiB;
constexpr size_t WS_VTC = WS_R1 + 536 * MiB;
constexpr size_t WS_FO = WS_R1 + 540 * MiB;
constexpr size_t WS_OUTS = WS_R1 + 612 * MiB;
constexpr size_t WS_P = WS_R1;
constexpr size_t WS_T = WS_R1 + 288 * MiB;
constexpr size_t WS_Y = WS_R1 + 360 * MiB;
constexpr size_t WS_XE = WS_R1;
constexpr size_t WS_HID = WS_R1 + 144 * MiB;
constexpr size_t WS_YE = WS_R1 + 288 * MiB;
constexpr size_t WS_H8 = WS_R1 + 756 * MiB;
constexpr size_t WS_END = WS_R1 + 792 * MiB;
constexpr int CW_BAR = 4096;

constexpr int RING_BYTES = 131072;
constexpr int LDSCTL_OFF = 145408, MISC_OFF = LDSCTL_OFF + 320;
constexpr int LDS_BYTES = 147456;

__device__ __forceinline__ float bf2f(unsigned b) { return __uint_as_float(b << 16); }
__device__ __forceinline__ unsigned f2bf(float f) { unsigned u = __float_as_uint(f); return (u + 0x7fffu + ((u >> 16) & 1u)) >> 16; }
__device__ __forceinline__ unsigned pk2(float lo, float hi) { return f2bf(lo) | (f2bf(hi) << 16); }
__device__ __forceinline__ unsigned cvt_pk_bf16(float lo, float hi) { unsigned r; asm volatile("v_cvt_pk_bf16_f32 %0, %1, %2" : "=v"(r) : "v"(lo), "v"(hi)); return r; }
__device__ __forceinline__ float wave_sum(float v) {
#pragma unroll
    for (int o = 1; o < 64; o <<= 1) v += __shfl_xor(v, o);
    return v;
}
__device__ __forceinline__ float sigmoid_fast(float x) { return __builtin_amdgcn_rcpf(1.0f + __expf(-x)); }
__device__ __forceinline__ float sigmoid_acc(float x) { return 1.0f / (1.0f + expf(-x)); }
__device__ __forceinline__ float silu_acc(float x) { return x / (1.0f + expf(-x)); }
__device__ __forceinline__ float softplus_acc(float x) { return x > 20.f ? x : log1pf(expf(x)); }
#define LDS_WAIT() asm volatile("s_waitcnt lgkmcnt(0)" ::: "memory")
#define VM_WAIT() asm volatile("s_waitcnt vmcnt(0)" ::: "memory")

namespace pg8 {
constexpr int BM = 256, BK = 64, HALF = 128, HTB = HALF * BK * 2, STAGE_BYTES = 8 * HTB, NXCD = 8, WGM = 8;
__host__ __device__ __forceinline__ int lds_byte(int r, int c) { const int st = (r >> 4) * 2 + (c >> 5), rr = r & 15, cc = c & 31, ob = rr * 64 + cc * 2; return st * 1024 + (ob ^ (((ob >> 9) & 1) << 5)); }
__host__ __device__ __forceinline__ void stage_rc(int b, int& R, int& C) { const int st = b / 1024, sb = b % 1024, swz = sb ^ (((sb >> 9) & 1) << 5); R = (st >> 1) * 16 + swz / 64; C = (st & 1) * 32 + (swz % 64) / 2; }
__host__ __device__ __forceinline__ int perm32(int rho) { const int n = rho >> 4, i = rho & 15; return 8 * (i >> 2) + 4 * n + (i & 3); }

struct Unit { int pm, pn; const char* A; const char* B; };
struct Gemm { int K, lda, ldb; int sw = 0x7F7F7F7F, sx = 0x7F7F7F7F; };
typedef int v8i __attribute__((ext_vector_type(8)));
typedef int v4i __attribute__((ext_vector_type(4)));

template <class Map> struct Order {
    int nM, nN, nwg, G, c; Map map;
    __device__ __forceinline__ void init(int nM_, int nN_, int G_, int c_) { nM = nM_; nN = nN_; nwg = nM * nN; G = G_; c = c_; }
    __device__ __forceinline__ bool next(int i, Unit& u) const {
        const long L = (long)i * G + c; if (L >= nwg) return false;
        int wgid = (int)L; { const int q = nwg / NXCD, r = nwg % NXCD, xcd = wgid % NXCD, off = wgid / NXCD; wgid = (xcd < r ? xcd * (q + 1) : r * (q + 1) + (xcd - r) * q) + off; }
        const int nig = WGM * nN, gid = wgid / nig, fm = gid * WGM, gsz = (nM - fm) < WGM ? (nM - fm) : WGM;
        u.pm = fm + ((wgid % nig) % gsz); u.pn = (wgid % nig) / gsz; map(u); return true;
    }
    __device__ __forceinline__ void a_ready(const Unit&) const {}
    __device__ __forceinline__ void done(const Unit&) const {}
};

template <class Epi, class Sched, bool ALIGN_EPI = true, bool SP2 = true, bool GATHER = false, int ESZ = 2>
__device__ __forceinline__ void gemm_phase(LAS unsigned char* lds, const Gemm g, const Sched& S, const Epi& E, const int* selrow = nullptr) {
    int tid_ = threadIdx.x; asm volatile("" : "+v"(tid_));
    const int tid = tid_, wid = __builtin_amdgcn_readfirstlane(tid >> 6), lane = tid & 63, wr = wid >> 2, wc = wid & 3, fr = lane & 15, fq = lane >> 4;
    constexpr bool FP8 = (ESZ == 1);
    const int K = g.K, nt = K * ESZ / (BK * 2);
    unsigned voffA[2], voffB[2]; int gR[2]; unsigned gC2[2];
#pragma unroll
    for (int i = 0; i < 2; ++i) { int R, C; stage_rc(tid * 16 + i * 8192, R, C); const int Rb = Epi::PERM ? ((R & ~31) + perm32(R & 31)) : R;
        voffA[i] = (unsigned)(R * g.lda * ESZ + C * 2); voffB[i] = (unsigned)(Rb * g.ldb * ESZ + C * 2); gR[i] = R; gC2[i] = (unsigned)C * 2u; }
    unsigned gc0[2] = {voffA[0], voffA[1]}, gc1[2] = {voffA[0], voffA[1]};
    int gn0r[2] = {0, 0}, gn1r[2] = {0, 0};
    const size_t kstep = (size_t)(BK * 2);
    const size_t hstepA = GATHER ? (size_t)0 : (size_t)HALF * g.lda * ESZ, hstepB = (size_t)HALF * g.ldb * ESZ;
    const unsigned ldsw = (unsigned)wid * 1024u;
    const int aoff = lds_byte(wr * 64 + fr, FP8 ? fq * 16 : fq * 8), boff = lds_byte(wc * 32 + fr, FP8 ? fq * 16 : fq * 8);
    const int sel8 = FP8 ? ((fq & 1) << 4) : 0; const int aoff1 = aoff + sel8, aoff2 = aoff + 16 - sel8, boff1 = boff + sel8, boff2 = boff + 16 - sel8;
#define PG8_SA(b, h) (((b) * 2 + (h)) * HTB)
#define PG8_SB(b, h) ((4 + (b) * 2 + (h)) * HTB)
#define PG8_STAGE(bufoff, gbase, voff) do { _Pragma("unroll") for (int _i = 0; _i < 2; ++_i) \
        __builtin_amdgcn_global_load_lds((const unsigned*)((const char*)(gbase) + (voff)[_i]), (LAS unsigned*)(lds + (bufoff) + ldsw + _i * 8192), 16, 0, 0); } while (0)
#define PG8_CAT(p_, q_) __builtin_shufflevector(*(const LAS v4i*)(p_), *(const LAS v4i*)(q_), 0, 1, 2, 3, 4, 5, 6, 7)
#define PG8_LDA(dst, b, h) do { if constexpr (FP8) { _Pragma("unroll") for (int m = 0; m < 4; ++m) dst##8[m] = PG8_CAT(lds + PG8_SA(b, h) + aoff1 + m * 2048, lds + PG8_SA(b, h) + aoff2 + m * 2048); } \
        else { _Pragma("unroll") for (int m = 0; m < 4; ++m) _Pragma("unroll") for (int k = 0; k < 2; ++k) dst[m][k] = *(const LAS bf16x8*)(lds + PG8_SA(b, h) + aoff + m * 2048 + k * 1024); } } while (0)
#define PG8_LDB(dst, b, h) do { if constexpr (FP8) { _Pragma("unroll") for (int n = 0; n < 2; ++n) dst##8[n] = PG8_CAT(lds + PG8_SB(b, h) + boff1 + n * 2048, lds + PG8_SB(b, h) + boff2 + n * 2048); } \
        else { _Pragma("unroll") for (int n = 0; n < 2; ++n) _Pragma("unroll") for (int k = 0; k < 2; ++k) dst[n][k] = *(const LAS bf16x8*)(lds + PG8_SB(b, h) + boff + n * 2048 + k * 1024); } } while (0)
#define PG8_MMA(ai, bj, At, Bt) do { __builtin_amdgcn_s_setprio(1); \
        if constexpr (FP8) { _Pragma("unroll") for (int m = 0; m < 4; ++m) _Pragma("unroll") for (int n = 0; n < 2; ++n) \
            asm volatile("v_mfma_scale_f32_16x16x128_f8f6f4 %0, %1, %2, %0, %3, %4 op_sel_hi:[0,0,0]" : "+v"(acc[ai][bj][m][n]) : "v"(Bt##8[n]), "v"(At##8[m]), "v"(vsw), "v"(vsx)); } \
        else { _Pragma("unroll") for (int m = 0; m < 4; ++m) _Pragma("unroll") for (int n = 0; n < 2; ++n) _Pragma("unroll") for (int k = 0; k < 2; ++k) \
            acc[ai][bj][m][n] = __builtin_amdgcn_mfma_f32_16x16x32_bf16(Bt[n][k], At[m][k], acc[ai][bj][m][n], 0, 0, 0); } \
        __builtin_amdgcn_s_setprio(0); } while (0)
#define PG8_WAIT_V(n) asm volatile("s_waitcnt vmcnt(" #n ")" ::: "memory")
#define PG8_WAIT_L(n) asm volatile("s_waitcnt lgkmcnt(" #n ")" ::: "memory")
#define PG8_BAR __builtin_amdgcn_s_barrier()
#define PG8_SCHED __builtin_amdgcn_sched_barrier(0)
    Unit cur, nxt; int ui = 0;
    if (!S.next(0, cur)) return;
    f32x4 acc[2][2][4][2];
#pragma unroll
    for (int a = 0; a < 2; ++a)
#pragma unroll
        for (int b = 0; b < 2; ++b)
#pragma unroll
            for (int m = 0; m < 4; ++m)
#pragma unroll
                for (int n = 0; n < 2; ++n) acc[a][b][m][n] = (f32x4){0.f, 0.f, 0.f, 0.f};
    bf16x8 At[4][2], B0[2][2], B1[2][2];
    v8i At8[4], B08[2], B18[2];
    const int vsw = g.sw, vsx = g.sx;
    const char* cA = cur.A; const char* cB = cur.B;
    S.a_ready(cur);
    if constexpr (GATHER) {
#pragma unroll
        for (int i = 0; i < 2; ++i) { gc0[i] = (unsigned)selrow[cur.pm * 256 + gR[i]] * (unsigned)(g.lda * ESZ) + gC2[i]; gc1[i] = (unsigned)selrow[cur.pm * 256 + 128 + gR[i]] * (unsigned)(g.lda * ESZ) + gC2[i]; } }
    if constexpr (SP2) {
        PG8_STAGE(PG8_SB(0, 0), cB, voffB); PG8_STAGE(PG8_SB(0, 1), cB + hstepB, voffB); PG8_STAGE(PG8_SA(0, 0), cA, gc0); PG8_STAGE(PG8_SA(0, 1), cA + hstepA, gc1);
        if (wr == 1) PG8_BAR;
        PG8_WAIT_V(2); PG8_BAR;
        PG8_STAGE(PG8_SB(1, 0), cB + kstep, voffB); PG8_STAGE(PG8_SA(1, 0), cA + kstep, gc0); PG8_STAGE(PG8_SB(1, 1), cB + hstepB + kstep, voffB);
        PG8_WAIT_V(6); PG8_BAR;
    } else {
        PG8_STAGE(PG8_SB(0, 0), cB, voffB); PG8_STAGE(PG8_SA(0, 0), cA, voffA); PG8_STAGE(PG8_SB(0, 1), cB + hstepB, voffB); PG8_STAGE(PG8_SA(0, 1), cA + hstepA, voffA);
        if (wr == 1) PG8_BAR;
        PG8_WAIT_V(4); PG8_BAR;
        PG8_STAGE(PG8_SB(1, 0), cB + kstep, voffB); PG8_STAGE(PG8_SA(1, 0), cA + kstep, voffA); PG8_STAGE(PG8_SB(1, 1), cB + hstepB + kstep, voffB);
        PG8_WAIT_V(6); PG8_BAR;
    }
    for (;;) {
        const bool has_next = S.next(ui + 1, nxt);
        if constexpr (GATHER) { if (has_next) {
#pragma unroll
            for (int i = 0; i < 2; ++i) { gn0r[i] = selrow[nxt.pm * 256 + gR[i]]; gn1r[i] = selrow[nxt.pm * 256 + 128 + gR[i]]; } } }
        const char* nA = has_next ? nxt.A : cA; const char* nB = has_next ? nxt.B : cB;
#pragma unroll 1
        for (int t = 0; t < nt; t += 2) {
            const bool last = (t == nt - 2);
            const char* a1 = cA + (size_t)(t + 1) * kstep;
            const char* a2 = last ? nA : cA + (size_t)(t + 2) * kstep; const char* b2 = last ? nB : cB + (size_t)(t + 2) * kstep;
            const char* a3 = a2 + kstep; const char* b3 = b2 + kstep;
            if (last && has_next) S.a_ready(nxt);
            unsigned s0[2] = {gc0[0], gc0[1]}, s1[2] = {gc1[0], gc1[1]};
            if constexpr (GATHER) { if (last && has_next) { asm volatile("" : "+v"(gn0r[0]), "+v"(gn0r[1]), "+v"(gn1r[0]), "+v"(gn1r[1]));
#pragma unroll
                for (int i = 0; i < 2; ++i) { s0[i] = (unsigned)gn0r[i] * (unsigned)(g.lda * ESZ) + gC2[i]; s1[i] = (unsigned)gn1r[i] * (unsigned)(g.lda * ESZ) + gC2[i]; } } }
            if constexpr (SP2) {
            PG8_LDB(B0, 0, 0); PG8_LDB(B1, 0, 1); PG8_SCHED; PG8_LDA(At, 0, 0); PG8_STAGE(PG8_SA(1, 1), a1 + hstepA, gc1);
            PG8_WAIT_V(8); PG8_WAIT_L(0); PG8_BAR; PG8_MMA(0, 0, At, B0); PG8_MMA(0, 1, At, B1); PG8_BAR; PG8_SCHED;
            PG8_LDA(At, 0, 1); PG8_STAGE(PG8_SB(0, 0), b2, voffB); PG8_STAGE(PG8_SB(0, 1), b2 + hstepB, voffB); PG8_STAGE(PG8_SA(0, 0), a2, s0);
            PG8_WAIT_V(8); PG8_WAIT_L(0); PG8_BAR; PG8_MMA(1, 0, At, B0); PG8_MMA(1, 1, At, B1); PG8_BAR; PG8_SCHED;
            PG8_LDB(B0, 1, 0); PG8_LDB(B1, 1, 1); PG8_SCHED; PG8_LDA(At, 1, 0); PG8_STAGE(PG8_SA(0, 1), a2 + hstepA, s1);
            PG8_WAIT_V(8); PG8_WAIT_L(0); PG8_BAR; PG8_MMA(0, 0, At, B0); PG8_MMA(0, 1, At, B1); PG8_BAR; PG8_SCHED;
            PG8_LDA(At, 1, 1); PG8_STAGE(PG8_SB(1, 0), b3, voffB); PG8_STAGE(PG8_SB(1, 1), b3 + hstepB, voffB); PG8_STAGE(PG8_SA(1, 0), a3, s0);
            PG8_WAIT_V(8); PG8_WAIT_L(0); PG8_BAR; PG8_MMA(1, 0, At, B0); PG8_MMA(1, 1, At, B1); PG8_BAR; PG8_SCHED;
            } else {
            PG8_LDB(B0, 0, 0); PG8_SCHED; PG8_LDA(At, 0, 0); PG8_STAGE(PG8_SA(1, 1), a1 + hstepA, voffA);
            PG8_WAIT_L(8); PG8_BAR; PG8_WAIT_L(0); PG8_MMA(0, 0, At, B0); PG8_BAR; PG8_SCHED;
            PG8_LDB(B1, 0, 1); PG8_STAGE(PG8_SB(0, 0), b2, voffB);
            PG8_BAR; PG8_WAIT_L(0); PG8_MMA(0, 1, At, B1); PG8_BAR;
            PG8_LDA(At, 0, 1); PG8_STAGE(PG8_SA(0, 0), a2, voffA);
            PG8_BAR; PG8_WAIT_L(0); PG8_MMA(1, 0, At, B0); PG8_BAR; PG8_SCHED;
            PG8_STAGE(PG8_SB(0, 1), b2 + hstepB, voffB);
            PG8_WAIT_V(6); PG8_BAR; PG8_MMA(1, 1, At, B1); PG8_BAR;
            PG8_LDB(B0, 1, 0); PG8_SCHED; PG8_LDA(At, 1, 0); PG8_STAGE(PG8_SA(0, 1), a2 + hstepA, voffA);
            PG8_WAIT_L(8); PG8_BAR; PG8_WAIT_L(0); PG8_MMA(0, 0, At, B0); PG8_BAR; PG8_SCHED;
            PG8_LDB(B1, 1, 1); PG8_STAGE(PG8_SB(1, 0), b3, voffB);
            PG8_BAR; PG8_WAIT_L(0); PG8_MMA(0, 1, At, B1); PG8_BAR;
            PG8_LDA(At, 1, 1); PG8_STAGE(PG8_SA(1, 0), a3, voffA);
            PG8_BAR; PG8_WAIT_L(0); PG8_MMA(1, 0, At, B0); PG8_BAR; PG8_SCHED;
            PG8_STAGE(PG8_SB(1, 1), b3 + hstepB, voffB);
            PG8_WAIT_V(6); PG8_BAR; PG8_MMA(1, 1, At, B1); PG8_BAR;
            }
        }
        if constexpr (ALIGN_EPI) { if (wr == 0) PG8_BAR; }
        if constexpr (FP8) asm volatile("s_nop 7\n\ts_nop 7\n\ts_nop 3" ::: "memory");
        E(acc, cur, wr, wc, fr, fq); S.done(cur);
        if (!has_next) break;
#pragma unroll
        for (int a = 0; a < 2; ++a)
#pragma unroll
            for (int b = 0; b < 2; ++b)
#pragma unroll
                for (int m = 0; m < 4; ++m)
#pragma unroll
                    for (int n = 0; n < 2; ++n) acc[a][b][m][n] = (f32x4){0.f, 0.f, 0.f, 0.f};
        cur = nxt; cA = nA; cB = nB; ++ui;
        if constexpr (GATHER) {
#pragma unroll
            for (int i = 0; i < 2; ++i) { gc0[i] = (unsigned)gn0r[i] * (unsigned)(g.lda * ESZ) + gC2[i]; gc1[i] = (unsigned)gn1r[i] * (unsigned)(g.lda * ESZ) + gC2[i]; } }
        if constexpr (ALIGN_EPI) { if (wr == 1) PG8_BAR; }
    }
    PG8_WAIT_V(0);
    if constexpr (!ALIGN_EPI) { if (wr == 0) PG8_BAR; }
    PG8_BAR;
#undef PG8_SA
#undef PG8_SB
#undef PG8_STAGE
#undef PG8_LDA
#undef PG8_LDB
#undef PG8_MMA
#undef PG8_CAT
#undef PG8_WAIT_V
#undef PG8_WAIT_L
#undef PG8_BAR
#undef PG8_SCHED
}
}
using pg8::Unit;

#define XB_TMO      128
#define XB_XCNT(j)  (256  + 64 * (j))
#define XB_XSUB(j)  (1280 + 64 * (j))
#define XB_XGEN(j)  (2304 + 64 * (j))
#define XB_TOP      3328
#define XB_TOPGEN   3392
#define XCD_BAR_WORDS 3456
#define XB_SPIN_CAP (1u << 18)

__device__ __forceinline__ unsigned xb_ld(unsigned* p)              { return __hip_atomic_load(p, __ATOMIC_RELAXED, __HIP_MEMORY_SCOPE_AGENT); }
__device__ __forceinline__ unsigned xb_add(unsigned* p, unsigned v) { return __hip_atomic_fetch_add(p, v, __ATOMIC_RELAXED, __HIP_MEMORY_SCOPE_AGENT); }
__device__ __forceinline__ unsigned xb_xcc_id() { return (unsigned)__builtin_amdgcn_s_getreg((3 << 11) | 20) & 0xFu; }
#define XB_SPIN(cond, bar) do { unsigned _sp = 0; while (cond) { __builtin_amdgcn_s_sleep(1); \
    if ((++_sp & 255u) == 0u) { if (xb_ld(&(bar)[XB_TMO])) break; if (_sp > XB_SPIN_CAP) { atomicAdd(&(bar)[XB_TMO], 1u); break; } } } } while (0)

struct XcdBarrier {
    unsigned* bar; unsigned x;
    volatile LAS unsigned* st;
};

__device__ __forceinline__ XcdBarrier xcd_barrier_post(unsigned* bar, volatile LAS unsigned* st) {
    XcdBarrier b; b.bar = bar; b.x = xb_xcc_id(); b.st = st;
    if (threadIdx.x == 0) (void)xb_add(&bar[XB_XCNT(b.x)], 1u);
    return b;
}
__device__ __forceinline__ void xcd_barrier_complete(unsigned* bar, unsigned x, unsigned& nloc, unsigned& nx) {
    const unsigned G = gridDim.x * gridDim.y * gridDim.z;
    unsigned sum, cnt, mine, sp = 0u;
    for (;;) {
        sum = 0u; cnt = 0u; mine = 0u;
#pragma unroll
        for (unsigned j = 0; j < 16; ++j) { const unsigned c = xb_ld(&bar[XB_XCNT(j)]); sum += c; cnt += (c > 0u) ? 1u : 0u; mine = (j == x) ? c : mine; }
        if (sum == G) break;
        __builtin_amdgcn_s_sleep(1);
        if ((++sp & 255u) == 0u) { if (xb_ld(&bar[XB_TMO])) break; if (sp > XB_SPIN_CAP) { atomicAdd(&bar[XB_TMO], 1u); break; } }
    }
    nloc = mine > 0u ? mine : 1u; nx = cnt > 0u ? cnt : 1u;
}

__device__ __forceinline__ void xcd_barrier(const XcdBarrier& b) {
    asm volatile("s_waitcnt vmcnt(0)" ::: "memory");
    __syncthreads();
    if (threadIdx.x == 0) {
        unsigned* bar = b.bar;
        __builtin_amdgcn_s_waitcnt(0);
        unsigned nloc = b.st[0], nx = b.st[1];
        if (nloc == 0u) { xcd_barrier_complete(bar, b.x, nloc, nx); b.st[0] = nloc; b.st[1] = nx; }
        const unsigned old = xb_add(&bar[XB_XSUB(b.x)], 1u);
        const unsigned gen = old / nloc;
        if (old + 1u == (gen + 1u) * nloc) {
            __builtin_amdgcn_fence(__ATOMIC_RELEASE, "agent");
            asm volatile("s_waitcnt vmcnt(0)" ::: "memory");
            const unsigned og = xb_add(&bar[XB_TOP], 1u);
            const unsigned tg = og / nx;
            if (og + 1u == (tg + 1u) * nx) xb_add(&bar[XB_TOPGEN], 1u);
            else XB_SPIN(xb_ld(&bar[XB_TOPGEN]) == tg, bar);
            __builtin_amdgcn_fence(__ATOMIC_ACQUIRE, "agent");
            xb_add(&bar[XB_XGEN(b.x)], 1u);
            asm volatile("s_waitcnt vmcnt(0)" ::: "memory");
        } else {
            XB_SPIN(xb_ld(&bar[XB_XGEN(b.x)]) == gen, bar);
            __builtin_amdgcn_fence(__ATOMIC_ACQUIRE, "agent");
            asm volatile("s_waitcnt vmcnt(0)" ::: "memory");
        }
    }
    __syncthreads();
}

__device__ __forceinline__ unsigned pk4_fp8(float a, float b, float c, float d) { int w = 0; w = __builtin_amdgcn_cvt_pk_fp8_f32(a, b, w, false); w = __builtin_amdgcn_cvt_pk_fp8_f32(c, d, w, true); return (unsigned)w; }
#define EPI_SIG const f32x4 (&acc)[2][2][4][2], const Unit& u, int wr, int wc, int fr, int fq
struct EpiZ { static constexpr bool PERM = true; bf16* ZB; float* ZF;
    __device__ __forceinline__ void operator()(EPI_SIG) const {
        const int row0 = u.pm * 256 + wr * 64 + fr;
        if (u.pn < 11) {
            const int col0 = u.pn * 256 + wc * 32 + 8 * fq;
#pragma unroll
            for (int ai = 0; ai < 2; ++ai)
#pragma unroll
                for (int m = 0; m < 4; ++m) { bf16* rowp = ZB + (size_t)(row0 + ai * 128 + m * 16) * NZB + col0;
#pragma unroll
                    for (int bj = 0; bj < 2; ++bj) { const f32x4 v0 = acc[ai][bj][m][0], v1 = acc[ai][bj][m][1]; v4u w; w.x = cvt_pk_bf16(v0[0], v0[1]); w.y = cvt_pk_bf16(v0[2], v0[3]); w.z = cvt_pk_bf16(v1[0], v1[1]); w.w = cvt_pk_bf16(v1[2], v1[3]);
                        *(v4u*)(rowp + bj * 128) = w; } }
        } else {
            const int col0 = (u.pn - 11) * 256 + wc * 32 + 8 * fq;
#pragma unroll
            for (int ai = 0; ai < 2; ++ai)
#pragma unroll
                for (int m = 0; m < 4; ++m) { float* rowp = ZF + (size_t)(row0 + ai * 128 + m * 16) * NZF + col0;
#pragma unroll
                    for (int bj = 0; bj < 2; ++bj) { *(f32x4*)(rowp + bj * 128) = acc[ai][bj][m][0]; *(f32x4*)(rowp + bj * 128 + 4) = acc[ai][bj][m][1]; } }
        }
    }
};
struct EpiBf { static constexpr bool PERM = true; bf16* O; int ldc; const float* roww;
    __device__ __forceinline__ void operator()(EPI_SIG) const {
        const int row0 = u.pm * 256 + wr * 64 + fr, col0 = u.pn * 256 + wc * 32 + 8 * fq;
#pragma unroll
        for (int ai = 0; ai < 2; ++ai)
#pragma unroll
            for (int m = 0; m < 4; ++m) { const int row = row0 + ai * 128 + m * 16; const float s = roww ? roww[row] : 1.0f; bf16* rowp = O + (size_t)row * ldc + col0;
#pragma unroll
                for (int bj = 0; bj < 2; ++bj) { const f32x4 v0 = acc[ai][bj][m][0] * s, v1 = acc[ai][bj][m][1] * s; v4u w; w.x = cvt_pk_bf16(v0[0], v0[1]); w.y = cvt_pk_bf16(v0[2], v0[3]); w.z = cvt_pk_bf16(v1[0], v1[1]); w.w = cvt_pk_bf16(v1[2], v1[3]);
                    *(v4u*)(rowp + bj * 128) = w; } }
    }
};
struct EpiFour1 { static constexpr bool PERM = true; bf16* VTL; bf16* VTC;
    __device__ __forceinline__ void operator()(EPI_SIG) const {
        bf16* base; int ldc;
        if (u.pn < 128) { const int b = u.pn >> 3, t0 = (u.pn & 7) * 256; base = VTL + (size_t)b * 256 * 4096 + u.pm * 2048 + t0; ldc = 4096; }
        else { const int b = u.pn - 128; base = VTC + (size_t)b * 256 * 512 + u.pm * 256; ldc = 512; }
        const int r0 = wr * 64 + fr, col0 = wc * 32 + 8 * fq;
#pragma unroll
        for (int ai = 0; ai < 2; ++ai)
#pragma unroll
            for (int m = 0; m < 4; ++m) { bf16* rowp = base + (size_t)(r0 + ai * 128 + m * 16) * ldc + col0;
#pragma unroll
                for (int bj = 0; bj < 2; ++bj) { const f32x4 v0 = acc[ai][bj][m][0], v1 = acc[ai][bj][m][1]; v4u w; w.x = cvt_pk_bf16(v0[0], v0[1]); w.y = cvt_pk_bf16(v0[2], v0[3]); w.z = cvt_pk_bf16(v1[0], v1[1]); w.w = cvt_pk_bf16(v1[2], v1[3]);
                    *(v4u*)(rowp + bj * 128) = w; } }
    }
};
struct EpiF32 { static constexpr bool PERM = false; float* C; int ldc;
    __device__ __forceinline__ void operator()(EPI_SIG) const {
        const int row0 = u.pm * 256 + wr * 64 + fr, col0 = u.pn * 256 + wc * 32 + 4 * fq;
#pragma unroll
        for (int ai = 0; ai < 2; ++ai)
#pragma unroll
            for (int m = 0; m < 4; ++m) { float* rowp = C + (size_t)(row0 + ai * 128 + m * 16) * ldc + col0;
#pragma unroll
                for (int bj = 0; bj < 2; ++bj)
#pragma unroll
                    for (int n = 0; n < 2; ++n) *(f32x4*)(rowp + bj * 128 + n * 16) = acc[ai][bj][m][n]; }
    }
};
struct EpiFourT { static constexpr bool PERM = false; float* FO; int ctx;
    __device__ __forceinline__ void operator()(EPI_SIG) const {
        float* base = ctx ? FO + (size_t)(ML + u.pn * 256) * 256 : FO + (size_t)(u.pn & 1) * MT * 256 + (size_t)((u.pn >> 1) * 2048 + u.pm * 256) * 256;
        const int r0 = wr * 64 + fr, col0 = wc * 32 + 4 * fq;
#pragma unroll
        for (int ai = 0; ai < 2; ++ai)
#pragma unroll
            for (int m = 0; m < 4; ++m) { float* rowp = base + (size_t)(r0 + ai * 128 + m * 16) * 256 + col0;
#pragma unroll
                for (int bj = 0; bj < 2; ++bj)
#pragma unroll
                    for (int n = 0; n < 2; ++n) *(f32x4*)(rowp + bj * 128 + n * 16) = acc[ai][bj][m][n]; }
    }
};
struct EpiP { static constexpr bool PERM = true; bf16* P2;
    __device__ __forceinline__ void operator()(EPI_SIG) const {
        const int g = u.pn >> 2, ct = u.pn & 3;
#pragma unroll
        for (int ai = 0; ai < 2; ++ai)
#pragma unroll
            for (int m = 0; m < 4; ++m)
#pragma unroll
                for (int bj = 0; bj < 2; ++bj) { const int pn = ct * 4 + bj * 2 + (wc >> 1), wave_m = wr * 4 + (wc & 1) * 2 + (fq >> 1);
#pragma unroll
                    for (int n = 0; n < 2; ++n) { const int lane_m = ((fq & 1) * 2 + n) * 16 + fr; const f32x4 v = acc[ai][bj][m][n];
                        v2u w; w.x = cvt_pk_bf16(v[0], v[1]); w.y = cvt_pk_bf16(v[2], v[3]);
                        *(v2u*)(P2 + ((((((size_t)u.pm * 16 + pn) * 2 + ai) * 4 + m) * 8 + wave_m) * 4 + g) * 256 + lane_m * 4) = w; } }
    }
};
struct EpiMerge { static constexpr bool PERM = false; const bf16* P; bf16* T; const float* bg;
    __device__ __forceinline__ void operator()(EPI_SIG) const {
        const int row0 = u.pm * 256 + wr * 64 + fr, oc = u.pn * 64 + wc * 16 + 4 * fq;
        f32x4 bv[4];
#pragma unroll
        for (int g = 0; g < 4; ++g) bv[g] = *(const f32x4*)(bg + g * 1024 + oc);
#pragma unroll
        for (int ai = 0; ai < 2; ++ai)
#pragma unroll
            for (int m = 0; m < 4; ++m) { const int row = row0 + ai * 128 + m * 16; const bf16* prow = P + (((((size_t)u.pm * 16 + u.pn) * 2 + ai) * 4 + m) * 8 + (wr * 4 + wc)) * 1024 + (fq * 16 + fr) * 4;
                v2u pw[4];
#pragma unroll
                for (int g = 0; g < 4; ++g) pw[g] = *(const v2u*)(prow + g * 256);
                f32x4 t = (f32x4){0.f, 0.f, 0.f, 0.f};
#pragma unroll
                for (int bj = 0; bj < 2; ++bj)
#pragma unroll
                    for (int n = 0; n < 2; ++n) { const int g = 2 * bj + n; const f32x4 a = acc[ai][bj][m][n] + bv[g];
                        t[0] += sigmoid_fast(a[0]) * bf2f(pw[g].x & 0xffffu); t[1] += sigmoid_fast(a[1]) * bf2f(pw[g].x >> 16);
                        t[2] += sigmoid_fast(a[2]) * bf2f(pw[g].y & 0xffffu); t[3] += sigmoid_fast(a[3]) * bf2f(pw[g].y >> 16); }
                v2u w; w.x = cvt_pk_bf16(t[0], t[1]); w.y = cvt_pk_bf16(t[2], t[3]);
                *(v2u*)(T + (size_t)row * 1024 + oc) = w; }
    }
};
struct EpiSwiGLU { static constexpr bool PERM = true; unsigned char* HID;
    __device__ __forceinline__ void operator()(EPI_SIG) const {
        const int row0 = u.pm * 256 + wr * 64 + fr, col0 = u.pn * 128 + wc * 32 + 8 * fq;
#pragma unroll
        for (int ai = 0; ai < 2; ++ai)
#pragma unroll
            for (int m = 0; m < 4; ++m) { unsigned char* rowp = HID + (size_t)(row0 + ai * 128 + m * 16) * 1024 + col0; float o[8];
#pragma unroll
                for (int n = 0; n < 2; ++n)
#pragma unroll
                    for (int j = 0; j < 4; ++j) { const float gv = acc[ai][0][m][n][j], uv = acc[ai][1][m][n][j]; o[4 * n + j] = fminf(fmaxf(gv * sigmoid_fast(gv) * uv, -448.f), 448.f); }
                v2u w; w.x = pk4_fp8(o[0], o[1], o[2], o[3]); w.y = pk4_fp8(o[4], o[5], o[6], o[7]);
                *(v2u*)rowp = w; }
    }
};
struct EpiZB { static constexpr bool PERM = true; bf16* O;
    __device__ __forceinline__ void operator()(EPI_SIG) const {
        const int row0 = u.pm * 256 + wr * 64 + fr, col0 = u.pn * 256 + wc * 32 + 8 * fq; const bool sl = (u.pn == 0);
#pragma unroll
        for (int ai = 0; ai < 2; ++ai)
#pragma unroll
            for (int m = 0; m < 4; ++m) { bf16* rowp = O + (size_t)(row0 + ai * 128 + m * 16) * NZB + col0;
#pragma unroll
                for (int bj = 0; bj < 2; ++bj) { f32x4 v0 = acc[ai][bj][m][0], v1 = acc[ai][bj][m][1];
                    if (sl) {
#pragma unroll
                        for (int t = 0; t < 4; ++t) { v0[t] *= sigmoid_fast(v0[t]); v1[t] *= sigmoid_fast(v1[t]); } }
                    v4u w; w.x = cvt_pk_bf16(v0[0], v0[1]); w.y = cvt_pk_bf16(v0[2], v0[3]); w.z = cvt_pk_bf16(v1[0], v1[1]); w.w = cvt_pk_bf16(v1[2], v1[3]);
                    *(v4u*)(rowp + bj * 128) = w; } }
    }
};
struct EpiZF { static constexpr bool PERM = false; float* C; const float* lb;
    __device__ __forceinline__ void operator()(EPI_SIG) const {
        const int row0 = u.pm * 256 + wr * 64 + fr, cc = wc * 32 + 4 * fq;
        f32x4 lbv[2][2];
#pragma unroll
        for (int bj = 0; bj < 2; ++bj)
#pragma unroll
            for (int n = 0; n < 2; ++n) lbv[bj][n] = (u.pn < 2) ? *(const f32x4*)(lb + u.pn * 1024 + cc + bj * 128 + n * 16) : (f32x4){0.f, 0.f, 0.f, 0.f};
#pragma unroll
        for (int ai = 0; ai < 2; ++ai)
#pragma unroll
            for (int m = 0; m < 4; ++m) { float* rowp = C + (size_t)(row0 + ai * 128 + m * 16) * NZF + u.pn * 256 + cc;
#pragma unroll
                for (int bj = 0; bj < 2; ++bj)
#pragma unroll
                    for (int n = 0; n < 2; ++n) { f32x4 v = acc[ai][bj][m][n];
                        if (u.pn < 2) {
#pragma unroll
                            for (int t = 0; t < 4; ++t) v[t] = __logf(fmaxf(lbv[bj][n][t] + (1.0f - lbv[bj][n][t]) * sigmoid_fast(v[t]), 1e-30f)); }
                        if (u.pn < 2 || (bj == 0 && wc == 0 && (n == 0 || fq < 2))) *(f32x4*)(rowp + bj * 128 + n * 16) = v; } }
    }
};
struct EpiF8 { static constexpr bool PERM = true; unsigned char* O; const float* roww;
    __device__ __forceinline__ void operator()(EPI_SIG) const {
        const int row0 = u.pm * 256 + wr * 64 + fr, col0 = u.pn * 256 + wc * 32 + 8 * fq;
#pragma unroll
        for (int ai = 0; ai < 2; ++ai)
#pragma unroll
            for (int m = 0; m < 4; ++m) { const int row = row0 + ai * 128 + m * 16; const float s = roww[row] * 64.0f; unsigned char* rowp = O + (size_t)row * 1024 + col0;
#pragma unroll
                for (int bj = 0; bj < 2; ++bj) { const f32x4 v0 = acc[ai][bj][m][0] * s, v1 = acc[ai][bj][m][1] * s; v2u w;
                    w.x = pk4_fp8(fminf(fmaxf(v0[0], -448.f), 448.f), fminf(fmaxf(v0[1], -448.f), 448.f), fminf(fmaxf(v0[2], -448.f), 448.f), fminf(fmaxf(v0[3], -448.f), 448.f));
                    w.y = pk4_fp8(fminf(fmaxf(v1[0], -448.f), 448.f), fminf(fmaxf(v1[1], -448.f), 448.f), fminf(fmaxf(v1[2], -448.f), 448.f), fminf(fmaxf(v1[3], -448.f), 448.f));
                    *(v2u*)(rowp + bj * 128) = w; } }
    }
};
struct MapPlain { const char* A; const char* B; size_t sa, sb; __device__ __forceinline__ void operator()(Unit& u) const { u.A = A + (size_t)u.pm * sa; u.B = B + (size_t)u.pn * sb; } };
struct MapP { const char* OUTS; const char* WBR; __device__ __forceinline__ void operator()(Unit& u) const { const int g = u.pn >> 2; u.A = OUTS + (size_t)u.pm * (256 * 1024 * 2) + g * 512; u.B = WBR + (size_t)g * (1024 * 256 * 2) + (size_t)(u.pn & 3) * (256 * 256 * 2); } };
struct MapFourT { const char* DFTL; const char* VTL; __device__ __forceinline__ void operator()(Unit& u) const { const int kh = u.pn & 1; u.A = DFTL + (size_t)u.pm * (256 * 4096 * 2) + kh * 4096; u.B = VTL + (size_t)(u.pn >> 1) * (256 * 4096 * 2) + kh * 4096; } };
struct MapMoE { const char* A; const char* W; size_t se, st; __device__ __forceinline__ void operator()(Unit& u) const { const int e = u.pm < 256 ? (u.pm >> 4) : ((u.pm - 256) >> 1); u.A = A + (size_t)u.pm * st; u.B = W + (size_t)e * se + (size_t)u.pn * st; } };
struct MapMoEG { const char* A; const char* W; size_t se, st; __device__ __forceinline__ void operator()(Unit& u) const { const int e = u.pm < 256 ? (u.pm >> 4) : ((u.pm - 256) >> 1); u.A = A; u.B = W + (size_t)e * se + (size_t)u.pn * st; } };
struct Args { const float* in[31]; float* out; unsigned char* ws; int ph_lo, ph_hi, li, pad; };
enum { I_X = 0, I_C, I_CTX, I_CCTX, I_ADAW, I_ADAB, I_WIN, I_LBLOG, I_HGRN_NW, I_GDN_CW, I_GDN_ALOG, I_GDN_DTB, I_GDN_NW, I_SSD_CW, I_SSD_CB, I_SSD_ALOG, I_SSD_DTB, I_SSD_D, I_SSD_NW,
       I_WGATE, I_BGATE, I_WBR, I_WOUT, I_LN1G, I_LN1B, I_WROUTER, I_WFFG, I_WFFU, I_WFFD, I_LN2G, I_LN2B };
struct WCtx { int tid, lane, wave, bid, G, gw, NGW; };

__device__ __forceinline__ float dpp_xor1(float x) { return __int_as_float(__builtin_amdgcn_mov_dpp(__float_as_int(x), 0xB1, 0xf, 0xf, true)); }
__device__ __forceinline__ float dpp_xor2(float x) { return __int_as_float(__builtin_amdgcn_mov_dpp(__float_as_int(x), 0x4E, 0xf, 0xf, true)); }
__device__ __forceinline__ int zrow(int n) {
    if (n < 256) return n;
    if (n < 512) return 11 * 256 + (n - 256);
    if (n < 768) return 12 * 256 + (n - 512);
    if (n < 1024) return 1 * 256 + (n - 768);
    if (n < 1280) return 2 * 256 + (n - 1024);
    if (n < 2048) return 3 * 256 + (n - 1280);
    if (n < 2304) return 6 * 256 + (n - 2048);
    if (n < 2312) return 13 * 256 + (n - 2304);
    if (n < 2320) return 13 * 256 + 8 + (n - 2312);
    if (n < 2576) return 7 * 256 + (n - 2320);
    if (n < 3088) return 8 * 256 + (n - 2576);
    if (n < 3344) return 10 * 256 + (n - 3088);
    return 13 * 256 + 16 + (n - 3344);
}
__device__ __forceinline__ int rowmap(int mode, int aux, int n) {
    if (mode == 0) return n;
    if (mode == 1) return zrow(n);
    if (mode == 2) return 256 * (n >> 6) + 128 * (aux >> 1) + 32 * ((n & 63) >> 4) + 16 * (aux & 1) + (n & 15);
    if (mode == 3) return 256 * (n >> 7) + (n & 127);
    return 256 * (n >> 7) + 128 + (n & 127);
}
__device__ __forceinline__ void transpose_item(const float* W, int N, bf16* WT, int ldt, LAS unsigned* scr, int item, int lane, int mode, int aux) {
    const int nblk = (N + 63) >> 6, kb = item / nblk, nb = item - kb * nblk, k0 = 64 * kb, n0 = 64 * nb;
    const int ncol = n0 + lane; const bool okc = ncol < N;
    const float* wp = W + (size_t)k0 * N + (okc ? ncol : 0);
    float v[64];
#pragma unroll
    for (int i = 0; i < 64; ++i) v[i] = wp[(size_t)i * N];
#pragma unroll
    for (int i = 0; i < 32; ++i) scr[i * 65 + lane] = okc ? pk2(v[2 * i], v[2 * i + 1]) : 0u;
    LDS_WAIT();
    const int c = lane & 7;
#pragma unroll
    for (int j = 0; j < 8; ++j) { const int nn = (lane >> 3) + 8 * j, n = n0 + nn;
        v4u o; o.x = scr[(4 * c + 0) * 65 + nn]; o.y = scr[(4 * c + 1) * 65 + nn]; o.z = scr[(4 * c + 2) * 65 + nn]; o.w = scr[(4 * c + 3) * 65 + nn];
        if (n < N) *(v4u*)(WT + (size_t)rowmap(mode, aux, n) * ldt + k0 + 8 * c) = o; }
    LDS_WAIT();
}
__device__ __forceinline__ void transpose_item8(const float* W, int N, unsigned char* WT, int ldt, int item, int lane, int mode, int aux) {
    const int nblk = (N + 63) >> 6, kb = item / nblk, nb = item - kb * nblk, k0 = 64 * kb, n0 = 64 * nb;
    const int ncol = n0 + lane;
    const float* wp = W + (size_t)k0 * N + ncol;
    float v[64];
#pragma unroll
    for (int i = 0; i < 64; ++i) v[i] = wp[(size_t)i * N];
    unsigned o[16];
#pragma unroll
    for (int q = 0; q < 16; ++q) o[q] = pk4_fp8(fminf(fmaxf(v[4 * q] * 64.f, -448.f), 448.f), fminf(fmaxf(v[4 * q + 1] * 64.f, -448.f), 448.f), fminf(fmaxf(v[4 * q + 2] * 64.f, -448.f), 448.f), fminf(fmaxf(v[4 * q + 3] * 64.f, -448.f), 448.f));
    v4u* dst = (v4u*)(WT + (size_t)rowmap(mode, aux, ncol) * ldt + k0);
#pragma unroll
    for (int q = 0; q < 4; ++q) dst[q] = (v4u){o[4 * q], o[4 * q + 1], o[4 * q + 2], o[4 * q + 3]};
}
constexpr int WI_IN = 16 * 53, WI_G = 4 * 256, WI_BR = 4 * 64, WI_OUT = 256, WI_FF = 16 * 256;
constexpr int WI_REST = WI_G + WI_BR + WI_OUT + 3 * WI_FF;
constexpr int WI_XA = 9216, WI_XB = 10368;
__device__ __forceinline__ void convert_win(const Args& a, LAS unsigned char* lds, int wave, int lane, int gw, int ngw, int l) {
    LAS unsigned* scr = (LAS unsigned*)(lds + wave * 8448);
    for (int it = gw; it < WI_IN; it += ngw) transpose_item(a.in[I_WIN] + (size_t)l * 1024 * IN_COLS, IN_COLS, (bf16*)(a.ws + WS_WIN), 1024, scr, it, lane, 1, 0);
}
__device__ __forceinline__ void convert_rest(const Args& a, LAS unsigned char* lds, int wave, int lane, int gw, int ngw, int l, int it0, int it1) {
    LAS unsigned* scr = (LAS unsigned*)(lds + wave * 8448);
    unsigned char* ws = a.ws;
    for (int it = it0 + gw; it < it1; it += ngw) {
        int r = it;
        if (r < WI_G) { const int g = r >> 8; transpose_item8(a.in[I_WGATE] + (size_t)(l * 4 + g) * 1024 * 1024, 1024, ws + WS_WG, 1024, r & 255, lane, 2, g); continue; } r -= WI_G;
        if (r < WI_BR) { const int g = r >> 6; transpose_item(a.in[I_WBR] + (size_t)(l * 4 + g) * 256 * 1024, 1024, (bf16*)(ws + WS_WBR) + (size_t)g * 1024 * 256, 256, scr, r & 63, lane, 0, 0); continue; } r -= WI_BR;
        if (r < WI_OUT) { transpose_item(a.in[I_WOUT] + (size_t)l * 1024 * 1024, 1024, (bf16*)(ws + WS_WOUT), 1024, scr, r, lane, 0, 0); continue; } r -= WI_OUT;
        if (r < WI_FF) { const int e = r >> 8; transpose_item8(a.in[I_WFFG] + (size_t)(l * 16 + e) * 1024 * 1024, 1024, ws + WS_WGU + (size_t)e * 2048 * 1024, 1024, r & 255, lane, 3, 0); continue; } r -= WI_FF;
        if (r < WI_FF) { const int e = r >> 8; transpose_item8(a.in[I_WFFU] + (size_t)(l * 16 + e) * 1024 * 1024, 1024, ws + WS_WGU + (size_t)e * 2048 * 1024, 1024, r & 255, lane, 4, 0); continue; } r -= WI_FF;
        { const int e = r >> 8; transpose_item8(a.in[I_WFFD] + (size_t)(l * 16 + e) * 1024 * 1024, 1024, ws + WS_WDN + (size_t)e * 1024 * 1024, 1024, r & 255, lane, 0, 0); }
    }
}

__device__ __forceinline__ void row_load(const float* p, int lane, f32x4 (&v)[4]) { const f32x4* xr = (const f32x4*)p + lane;
#pragma unroll
    for (int j = 0; j < 4; ++j) v[j] = xr[64 * j]; }
__device__ __forceinline__ void row_store(float* p, int lane, const f32x4 (&v)[4]) { f32x4* xr = (f32x4*)p + lane;
#pragma unroll
    for (int j = 0; j < 4; ++j) xr[64 * j] = v[j]; }
__device__ __forceinline__ void ln_stats(const f32x4 (&v)[4], float& mean, float& rstd) {
    float s = 0.f;
#pragma unroll
    for (int j = 0; j < 4; ++j) s += (v[j][0] + v[j][1]) + (v[j][2] + v[j][3]);
    mean = wave_sum(s) * (1.f / 1024.f); float q = 0.f;
#pragma unroll
    for (int j = 0; j < 4; ++j) { const f32x4 d = v[j] - mean; q += (d[0] * d[0] + d[1] * d[1]) + (d[2] * d[2] + d[3] * d[3]); }
    rstd = 1.0f / sqrtf(wave_sum(q) * (1.f / 1024.f) + LN_EPS);
}
__device__ __forceinline__ unsigned pk4c_fp8(f32x4 v) { return pk4_fp8(fminf(fmaxf(v[0], -448.f), 448.f), fminf(fmaxf(v[1], -448.f), 448.f), fminf(fmaxf(v[2], -448.f), 448.f), fminf(fmaxf(v[3], -448.f), 448.f)); }
__device__ __forceinline__ void modulate_row(const f32x4 (&v)[4], const float* sh, const float* sc, bf16* hrow, unsigned* h8row, int lane, f32x4 (&hv)[4]) {
    float mean, rstd; ln_stats(v, mean, rstd);
#pragma unroll
    for (int j = 0; j < 4; ++j) { const f32x4 s = *((const f32x4*)sc + lane + 64 * j), t = *((const f32x4*)sh + lane + 64 * j);
        hv[j] = (v[j] - mean) * rstd * (s + 1.0f) + t;
        v2u w; w.x = cvt_pk_bf16(hv[j][0], hv[j][1]); w.y = cvt_pk_bf16(hv[j][2], hv[j][3]); *((v2u*)hrow + lane + 64 * j) = w; h8row[lane + 64 * j] = pk4c_fp8(hv[j]); }
}
__device__ __forceinline__ const float* mod_ptr(const Args& a, int l, int row, int chunk) { const int r = row < ML ? (row >> 11) : 16; return (const float*)(a.ws + WS_MOD) + ((size_t)(l * 17 + r) * 6144 + chunk * 1024); }

__device__ __forceinline__ void phase_prologue(const Args& a, LAS unsigned char* lds, const WCtx& w) {
    {
        LAS float* SC = (LAS float*)lds; LAS float* RED = (LAS float*)(lds + 17 * 1024 * 4);
        for (int i = w.tid; i < 17 * 1024; i += NTHREADS) { const int r = i >> 10, k = i & 1023; const float v = r < 16 ? a.in[I_C][r * 1024 + k] : a.in[I_CCTX][k]; SC[i] = silu_acc(v); }
        __syncthreads();
        float* MOD = (float*)(a.ws + WS_MOD);
        for (int it = w.bid; it < 4 * 96; it += w.G) {
            const int l = it / 96, cg = it - l * 96;
            const float* wp = a.in[I_ADAW] + (size_t)l * 1024 * 6144 + cg * 64 + w.lane;
            float acc[17];
#pragma unroll
            for (int r = 0; r < 17; ++r) acc[r] = 0.f;
            const int k0 = w.wave * 128;
            const float* wq = wp + (size_t)k0 * 6144;
            float a0 = wq[0], a1 = wq[6144], a2 = wq[2 * 6144], a3 = wq[3 * 6144], b0 = wq[4 * 6144], b1 = wq[5 * 6144], b2 = wq[6 * 6144], b3 = wq[7 * 6144];
#pragma unroll 1
            for (int k = k0; k < k0 + 128; k += 4) {
                const float w0 = a0, w1 = a1, w2 = a2, w3 = a3; a0 = b0; a1 = b1; a2 = b2; a3 = b3;
                if (k + 8 < k0 + 128) { const float* wn = wp + (size_t)(k + 8) * 6144; b0 = wn[0]; b1 = wn[6144]; b2 = wn[2 * 6144]; b3 = wn[3 * 6144]; }
#pragma unroll
                for (int r = 0; r < 17; ++r) { const f32x4 s = *(const LAS f32x4*)(SC + r * 1024 + k); acc[r] += (s[0] * w0 + s[1] * w1) + (s[2] * w2 + s[3] * w3); }
            }
#pragma unroll
            for (int r = 0; r < 17; ++r) RED[(w.wave * 17 + r) * 64 + w.lane] = acc[r];
            __syncthreads();
            for (int i = w.tid; i < 17 * 64; i += NTHREADS) { const int r = i >> 6, col = i & 63; float s = 0.f;
#pragma unroll
                for (int q = 0; q < 8; ++q) s += RED[(q * 17 + r) * 64 + col];
                MOD[(size_t)(l * 17 + r) * 6144 + cg * 64 + col] = s + a.in[I_ADAB][l * 6144 + cg * 64 + col]; }
            __syncthreads();
        }
    }
    {
        float* X = (float*)(a.ws + WS_X);
        float om[4];
#pragma unroll
        for (int e = 0; e < 4; ++e) om[e] = 1.0f / powf(10000.0f, (float)(4 * w.lane + e) * (1.0f / 256.0f));
        int tcur = -1; f32x4 pos[4];
#pragma unroll
        for (int j = 0; j < 4; ++j) pos[j] = (f32x4){0.f, 0.f, 0.f, 0.f};
        for (int row = w.gw; row < MT; row += w.NGW) {
            f32x4 v[4];
            if (row < ML) { row_load(a.in[I_X] + (size_t)row * 1024, w.lane, v); const int t = row & 2047;
                if (t != tcur) { tcur = t; const float pr = (float)(t >> 6), pc = (float)(t & 63);
#pragma unroll
                    for (int e = 0; e < 4; ++e) { pos[0][e] = sinf(pr * om[e]); pos[1][e] = cosf(pr * om[e]); pos[2][e] = sinf(pc * om[e]); pos[3][e] = cosf(pc * om[e]); } }
#pragma unroll
                for (int j = 0; j < 4; ++j) v[j] += pos[j]; }
            else row_load(a.in[I_CTX] + (size_t)(row - ML) * 1024, w.lane, v);
            row_store(X + (size_t)row * 1024, w.lane, v);
        }
    }
    {
        { float* TWg = (float*)(a.ws + WS_LB + 65536);
          for (int i = w.bid * NTHREADS + w.tid; i < 1024; i += w.G * NTHREADS) { float s, c; sincospif((float)i * (1.0f / 1024.0f), &s, &c); TWg[2 * i] = c; TWg[2 * i + 1] = -s; } }
        bf16* D6 = (bf16*)(a.ws + WS_DFT64);
        for (int i = w.bid * NTHREADS + w.tid; i < 512 * 256; i += w.G * NTHREADS) { const int j = i >> 8, k = i & 255; const int g = (j & 255) >> 6, kc = j & 63; float val = 0.f;
            if ((k >> 6) == g) { const int m = (kc * (k & 63)) & 63; float s, c; sincospif((float)m * (1.0f / 32.0f), &s, &c); val = (j >> 8) ? -s : c; }
            D6[i] = (bf16)f2bf(val); }
        if (w.bid == 0) { float* LB = (float*)(a.ws + WS_LB); const int d = w.tid >> 8, ch = w.tid & 255; float lg[4], mx = -1e30f;
#pragma unroll
            for (int l = 0; l < 4; ++l) { lg[l] = a.in[I_LBLOG][(d * 4 + l) * 256 + ch]; mx = fmaxf(mx, lg[l]); }
            float s = 0.f;
#pragma unroll
            for (int l = 0; l < 4; ++l) { lg[l] = expf(lg[l] - mx); s += lg[l]; }
            float cum = 0.f;
#pragma unroll
            for (int l = 0; l < 4; ++l) { if (l > 0) cum += lg[l] / s; LB[(d * 4 + l) * 256 + ch] = cum; } }
    }
    __syncthreads();
    convert_win(a, lds, w.wave, w.lane, w.gw, w.NGW, 0);
}
__device__ __forceinline__ void phase_mod_rows(const Args& a, const WCtx& w, int l) {
    const float* X = (const float*)(a.ws + WS_X); bf16* H = (bf16*)(a.ws + WS_H);
    for (int row = w.gw; row < MT; row += w.NGW) { f32x4 v[4], hv[4]; row_load(X + (size_t)row * 1024, w.lane, v);
        modulate_row(v, mod_ptr(a, l, row, 0), mod_ptr(a, l, row, 1), H + (size_t)row * 1024, (unsigned*)(a.ws + WS_H8 + (size_t)row * 1024), w.lane, hv); }
}

__device__ __forceinline__ f32x4 ld_bf4(const bf16* p) { const v2u u = *(const v2u*)p; return (f32x4){bf2f(u.x & 0xffffu), bf2f(u.x >> 16), bf2f(u.y & 0xffffu), bf2f(u.y >> 16)}; }
__device__ __forceinline__ void st_bf4(bf16* p, f32x4 v) { v2u w; w.x = cvt_pk_bf16(v[0], v[1]); w.y = cvt_pk_bf16(v[2], v[3]); *(v2u*)p = w; }
__device__ __forceinline__ void phase_prep(const Args& a, const WCtx& w, int l) {
    const bf16* ZB = (const bf16*)(a.ws + WS_ZB); bf16* PB = (bf16*)(a.ws + WS_PB);
    constexpr int NSEG = 16 * 128 + 16 * 16;
    for (int it = w.gw; it < NSEG * 3; it += w.NGW) {
        const int seg = it / 3, bg = it - seg * 3;
        int T, t0, rowbase;
        if (seg < 2048) { const int b = seg >> 7; t0 = (seg & 127) * 16; T = 2048; rowbase = b * 2048; } else { const int s2 = seg - 2048; const int b = s2 >> 4; t0 = (s2 & 15) * 16; T = 256; rowbase = ML + b * 256; }
        const int blk = bg * 8 + (w.lane >> 3), c8 = (w.lane & 7) * 8;
        if (blk < 20) {
            int zcol, pcol; float cw[5][8], bias[8];
            if (blk < 12) { const int c = blk * 64 + c8; zcol = 768 + c; pcol = c;
#pragma unroll
                for (int k = 0; k < 5; ++k) { const f32x4 w0 = *(const f32x4*)(a.in[I_GDN_CW] + (size_t)(l * 5 + k) * 768 + c), w1 = *(const f32x4*)(a.in[I_GDN_CW] + (size_t)(l * 5 + k) * 768 + c + 4);
#pragma unroll
                    for (int i = 0; i < 4; ++i) { cw[k][i] = w0[i]; cw[k][4 + i] = w1[i]; } }
#pragma unroll
                for (int i = 0; i < 8; ++i) bias[i] = 0.f; }
            else { const int c = (blk - 12) * 64 + c8; zcol = 2048 + c; pcol = 768 + c;
#pragma unroll
                for (int k = 0; k < 5; ++k) { const f32x4 w0 = *(const f32x4*)(a.in[I_SSD_CW] + (size_t)(l * 5 + k) * 512 + c), w1 = *(const f32x4*)(a.in[I_SSD_CW] + (size_t)(l * 5 + k) * 512 + c + 4);
#pragma unroll
                    for (int i = 0; i < 4; ++i) { cw[k][i] = w0[i]; cw[k][4 + i] = w1[i]; } }
                const f32x4 b0 = *(const f32x4*)(a.in[I_SSD_CB] + l * 512 + c), b1 = *(const f32x4*)(a.in[I_SSD_CB] + l * 512 + c + 4);
#pragma unroll
                for (int i = 0; i < 4; ++i) { bias[i] = b0[i]; bias[4 + i] = b1[i]; } }
            const bf16* zp = ZB + (size_t)rowbase * NZB + zcol;
            v4u raw[20];
#pragma unroll
            for (int r = 0; r < 20; ++r) { const int t = t0 - 2 + r; raw[r] = (t >= 0 && t < T) ? *(const v4u*)(zp + (size_t)t * NZB) : (v4u){0u, 0u, 0u, 0u}; }
#pragma unroll
            for (int i = 0; i < 16; ++i) {
                float y[8];
#pragma unroll
                for (int q = 0; q < 8; ++q) y[q] = bias[q];
#pragma unroll
                for (int k = 0; k < 5; ++k) { const v4u rr = raw[i + k]; const unsigned uu[4] = {rr.x, rr.y, rr.z, rr.w};
#pragma unroll
                    for (int q = 0; q < 4; ++q) { y[2 * q] += cw[k][2 * q] * bf2f(uu[q] & 0xffffu); y[2 * q + 1] += cw[k][2 * q + 1] * bf2f(uu[q] >> 16); } }
                float ss = 0.f;
#pragma unroll
                for (int q = 0; q < 8; ++q) { y[q] = y[q] * sigmoid_fast(y[q]); ss += y[q] * y[q]; }
                if (blk < 8) { ss += dpp_xor1(ss); ss += dpp_xor2(ss); ss += __shfl_xor(ss, 4); float r = __builtin_amdgcn_rsqf(ss + LN_EPS); if (blk < 4) r *= 0.125f;
#pragma unroll
                    for (int q = 0; q < 8; ++q) y[q] *= r; }
                v4u o; o.x = cvt_pk_bf16(y[0], y[1]); o.y = cvt_pk_bf16(y[2], y[3]); o.z = cvt_pk_bf16(y[4], y[5]); o.w = cvt_pk_bf16(y[6], y[7]);
                *(v4u*)(PB + (size_t)(rowbase + t0 + i) * NPB + pcol) = o;
            }
        }
    }
}

__device__ __forceinline__ float red4(float x) { x += dpp_xor1(x); x += dpp_xor2(x); return x; }
__device__ __forceinline__ void phase_scan(const Args& a, LAS unsigned char* lds, const WCtx& w, int l) {
    LAS float* Qs = (LAS float*)lds; LAS float* Ks = Qs + 4096; LAS float* Dd = Qs + 8192; LAS float* Vs = Qs + 12288; LAS float* As = Qs + 16384; LAS float* Bs = As + 64;
    LAS bf16* Os = (LAS bf16*)(lds + 66048);
    const bf16* ZB = (const bf16*)(a.ws + WS_ZB); const float* ZF = (const float*)(a.ws + WS_ZF); const bf16* PB = (const bf16*)(a.ws + WS_PB); bf16* SO = (bf16*)(a.ws + WS_SO);
    const int sdir = w.tid >> 8, sr = (w.tid & 255) >> 3, c0 = (w.tid & 7) * 8;
    const int cdir = w.wave >> 2, eg = w.wave & 3, el = w.lane >> 2, dq = w.lane & 3;
    for (int pi = w.bid; pi < 192; pi += w.G) {
        const int mix = pi >> 6, b = (pi & 63) >> 2, h = pi & 3;
        float lbv[8]; float alog = 0.f, dtb = 0.f;
#pragma unroll
        for (int i = 0; i < 8; ++i) lbv[i] = 0.f;
        if (mix == 0) {
#pragma unroll
            for (int i = 0; i < 8; ++i) lbv[i] = ((const float*)(a.ws + WS_LB))[(sdir * 4 + l) * 256 + h * 64 + c0 + i]; }
        else if (mix == 1) { alog = expf(a.in[I_GDN_ALOG][(l * 2 + sdir) * 4 + h]); dtb = a.in[I_GDN_DTB][(l * 2 + sdir) * 4 + h]; }
        else { alog = expf(a.in[I_SSD_ALOG][(l * 2 + sdir) * 4 + h]); dtb = a.in[I_SSD_DTB][(l * 2 + sdir) * 4 + h]; }
        float S[16];
#pragma unroll
        for (int i = 0; i < 16; ++i) S[i] = 0.f;
        v4u rA, rB, rC; f32x4 rF0, rF1; float rs0 = 0.f, rs1 = 0.f;
        rA = rB = rC = (v4u){0u, 0u, 0u, 0u}; rF0 = rF1 = (f32x4){0.f, 0.f, 0.f, 0.f};
#define SCAN_ROW(dir_, sg_) (((sg_) < 256) ? (ML + b * 256 + ((dir_) ? 255 - (sg_) : (sg_))) : (b * 2048 + ((dir_) ? 2047 - ((sg_) - 256) : ((sg_) - 256))))
#define SCAN_LOAD(tb_) do { const int row_ = SCAN_ROW(sdir, (tb_) * 32 + sr); \
            if (mix == 0) { rA = *(const v4u*)(ZB + (size_t)row_ * NZB + h * 64 + c0); rC = *(const v4u*)(ZB + (size_t)row_ * NZB + 256 + h * 64 + c0); \
                            rF0 = *(const f32x4*)(ZF + (size_t)row_ * NZF + sdir * 256 + h * 64 + c0); rF1 = *(const f32x4*)(ZF + (size_t)row_ * NZF + sdir * 256 + h * 64 + c0 + 4); } \
            else if (mix == 1) { rA = *(const v4u*)(PB + (size_t)row_ * NPB + h * 64 + c0); rB = *(const v4u*)(PB + (size_t)row_ * NPB + 256 + h * 64 + c0); rC = *(const v4u*)(PB + (size_t)row_ * NPB + 512 + h * 64 + c0); \
                            rs0 = ZF[(size_t)row_ * NZF + 512 + sdir * 4 + h]; rs1 = ZF[(size_t)row_ * NZF + 520 + sdir * 4 + h]; } \
            else { rA = *(const v4u*)(PB + (size_t)row_ * NPB + 768 + 384 + (h >> 1) * 64 + c0); rB = *(const v4u*)(PB + (size_t)row_ * NPB + 768 + 256 + (h >> 1) * 64 + c0); rC = *(const v4u*)(PB + (size_t)row_ * NPB + 768 + h * 64 + c0); \
                            rs0 = ZF[(size_t)row_ * NZF + 528 + sdir * 4 + h]; } } while (0)
#define SCAN_STORE() do { const int o_ = (sdir * 32 + sr) * 64 + c0; float qa[8], ka[8], va[8], da[8]; \
            const unsigned ua[4] = {rA.x, rA.y, rA.z, rA.w}, ub[4] = {rB.x, rB.y, rB.z, rB.w}, uc[4] = {rC.x, rC.y, rC.z, rC.w}; \
            _Pragma("unroll") for (int i_ = 0; i_ < 4; ++i_) { qa[2 * i_] = bf2f(ua[i_] & 0xffffu); qa[2 * i_ + 1] = bf2f(ua[i_] >> 16); ka[2 * i_] = bf2f(ub[i_] & 0xffffu); ka[2 * i_ + 1] = bf2f(ub[i_] >> 16); \
                va[2 * i_] = bf2f(uc[i_] & 0xffffu); va[2 * i_ + 1] = bf2f(uc[i_] >> 16); } \
            if (mix == 0) { const float zf_[8] = {rF0[0], rF0[1], rF0[2], rF0[3], rF1[0], rF1[1], rF1[2], rF1[3]}; \
                _Pragma("unroll") for (int i_ = 0; i_ < 8; ++i_) { const float sg_ = sigmoid_acc(zf_[i_]); da[i_] = lbv[i_] + (1.0f - lbv[i_]) * sg_; ka[i_] = (1.0f - lbv[i_]) * (1.0f - sg_); qa[i_] = silu_acc(qa[i_]); } \
                if (c0 == 0) { As[sdir * 32 + sr] = 0.f; Bs[sdir * 32 + sr] = 0.f; } } \
            else if (mix == 1) { const float av_ = expf(-alog * softplus_acc(rs0 + dtb)); _Pragma("unroll") for (int i_ = 0; i_ < 8; ++i_) da[i_] = av_; \
                if (c0 == 0) { As[sdir * 32 + sr] = av_; Bs[sdir * 32 + sr] = sigmoid_acc(rs1); } } \
            else { const float dt_ = softplus_acc(rs0 + dtb); const float av_ = expf(-alog * dt_); _Pragma("unroll") for (int i_ = 0; i_ < 8; ++i_) { da[i_] = av_; va[i_] *= dt_; } \
                if (c0 == 0) { As[sdir * 32 + sr] = av_; Bs[sdir * 32 + sr] = 0.f; } } \
            *(LAS f32x4*)(Qs + o_) = (f32x4){qa[0], qa[1], qa[2], qa[3]}; *(LAS f32x4*)(Qs + o_ + 4) = (f32x4){qa[4], qa[5], qa[6], qa[7]}; \
            *(LAS f32x4*)(Ks + o_) = (f32x4){ka[0], ka[1], ka[2], ka[3]}; *(LAS f32x4*)(Ks + o_ + 4) = (f32x4){ka[4], ka[5], ka[6], ka[7]}; \
            *(LAS f32x4*)(Dd + o_) = (f32x4){da[0], da[1], da[2], da[3]}; *(LAS f32x4*)(Dd + o_ + 4) = (f32x4){da[4], da[5], da[6], da[7]}; \
            *(LAS f32x4*)(Vs + o_) = (f32x4){va[0], va[1], va[2], va[3]}; *(LAS f32x4*)(Vs + o_ + 4) = (f32x4){va[4], va[5], va[6], va[7]}; } while (0)
        SCAN_LOAD(0); SCAN_STORE(); __syncthreads();
        for (int tb = 0; tb < 72; ++tb) {
            if (tb + 1 < 72) SCAN_LOAD(tb + 1);
#pragma unroll 2
            for (int s = 0; s < 32; ++s) {
                const int base = (cdir * 32 + s) * 64 + dq * 16;
                f32x4 q4[4], k4[4];
#pragma unroll
                for (int i = 0; i < 4; ++i) { q4[i] = *(const LAS f32x4*)(Qs + base + 4 * i); k4[i] = *(const LAS f32x4*)(Ks + base + 4 * i); }
                float vv = Vs[(cdir * 32 + s) * 64 + eg * 16 + el];
                const float av = As[cdir * 32 + s];
                float o0 = 0.f, o1 = 0.f, o2 = 0.f, o3 = 0.f;
                if (mix == 0) {
                    f32x4 d4[4];
#pragma unroll
                    for (int i = 0; i < 4; ++i) d4[i] = *(const LAS f32x4*)(Dd + base + 4 * i);
#pragma unroll
                    for (int i = 0; i < 4; ++i) {
                        S[4 * i + 0] = d4[i][0] * S[4 * i + 0] + k4[i][0] * vv; o0 += q4[i][0] * S[4 * i + 0];
                        S[4 * i + 1] = d4[i][1] * S[4 * i + 1] + k4[i][1] * vv; o1 += q4[i][1] * S[4 * i + 1];
                        S[4 * i + 2] = d4[i][2] * S[4 * i + 2] + k4[i][2] * vv; o2 += q4[i][2] * S[4 * i + 2];
                        S[4 * i + 3] = d4[i][3] * S[4 * i + 3] + k4[i][3] * vv; o3 += q4[i][3] * S[4 * i + 3]; }
                } else {
                    if (mix == 1) { const float be = Bs[cdir * 32 + s]; float k0 = 0.f, k1 = 0.f, k2 = 0.f, k3 = 0.f;
#pragma unroll
                        for (int i = 0; i < 4; ++i) { k0 += k4[i][0] * S[4 * i + 0]; k1 += k4[i][1] * S[4 * i + 1]; k2 += k4[i][2] * S[4 * i + 2]; k3 += k4[i][3] * S[4 * i + 3]; }
                        const float ks = red4((k0 + k1) + (k2 + k3)); vv = be * (vv - av * ks); }
#pragma unroll
                    for (int i = 0; i < 4; ++i) {
                        S[4 * i + 0] = av * S[4 * i + 0] + k4[i][0] * vv; o0 += q4[i][0] * S[4 * i + 0];
                        S[4 * i + 1] = av * S[4 * i + 1] + k4[i][1] * vv; o1 += q4[i][1] * S[4 * i + 1];
                        S[4 * i + 2] = av * S[4 * i + 2] + k4[i][2] * vv; o2 += q4[i][2] * S[4 * i + 2];
                        S[4 * i + 3] = av * S[4 * i + 3] + k4[i][3] * vv; o3 += q4[i][3] * S[4 * i + 3]; }
                }
                const float o = red4((o0 + o1) + (o2 + o3));
                if (dq == 0) Os[(w.wave * 32 + s) * 16 + el] = (bf16)f2bf(o);
            }
            LDS_WAIT();
            { const int r = w.lane >> 1, hf = w.lane & 1; const int row = SCAN_ROW(cdir, tb * 32 + r);
              const v4u ov = *(const LAS v4u*)(Os + (w.wave * 32 + r) * 16 + hf * 8);
              *(v4u*)(SO + ((size_t)(mix * 2 + cdir) * MT + row) * 256 + h * 64 + eg * 16 + hf * 8) = ov; }
            __syncthreads();
            if (tb + 1 < 72) SCAN_STORE();
            __syncthreads();
        }
#undef SCAN_ROW
#undef SCAN_LOAD
#undef SCAN_STORE
    }
}

__device__ __forceinline__ f32x4 silu4(f32x4 x) { return (f32x4){silu_acc(x[0]), silu_acc(x[1]), silu_acc(x[2]), silu_acc(x[3])}; }
__device__ __forceinline__ f32x4 silu4f(f32x4 x) { return (f32x4){x[0] * sigmoid_fast(x[0]), x[1] * sigmoid_fast(x[1]), x[2] * sigmoid_fast(x[2]), x[3] * sigmoid_fast(x[3])}; }
__device__ __forceinline__ f32x4 bf4(v2u u) { return (f32x4){bf2f(u.x & 0xffffu), bf2f(u.x >> 16), bf2f(u.y & 0xffffu), bf2f(u.y >> 16)}; }
struct FinRow { v2u so[6], zg[3], px; f32x4 fo0, fo1; };
__device__ __forceinline__ void fin_load(FinRow& R, const bf16* ZB, const bf16* PB, const bf16* SO, const float* FO, int row, int ch) {
#pragma unroll
    for (int k = 0; k < 6; ++k) R.so[k] = *(const v2u*)(SO + ((size_t)k * MT + row) * 256 + ch);
    R.zg[0] = *(const v2u*)(ZB + (size_t)row * NZB + 512 + ch); R.zg[1] = *(const v2u*)(ZB + (size_t)row * NZB + 1536 + ch); R.zg[2] = *(const v2u*)(ZB + (size_t)row * NZB + 2560 + ch);
    R.px = *(const v2u*)(PB + (size_t)row * NPB + 768 + ch);
    R.fo0 = *(const f32x4*)(FO + (size_t)row * 256 + ch); R.fo1 = (f32x4){0.f, 0.f, 0.f, 0.f};
}
__device__ __forceinline__ void phase_finish(const Args& a, const WCtx& w, int l, int nrows) {
    const bf16* ZB = (const bf16*)(a.ws + WS_ZB); const bf16* PB = (const bf16*)(a.ws + WS_PB); const bf16* SO = (const bf16*)(a.ws + WS_SO); const float* FO = (const float*)(a.ws + WS_FO);
    bf16* OUTS = (bf16*)(a.ws + WS_OUTS);
    const int ch = 4 * w.lane, hd = w.lane >> 4;
    const f32x4 nwa = *(const f32x4*)(a.in[I_HGRN_NW] + l * 256 + ch), nwb = *(const f32x4*)(a.in[I_GDN_NW] + l * 256 + ch), nwd = *(const f32x4*)(a.in[I_SSD_NW] + l * 256 + ch);
    const float dsk = a.in[I_SSD_D][l * 4 + hd];
    int row = w.gw; FinRow R, Rn;
    if (row < nrows) fin_load(R, ZB, PB, SO, FO, row, ch);
    while (row < nrows) {
        const int nrow = row + w.NGW;
        if (nrow < nrows) fin_load(Rn, ZB, PB, SO, FO, nrow, ch);
        asm volatile("" ::: "memory");
        bf16* orow = OUTS + (size_t)row * 1024 + ch;
        { f32x4 o = bf4(R.so[0]) + bf4(R.so[1]);
          float ss = (o[0] * o[0] + o[1] * o[1]) + (o[2] * o[2] + o[3] * o[3]); ss += dpp_xor1(ss); ss += dpp_xor2(ss); ss += __shfl_xor(ss, 4); ss += __shfl_xor(ss, 8);
          const float r = __builtin_amdgcn_rsqf(ss * (1.f / 64.f) + LN_EPS); st_bf4(orow, o * r * nwa * silu4f(bf4(R.zg[0]))); }
        { f32x4 o = bf4(R.so[2]) + bf4(R.so[3]);
          float ss = (o[0] * o[0] + o[1] * o[1]) + (o[2] * o[2] + o[3] * o[3]); ss += dpp_xor1(ss); ss += dpp_xor2(ss); ss += __shfl_xor(ss, 4); ss += __shfl_xor(ss, 8);
          const float r = __builtin_amdgcn_rsqf(ss * (1.f / 64.f) + LN_EPS); st_bf4(orow + 256, o * r * nwb * silu4f(bf4(R.zg[1]))); }
        st_bf4(orow + 512, R.fo0 + R.fo1);
        { f32x4 o = bf4(R.so[4]) + bf4(R.so[5]); f32x4 y = (o + bf4(R.px) * dsk) * silu4f(bf4(R.zg[2]));
          const float ss = wave_sum((y[0] * y[0] + y[1] * y[1]) + (y[2] * y[2] + y[3] * y[3]));
          const float r = __builtin_amdgcn_rsqf(ss * (1.f / 256.f) + LN_EPS); st_bf4(orow + 768, y * r * nwd); }
        R = Rn; row = nrow;
    }
}

__device__ __forceinline__ int row_batch(int row) { return row < ML ? (row >> 11) : 16; }
__device__ __forceinline__ void phase_ln1(const Args& a, LAS unsigned char* lds, const WCtx& w, int l, int nrows) {
    LAS float* WRT = (LAS float*)lds;
    LAS float* LNG = WRT + 16384; LAS float* LNB = LNG + 1024; LAS float* BV = LNB + 1024;
    const int rpb = (nrows + w.G - 1) / w.G, r0 = w.bid * rpb, r1 = (r0 + rpb < nrows) ? r0 + rpb : nrows;
    const int b_lo = row_batch(r0 < nrows ? r0 : 0), b_hi = row_batch(r1 > r0 ? r1 - 1 : 0);
    for (int i = w.tid; i < 16384; i += NTHREADS) { const int d = i >> 4, e = i & 15; WRT[e * 1024 + d] = a.in[I_WROUTER][(size_t)l * 16384 + i]; }
    for (int i = w.tid; i < 1024; i += NTHREADS) { LNG[i] = a.in[I_LN1G][l * 1024 + i]; LNB[i] = a.in[I_LN1B][l * 1024 + i];
#pragma unroll
        for (int s = 0; s < 2; ++s) { const float* mp = (const float*)(a.ws + WS_MOD) + (size_t)(l * 17 + (s ? b_hi : b_lo)) * 6144;
            BV[(s * 3 + 0) * 1024 + i] = mp[2048 + i]; BV[(s * 3 + 1) * 1024 + i] = mp[3072 + i]; BV[(s * 3 + 2) * 1024 + i] = mp[4096 + i]; } }
    __syncthreads();
    float* X = (float*)(a.ws + WS_X); const bf16* Y = (const bf16*)(a.ws + WS_Y); bf16* H = (bf16*)(a.ws + WS_H); float* AFF = (float*)(a.ws + WS_AFF);
    int row = r0 + w.wave;
    f32x4 x[4]; v2u yb[4];
#pragma unroll
    for (int j = 0; j < 4; ++j) { x[j] = (f32x4){0.f, 0.f, 0.f, 0.f}; yb[j] = (v2u){0u, 0u}; }
    if (row < r1) { row_load(X + (size_t)row * 1024, w.lane, x);
#pragma unroll
        for (int j = 0; j < 4; ++j) yb[j] = *((const v2u*)(Y + (size_t)row * 1024) + w.lane + 64 * j); }
    while (row < r1) {
        const int nrow = row + NWAVES; f32x4 xn[4]; v2u ybn[4];
#pragma unroll
        for (int j = 0; j < 4; ++j) { xn[j] = (f32x4){0.f, 0.f, 0.f, 0.f}; ybn[j] = (v2u){0u, 0u}; }
        if (nrow < r1) { row_load(X + (size_t)nrow * 1024, w.lane, xn);
#pragma unroll
            for (int j = 0; j < 4; ++j) ybn[j] = *((const v2u*)(Y + (size_t)nrow * 1024) + w.lane + 64 * j); }
        asm volatile("" ::: "memory");
        const LAS float* bv = BV + ((row_batch(row) != b_lo) ? 3 * 1024 : 0);
        f32x4 hv[4];
#pragma unroll
        for (int j = 0; j < 4; ++j) { const f32x4 g1 = *(const LAS f32x4*)(bv + 4 * w.lane + 256 * j);
            const f32x4 yv = (f32x4){bf2f(yb[j].x & 0xffffu), bf2f(yb[j].x >> 16), bf2f(yb[j].y & 0xffffu), bf2f(yb[j].y >> 16)};
            x[j] = x[j] * ALPHA + g1 * yv; }
        float mean, rstd; ln_stats(x, mean, rstd);
#pragma unroll
        for (int j = 0; j < 4; ++j) x[j] = (x[j] - mean) * rstd * *(const LAS f32x4*)(LNG + 4 * w.lane + 256 * j) + *(const LAS f32x4*)(LNB + 4 * w.lane + 256 * j);
        row_store(X + (size_t)row * 1024, w.lane, x);
        ln_stats(x, mean, rstd);
        { unsigned* hrow = (unsigned*)((unsigned char*)H + (size_t)row * 1024);
#pragma unroll
          for (int j = 0; j < 4; ++j) { const f32x4 sh = *(const LAS f32x4*)(bv + 1024 + 4 * w.lane + 256 * j), sc = *(const LAS f32x4*)(bv + 2048 + 4 * w.lane + 256 * j);
              hv[j] = (x[j] - mean) * rstd * (sc + 1.0f) + sh;
              hrow[w.lane + 64 * j] = pk4_fp8(fminf(fmaxf(hv[j][0], -448.f), 448.f), fminf(fmaxf(hv[j][1], -448.f), 448.f), fminf(fmaxf(hv[j][2], -448.f), 448.f), fminf(fmaxf(hv[j][3], -448.f), 448.f)); } }
        float pe[16];
#pragma unroll
        for (int e = 0; e < 16; ++e) { float p = 0.f;
#pragma unroll
            for (int j = 0; j < 4; ++j) { const f32x4 wv = *(const LAS f32x4*)(WRT + e * 1024 + 256 * j + 4 * w.lane); p += (hv[j][0] * wv[0] + hv[j][1] * wv[1]) + (hv[j][2] * wv[2] + hv[j][3] * wv[3]); }
            pe[e] = p; }
        float q8[8], q4[4], q2[2];
        { const bool hi = (w.lane & 32) != 0;
#pragma unroll
          for (int k = 0; k < 8; ++k) { const float mine = hi ? pe[k + 8] : pe[k], oth = hi ? pe[k] : pe[k + 8]; q8[k] = mine + __shfl_xor(oth, 32); } }
        { const bool hi = (w.lane & 16) != 0;
#pragma unroll
          for (int k = 0; k < 4; ++k) { const float mine = hi ? q8[k + 4] : q8[k], oth = hi ? q8[k] : q8[k + 4]; q4[k] = mine + __shfl_xor(oth, 16); } }
        { const bool hi = (w.lane & 8) != 0;
#pragma unroll
          for (int k = 0; k < 2; ++k) { const float mine = hi ? q4[k + 2] : q4[k], oth = hi ? q4[k] : q4[k + 2]; q2[k] = mine + __shfl_xor(oth, 8); } }
        float lg;
        { const bool hi = (w.lane & 4) != 0; const float mine = hi ? q2[1] : q2[0], oth = hi ? q2[0] : q2[1]; lg = mine + __shfl_xor(oth, 4); }
        lg += dpp_xor1(lg); lg += dpp_xor2(lg);
        float mx = lg;
        mx = fmaxf(mx, __shfl_xor(mx, 4)); mx = fmaxf(mx, __shfl_xor(mx, 8)); mx = fmaxf(mx, __shfl_xor(mx, 16)); mx = fmaxf(mx, __shfl_xor(mx, 32));
        const float ex = __expf(lg - mx); float s = ex;
        s += __shfl_xor(s, 4); s += __shfl_xor(s, 8); s += __shfl_xor(s, 16); s += __shfl_xor(s, 32);
        if ((w.lane & 3) == 0) AFF[(size_t)row * 16 + (w.lane >> 2)] = ex / s;
#pragma unroll
        for (int j = 0; j < 4; ++j) { x[j] = xn[j]; yb[j] = ybn[j]; }
        row = nrow;
    }
}

__device__ __forceinline__ void phase_topk(const Args& a, LAS unsigned char* lds, const WCtx& w, int nitems) {
    LAS int* CNT = (LAS int*)lds;
    LAS int* WS1 = CNT + 16;
    LAS int* WS2 = WS1 + 8;
    LAS int* SEL = WS2 + 8;
    LAS int* SELW = SEL + 256;
    const float* AFF = (const float*)(a.ws + WS_AFF); int* SLOT = (int*)(a.ws + WS_SLOT); float* ROWW = (float*)(a.ws + WS_ROWW);
    int* SELROW = (int*)(a.ws + WS_ROWW + 512 * 1024);
    for (int it2 = w.gw; it2 < nitems - 256; it2 += w.NGW) {
        const int b = it2 >> 4, e = it2 & 15, rowbase = ML + b * 256, xebase = 65536 + e * 512 + b * 32;
        unsigned key[4];
#pragma unroll
        for (int j = 0; j < 4; ++j) key[j] = __float_as_uint(AFF[(size_t)(rowbase + w.lane * 4 + j) * 16 + e]);
        unsigned T = 0u;
        for (int bit = 29; bit >= 0; --bit) { const unsigned trial = T | (1u << bit); int tot = 0;
#pragma unroll
            for (int j = 0; j < 4; ++j) tot += __popcll(__ballot(key[j] >= trial));
            if (tot >= CAP_C) T = trial; }
        int ngt = 0, ceq = 0;
#pragma unroll
        for (int j = 0; j < 4; ++j) { ngt += (key[j] > T) ? 1 : 0; ceq += (key[j] == T) ? 1 : 0; }
        int xg = ngt, xq = ceq;
#pragma unroll
        for (int o = 1; o < 64; o <<= 1) { const int yg = __shfl_up(xg, o), yq = __shfl_up(xq, o); if (w.lane >= o) { xg += yg; xq += yq; } }
        const int need_eq = CAP_C - __shfl(xg, 63); int eqrank = xq - ceq;
        int sel[4], csel = 0;
#pragma unroll
        for (int j = 0; j < 4; ++j) { const bool iseq = key[j] == T; sel[j] = (key[j] > T) || (iseq && eqrank < need_eq); if (iseq) ++eqrank; csel += sel[j]; }
        int xs = csel;
#pragma unroll
        for (int o = 1; o < 64; o <<= 1) { const int ys = __shfl_up(xs, o); if (w.lane >= o) xs += ys; }
        int slot = xs - csel;
#pragma unroll
        for (int j = 0; j < 4; ++j) { const int t = w.lane * 4 + j; int sv = -1; if (sel[j] && slot < CAP_C) { sv = slot; ROWW[xebase + slot] = __uint_as_float(key[j]); ++slot; }
            SLOT[(size_t)(rowbase + t) * 16 + e] = sv;
            if (sv >= 0) SELW[w.wave * 32 + sv] = t; }
        LDS_WAIT();
        if (w.lane < CAP_C) SELROW[xebase + w.lane] = rowbase + SELW[w.wave * 32 + w.lane];
        LDS_WAIT();
    }
    __syncthreads();
    for (int item = w.bid; item < (nitems < 256 ? nitems : 256); item += w.G) {
        int b, e, n, cap, rowbase, xebase;
        if (item < 256) { b = item >> 4; e = item & 15; n = 2048; cap = CAP_L; rowbase = b * 2048; xebase = e * 4096 + b * 256; }
        else { const int it2 = item - 256; b = it2 >> 4; e = it2 & 15; n = 256; cap = CAP_C; rowbase = ML + b * 256; xebase = 65536 + e * 512 + b * 32; }
        unsigned key[4];
#pragma unroll
        for (int j = 0; j < 4; ++j) { const int t = w.tid * 4 + j; key[j] = t < n ? __float_as_uint(AFF[(size_t)(rowbase + t) * 16 + e]) : 0u; }
        unsigned T = 0u;
        for (int bit = 29; bit >= 0; --bit) {
            const unsigned trial = T | (1u << bit); int c = 0;
#pragma unroll
            for (int j = 0; j < 4; ++j) c += (key[j] >= trial) ? 1 : 0;
#pragma unroll
            for (int o = 1; o < 64; o <<= 1) c += __shfl_xor(c, o);
            LAS int* cb = CNT + (bit & 1) * 8;
            if (w.lane == 0) cb[w.wave] = c;
            __syncthreads();
            int tot = 0;
#pragma unroll
            for (int q = 0; q < 8; ++q) tot += cb[q];
            if (tot >= cap) T = trial;
        }
        int ngt = 0, ceq = 0;
#pragma unroll
        for (int j = 0; j < 4; ++j) { ngt += (key[j] > T) ? 1 : 0; ceq += (key[j] == T && key[j] != 0u) ? 1 : 0; }
        int xg = ngt, xe = ceq;
#pragma unroll
        for (int o = 1; o < 64; o <<= 1) { const int yg = __shfl_up(xg, o), ye = __shfl_up(xe, o); if (w.lane >= o) { xg += yg; xe += ye; } }
        __syncthreads();
        if (w.lane == 63) { WS1[w.wave] = xg; WS2[w.wave] = xe; }
        __syncthreads();
        int totg = 0, offe = 0;
#pragma unroll
        for (int q = 0; q < 8; ++q) { totg += WS1[q]; if (q < w.wave) offe += WS2[q]; }
        const int need_eq = cap - totg; int eqrank = offe + xe - ceq;
        int sel[4], csel = 0;
#pragma unroll
        for (int j = 0; j < 4; ++j) { const bool iseq = (key[j] == T && key[j] != 0u); sel[j] = (key[j] > T) || (iseq && eqrank < need_eq); if (iseq) ++eqrank; csel += sel[j]; }
        int xs = csel;
#pragma unroll
        for (int o = 1; o < 64; o <<= 1) { const int ys = __shfl_up(xs, o); if (w.lane >= o) xs += ys; }
        __syncthreads();
        if (w.lane == 63) WS1[w.wave] = xs;
        __syncthreads();
        int offs = 0;
#pragma unroll
        for (int q = 0; q < 8; ++q) if (q < w.wave) offs += WS1[q];
        int slot = offs + xs - csel;
#pragma unroll
        for (int j = 0; j < 4; ++j) { const int t = w.tid * 4 + j; if (t < n) { int sv = -1; if (sel[j]) { sv = slot; if (slot < cap) { SEL[slot] = t; ROWW[xebase + slot] = __uint_as_float(key[j]); } ++slot; }
                SLOT[(size_t)(rowbase + t) * 16 + e] = (sv < cap) ? sv : -1; } }
        __syncthreads();
        for (int s = w.tid; s < cap; s += NTHREADS) SELROW[xebase + s] = rowbase + SEL[s];
        __syncthreads();
    }
}

__device__ __forceinline__ void phase_ln2(const Args& a, LAS unsigned char* lds, const WCtx& w, int l, int nrows) {
    LAS float* LNG = (LAS float*)lds; LAS float* LNB = LNG + 1024; LAS float* BV = LNB + 1024;
    const int rpb = (nrows + w.G - 1) / w.G, r0 = w.bid * rpb, r1 = (r0 + rpb < nrows) ? r0 + rpb : nrows;
    const int b_lo = row_batch(r0 < nrows ? r0 : 0), b_hi = row_batch(r1 > r0 ? r1 - 1 : 0);
    const int ln = (l + 1 < DEPTH) ? l + 1 : l;
    for (int i = w.tid; i < 1024; i += NTHREADS) { LNG[i] = a.in[I_LN2G][l * 1024 + i]; LNB[i] = a.in[I_LN2B][l * 1024 + i];
#pragma unroll
        for (int s = 0; s < 2; ++s) { const int bb = s ? b_hi : b_lo; const float* mp = (const float*)(a.ws + WS_MOD) + (size_t)(l * 17 + bb) * 6144; const float* mn = (const float*)(a.ws + WS_MOD) + (size_t)(ln * 17 + bb) * 6144;
            BV[(s * 3 + 0) * 1024 + i] = mp[5120 + i]; BV[(s * 3 + 1) * 1024 + i] = mn[i]; BV[(s * 3 + 2) * 1024 + i] = mn[1024 + i]; } }
    __syncthreads();
    float* X = (float*)(a.ws + WS_X); bf16* H = (bf16*)(a.ws + WS_H); const unsigned char* YE = (const unsigned char*)(a.ws + WS_YE);   const int* SLOT = (const int*)(a.ws + WS_SLOT);
    int row = r0 + w.wave;
    f32x4 x[4]; int myslot = -1;
#pragma unroll
    for (int j = 0; j < 4; ++j) x[j] = (f32x4){0.f, 0.f, 0.f, 0.f};
    if (row < r1) { row_load(X + (size_t)row * 1024, w.lane, x); myslot = SLOT[(size_t)row * 16 + (w.lane & 15)]; }
    while (row < r1) {
        const int nrow = row + NWAVES; f32x4 xn[4]; int nslot = -1;
#pragma unroll
        for (int j = 0; j < 4; ++j) xn[j] = (f32x4){0.f, 0.f, 0.f, 0.f};
        f32x4 mo[4];
#pragma unroll
        for (int j = 0; j < 4; ++j) mo[j] = (f32x4){0.f, 0.f, 0.f, 0.f};
        const int b = row < ML ? (row >> 11) : ((row - ML) >> 8);
        unsigned m = (unsigned)(__ballot(myslot >= 0) & 0xFFFFull);
        while (m) {
            unsigned t[4][4];
#pragma unroll
            for (int k = 0; k < 4; ++k) {
#pragma unroll
                for (int j = 0; j < 4; ++j) t[k][j] = 0u;
                if (m) { const int e = __builtin_ctz(m); m &= m - 1u; const int s = __shfl(myslot, e);
                    const size_t xr = row < ML ? (size_t)(e * 4096 + b * 256 + s) : (size_t)(65536 + e * 512 + b * 32 + s); const unsigned* yr = (const unsigned*)(YE + xr * 1024) + w.lane;
#pragma unroll
                    for (int j = 0; j < 4; ++j) t[k][j] = yr[64 * j]; } }
#pragma unroll
            for (int k = 0; k < 4; ++k)
#pragma unroll
                for (int j = 0; j < 4; ++j) { const f32x2 lo = __builtin_amdgcn_cvt_pk_f32_fp8((int)t[k][j], false), hi = __builtin_amdgcn_cvt_pk_f32_fp8((int)t[k][j], true); mo[j][0] += lo[0]; mo[j][1] += lo[1]; mo[j][2] += hi[0]; mo[j][3] += hi[1]; }
        }
#pragma unroll
        for (int j = 0; j < 4; ++j) mo[j] = mo[j] * (1.0f / 64.0f);
        if (nrow < r1) { row_load(X + (size_t)nrow * 1024, w.lane, xn); nslot = SLOT[(size_t)nrow * 16 + (w.lane & 15)]; }
        asm volatile("" ::: "memory");
        const LAS float* bv = BV + ((row_batch(row) != b_lo) ? 3 * 1024 : 0);
#pragma unroll
        for (int j = 0; j < 4; ++j) x[j] = x[j] * ALPHA + *(const LAS f32x4*)(bv + 4 * w.lane + 256 * j) * mo[j];
        float mean, rstd; ln_stats(x, mean, rstd);
#pragma unroll
        for (int j = 0; j < 4; ++j) x[j] = (x[j] - mean) * rstd * *(const LAS f32x4*)(LNG + 4 * w.lane + 256 * j) + *(const LAS f32x4*)(LNB + 4 * w.lane + 256 * j);
        if (l == DEPTH - 1) row_store(a.out + (size_t)row * 1024, w.lane, x);
        else { row_store(X + (size_t)row * 1024, w.lane, x);
            ln_stats(x, mean, rstd); bf16* hrow = H + (size_t)row * 1024;
#pragma unroll
            for (int j = 0; j < 4; ++j) { const f32x4 sh = *(const LAS f32x4*)(bv + 1024 + 4 * w.lane + 256 * j), sc = *(const LAS f32x4*)(bv + 2048 + 4 * w.lane + 256 * j);
                const f32x4 hv = (x[j] - mean) * rstd * (sc + 1.0f) + sh;
                v2u wv; wv.x = cvt_pk_bf16(hv[0], hv[1]); wv.y = cvt_pk_bf16(hv[2], hv[3]); *((v2u*)hrow + w.lane + 64 * j) = wv;
                ((unsigned*)(a.ws + WS_H8 + (size_t)row * 1024))[w.lane + 64 * j] = pk4c_fp8(hv); } }
#pragma unroll
        for (int j = 0; j < 4; ++j) x[j] = xn[j];
        myslot = nslot; row = nrow;
    }
}
typedef float f32x16 __attribute__((ext_vector_type(16)));
constexpr int TS = 72, TILE_BYTES = 64 * TS * 2;
constexpr int SCG_BYTES = 7 * TILE_BYTES + 2048;
constexpr size_t WS_UT = WS_R1 + 684 * MiB;
constexpr size_t WS_WW = WS_R1 + 720 * MiB;
__device__ __forceinline__ f32x16 mma64(f32x16 acc, const LAS bf16* A, const LAS bf16* BT, int lane) {
    const int r = lane & 31, h = lane >> 5;
    const LAS bf16* ap = A + r * TS + 8 * h; const LAS bf16* bp = BT + r * TS + 8 * h;
#pragma unroll
    for (int ks = 0; ks < 4; ++ks) { const bf16x8 av = *(const LAS bf16x8*)(ap + ks * 16), bv = *(const LAS bf16x8*)(bp + ks * 16); acc = __builtin_amdgcn_mfma_f32_32x32x16_bf16(av, bv, acc, 0, 0, 0); }
    return acc;
}
__device__ __forceinline__ int swz(int row, int col) { return row * TS + ((((col >> 3) ^ ((row >> 4) & 3)) << 3) | (col & 7)); }
template <bool SWA, bool SWB>
__device__ __forceinline__ f32x16 mma64s(f32x16 acc, const LAS bf16* A, int ablk, const LAS bf16* BT, int bblk, int lane) {
    const int r = lane & 31, h = lane >> 5;
    const int sa = SWA ? ((2 * ablk + (r >> 4)) & 3) : 0, sb = SWB ? ((2 * bblk + (r >> 4)) & 3) : 0;
    const LAS bf16* ap = A + (32 * ablk + r) * TS; const LAS bf16* bp = BT + (32 * bblk + r) * TS;
#pragma unroll
    for (int ks = 0; ks < 4; ++ks) { const bf16x8 av = *(const LAS bf16x8*)(ap + (((2 * ks + h) ^ sa) << 3)), bv = *(const LAS bf16x8*)(bp + (((2 * ks + h) ^ sb) << 3)); acc = __builtin_amdgcn_mfma_f32_32x32x16_bf16(av, bv, acc, 0, 0, 0); }
    return acc;
}
__device__ __forceinline__ f32x16 zero16() { f32x16 z;
#pragma unroll
    for (int i = 0; i < 16; ++i) z[i] = 0.f;
    return z; }
__device__ __forceinline__ int chain_row(int b, int dir, int c, int i) {
    if (c < 4) { const int p = 64 * c + i; return ML + b * 256 + (dir ? 255 - p : p); }
    const int p = 64 * (c - 4) + i; return b * 2048 + (dir ? 2047 - p : p);
}
__device__ __forceinline__ float expc(float x) { return __expf(fminf(x, 80.f)); }
__device__ __forceinline__ bf16 bfr(float x) { return (bf16)cvt_pk_bf16(x, x); }
__device__ __forceinline__ void st4bf(LAS bf16* p, float a, float b, float c, float d) { v2u w; w.x = cvt_pk_bf16(a, b); w.y = cvt_pk_bf16(c, d); *(LAS v2u*)p = w; }
__device__ __forceinline__ void unpack8(const v4u u, float (&f)[8]) { f[0] = bf2f(u.x & 0xffffu); f[1] = bf2f(u.x >> 16); f[2] = bf2f(u.y & 0xffffu); f[3] = bf2f(u.y >> 16); f[4] = bf2f(u.z & 0xffffu); f[5] = bf2f(u.z >> 16); f[6] = bf2f(u.w & 0xffffu); f[7] = bf2f(u.w >> 16); }
__device__ __forceinline__ void store_state_T(LAS bf16* TST, const f32x16& S, int wm, int wn, int r, int hh) {
#pragma unroll
    for (int q = 0; q < 4; ++q) st4bf(TST + (32 * wn + r) * TS + 32 * wm + 8 * q + 4 * hh, S[4 * q], S[4 * q + 1], S[4 * q + 2], S[4 * q + 3]);
}

constexpr int SOLVE_ITEM_BYTES = 33024;
__device__ __forceinline__ void solve_diag(float (&x)[64], const LAS float* AT, const int o, const int ja, const int jb) {
#pragma unroll
    for (int j = ja; j < jb; ++j) { const float xj = x[o + j];
        int z = 0; if (j >= 2) asm("" : "+v"(z) : "v"(x[o + j - 2]));
        const LAS float* ATj = AT + z;
#pragma unroll
        for (int i4 = ((j + 1) >> 2) << 2; i4 < 32; i4 += 4) { const f32x4 av = *(const LAS f32x4*)(ATj + j * 36 + i4);
#pragma unroll
            for (int t = 0; t < 4; ++t) if (i4 + t > j) x[o + i4 + t] -= av[t] * xj; } }
}
__device__ __forceinline__ void phase_gdn_solve(const Args& a, LAS unsigned char* lds, const WCtx& w, int l) {
    const int sub = w.wave >> 1, wv = w.wave & 1;
    LAS unsigned char* gb = lds + sub * SOLVE_ITEM_BYTES;
    LAS bf16* TK = (LAS bf16*)gb; LAS float* A11T = (LAS float*)(gb + 9216); LAS float* A22T = (LAS float*)(gb + 13824); LAS bf16* A21 = (LAS bf16*)(gb + 18432);
    LAS bf16* XT = (wv == 0) ? TK : (LAS bf16*)(gb + 23040); LAS float* G = (LAS float*)(gb + 32256); LAS float* BETA = G + 64;
    const bf16* PB = (const bf16*)(a.ws + WS_PB); const float* ZF = (const float*)(a.ws + WS_ZF);
    bf16* UT = (bf16*)(a.ws + WS_UT); bf16* WW = (bf16*)(a.ws + WS_WW);
    const int rounds = (128 * 36 + 4 * w.G - 1) / (4 * w.G);
    for (int k = 0; k < rounds; ++k) {
        int tl_ = w.tid; asm volatile("" : "+v"(tl_));
        const int t2 = tl_ & 127, lane = tl_ & 63, r = lane & 31, hh = lane >> 5;
        const int it = k * 4 * w.G + w.bid * 4 + sub;
        const bool live = it < 128 * 36;
        const int chain = live ? it / 36 : 0, c = live ? it - chain * 36 : 0; const int b = chain >> 3, h = (chain >> 1) & 3, dir = chain & 1;
        const int row0 = chain_row(b, dir, c, 0); const long sg = dir ? -1 : 1;
        float x[64];
        { const bf16* xp = PB + (size_t)row0 * NPB + (wv == 0 ? 512 : 256) + h * 64 + lane;
#pragma unroll
          for (int i = 0; i < 32; ++i) x[i] = bf2f(xp[sg * i * NPB]); }
        { const int i = t2 >> 1, hf = t2 & 1; const v4u* src = (const v4u*)(PB + (size_t)(row0 + sg * i) * NPB + 256 + h * 64 + 32 * hf);
          const v4u k0 = src[0], k1 = src[1], k2 = src[2], k3 = src[3]; LAS v4u* dst = (LAS v4u*)(TK + i * TS + 32 * hf); dst[0] = k0; dst[1] = k1; dst[2] = k2; dst[3] = k3; }
        if (wv == 0) { const int row = row0 + (int)sg * lane;
            const float al = expf(a.in[I_GDN_ALOG][(l * 2 + dir) * 4 + h]), dtb = a.in[I_GDN_DTB][(l * 2 + dir) * 4 + h];
            float g = -al * softplus_acc(ZF[(size_t)row * NZF + 512 + dir * 4 + h] + dtb);
#pragma unroll
            for (int o = 1; o < 64; o <<= 1) { const float y = __shfl_up(g, o); if (lane >= o) g += y; }
            const float be = sigmoid_acc(ZF[(size_t)row * NZF + 520 + dir * 4 + h]); G[lane] = g; BETA[lane] = be; BETA[64 + lane] = be * __expf(g); }
        __syncthreads();
        if (wv == 0) {
#pragma unroll
            for (int bi = 0; bi < 2; ++bi) {
                f32x16 acc = zero16(); acc = mma64(acc, TK + 32 * bi * TS, TK + 32 * bi * TS, lane);
                LAS float* AT = bi ? A22T : A11T; const float gj = G[32 * bi + r];
#pragma unroll
                for (int q = 0; q < 4; ++q) { const int i0 = 8 * q + 4 * hh; const f32x4 gi = *(const LAS f32x4*)(G + 32 * bi + i0), bi4 = *(const LAS f32x4*)(BETA + 32 * bi + i0); f32x4 o;
#pragma unroll
                    for (int t = 0; t < 4; ++t) o[t] = (r < i0 + t) ? bi4[t] * acc[4 * q + t] * __expf(gi[t] - gj) : 0.f;
                    *(LAS f32x4*)(AT + r * 36 + i0) = o; } }
        } else {
            f32x16 acc = zero16(); acc = mma64(acc, TK, TK + 32 * TS, lane);
            const float gi = G[32 + r], bi = BETA[32 + r];
#pragma unroll
            for (int q = 0; q < 4; ++q) { const int j0 = 8 * q + 4 * hh; const f32x4 gj = *(const LAS f32x4*)(G + j0);
                st4bf(A21 + r * TS + j0, bi * acc[4 * q] * __expf(gi - gj[0]), bi * acc[4 * q + 1] * __expf(gi - gj[1]), bi * acc[4 * q + 2] * __expf(gi - gj[2]), bi * acc[4 * q + 3] * __expf(gi - gj[3])); }
        }
        __syncthreads();
        {
#pragma unroll
            for (int i = 0; i < 32; i += 4) { const f32x4 sc = *(const LAS f32x4*)(BETA + 64 * wv + i);
#pragma unroll
                for (int t = 0; t < 4; ++t) x[i + t] *= sc[t]; }
            solve_diag(x, A11T, 0, 0, 12);
            { long zz = 0; asm volatile("" : "+v"(zz) : "v"(x[11]));
              const bf16* xp = PB + (size_t)row0 * NPB + (wv == 0 ? 512 : 256) + h * 64 + lane + zz;
#pragma unroll
              for (int i = 32; i < 64; ++i) x[i] = bf2f(xp[sg * i * NPB]); }
            solve_diag(x, A11T, 0, 12, 31);
#pragma unroll
            for (int i = 32; i < 64; i += 4) { const f32x4 sc = *(const LAS f32x4*)(BETA + 64 * wv + i);
#pragma unroll
                for (int t = 0; t < 4; ++t) x[i + t] *= sc[t]; }
#pragma unroll
            for (int q = 0; q < 4; ++q) { v4u o; o.x = cvt_pk_bf16(x[8 * q], x[8 * q + 1]); o.y = cvt_pk_bf16(x[8 * q + 2], x[8 * q + 3]); o.z = cvt_pk_bf16(x[8 * q + 4], x[8 * q + 5]); o.w = cvt_pk_bf16(x[8 * q + 6], x[8 * q + 7]); *(LAS v4u*)(XT + lane * TS + 8 * q) = o; }
            f32x16 d0 = zero16(), d1 = zero16();
#pragma unroll
            for (int ks = 0; ks < 2; ++ks) { const bf16x8 av = *(const LAS bf16x8*)(A21 + r * TS + 8 * hh + 16 * ks);
                const bf16x8 b0 = *(const LAS bf16x8*)(XT + r * TS + 8 * hh + 16 * ks), b1 = *(const LAS bf16x8*)(XT + (32 + r) * TS + 8 * hh + 16 * ks);
                d0 = __builtin_amdgcn_mfma_f32_32x32x16_bf16(av, b0, d0, 0, 0, 0); d1 = __builtin_amdgcn_mfma_f32_32x32x16_bf16(av, b1, d1, 0, 0, 0); }
#pragma unroll
            for (int e = 0; e < 16; ++e) { const auto sw = __builtin_amdgcn_permlane32_swap(__float_as_uint(d0[e]), __float_as_uint(d1[e]), false, false);
                x[32 + 8 * (e >> 2) + (e & 3)] -= __uint_as_float(sw[0]); x[32 + 8 * (e >> 2) + 4 + (e & 3)] -= __uint_as_float(sw[1]); }
            solve_diag(x, A22T, 32, 0, 31);
            if (live) {
                if (wv == 0) { bf16* dst = UT + ((size_t)(chain * 36 + c) * 64 + lane) * 64;
#pragma unroll
                    for (int q = 0; q < 8; ++q) { v4u o; o.x = cvt_pk_bf16(x[8 * q], x[8 * q + 1]); o.y = cvt_pk_bf16(x[8 * q + 2], x[8 * q + 3]); o.z = cvt_pk_bf16(x[8 * q + 4], x[8 * q + 5]); o.w = cvt_pk_bf16(x[8 * q + 6], x[8 * q + 7]); *(v4u*)(dst + 8 * q) = o; } }
                else { bf16* dst = WW + (size_t)(chain * 36 + c) * 4096 + lane;
#pragma unroll
                    for (int j = 0; j < 64; ++j) dst[j * 64] = (bf16)f2bf(x[j]); }
            }
        }
        __syncthreads();
    }
}
#define LBAR() asm volatile("s_waitcnt lgkmcnt(0)\n\ts_barrier" ::: "memory")
__device__ __forceinline__ void phase_scan_chunk(const Args& a, LAS unsigned char* lds, const WCtx& w, int l) {
    const int grp = w.tid >> 8, tl = w.tid & 255, gw4 = w.wave & 3, wm = gw4 >> 1, wn = gw4 & 1, lane = w.lane, r = lane & 31, hh = lane >> 5;
    const int dir = grp;
    LAS unsigned char* gb = lds + grp * SCG_BYTES;
    LAS bf16* TQ = (LAS bf16*)gb; LAS bf16* TK = TQ + 64 * TS; LAS bf16* TX = TK + 64 * TS; LAS bf16* TKD = TX + 64 * TS; LAS bf16* TVT = TKD + 64 * TS; LAS bf16* TST = TVT + 64 * TS; LAS bf16* TP = TST + 64 * TS;
    LAS float* G = (LAS float*)(gb + 7 * TILE_BYTES); LAS float* EG = G + 64; LAS float* DEC = G + 128; LAS float* BD = G + 192; LAS float* QSUM = G + 256;
    const bf16* ZB = (const bf16*)(a.ws + WS_ZB); const float* ZF = (const float*)(a.ws + WS_ZF); const bf16* PB = (const bf16*)(a.ws + WS_PB); bf16* SO = (bf16*)(a.ws + WS_SO);
    const bf16* UT = (const bf16*)(a.ws + WS_UT); const bf16* WW = (const bf16*)(a.ws + WS_WW);
    for (int pi = w.bid; pi < 64; pi += w.G) {
        const int mix = 0, b = (pi & 63) >> 2, h = pi & 3;
        f32x16 S = zero16();
        bf16* so = SO + (size_t)(mix * 2 + dir) * MT * 256 + h * 64 + 32 * wn + r;
        {
            const int d = tl & 63, iq = tl >> 6;
            unsigned short rq[16], rv[16]; float rz[16];
#define GLA_LOAD(c_) do { const int row0_ = chain_row(b, dir, (c_), 16 * iq); const long sg_ = dir ? -1 : 1; \
                const bf16* pq_ = ZB + (size_t)row0_ * NZB + h * 64 + d; const float* pz_ = ZF + (size_t)row0_ * NZF + dir * 256 + h * 64 + d; \
                _Pragma("unroll") for (int ii = 0; ii < 16; ++ii) rq[ii] = pq_[sg_ * ii * NZB]; asm volatile("" ::: "memory"); \
                _Pragma("unroll") for (int ii = 0; ii < 16; ++ii) rv[ii] = pq_[sg_ * ii * NZB + 256]; asm volatile("" ::: "memory"); \
                _Pragma("unroll") for (int ii = 0; ii < 16; ++ii) rz[ii] = pz_[sg_ * ii * NZF]; asm volatile("" ::: "memory"); } while (0)
            GLA_LOAD(0);
            for (int c = 0; c < 36; ++c) {
                float lc[16], kk[16], qq[16], vvv[16]; float run = 0.f;
#pragma unroll
                for (int ii = 0; ii < 16; ++ii) { kk[ii] = 1.0f - __expf(rz[ii]); run += rz[ii]; lc[ii] = run; qq[ii] = bf2f(rq[ii]); vvv[ii] = bf2f(rv[ii]); }
                QSUM[iq * 64 + d] = run;
                LBAR();
                const float s0 = QSUM[d], s1 = QSUM[64 + d], s2 = QSUM[128 + d], s3 = QSUM[192 + d];
                const float off = (iq > 0 ? s0 : 0.f) + (iq > 1 ? s1 : 0.f) + (iq > 2 ? s2 : 0.f), g31 = s0 + s1, g63 = g31 + s2 + s3;
                { float kd[16];
                  const float e2 = __expf(g63 - g31);
#pragma unroll
                  for (int ii = 0; ii < 16; ++ii) { const int i = 16 * iq + ii; const float gi = off + lc[ii]; const float ea = __expf(gi), eb = expc(g31 - gi);
                      TQ[i * TS + d] = bfr(qq[ii] * ea);
                      TK[i * TS + d] = bfr(kk[ii] * eb);
                      if (iq >= 2) TX[(i - 32) * TS + d] = bfr(qq[ii] * __builtin_amdgcn_rcpf(eb));
                      else TX[(32 + i) * TS + d] = bfr(kk[ii] * __builtin_amdgcn_rcpf(fmaxf(ea, 1e-35f)));
                      kd[ii] = kk[ii] * eb * e2; }
                  v4u o0, o1; o0.x = cvt_pk_bf16(kd[0], kd[1]); o0.y = cvt_pk_bf16(kd[2], kd[3]); o0.z = cvt_pk_bf16(kd[4], kd[5]); o0.w = cvt_pk_bf16(kd[6], kd[7]);
                  o1.x = cvt_pk_bf16(kd[8], kd[9]); o1.y = cvt_pk_bf16(kd[10], kd[11]); o1.z = cvt_pk_bf16(kd[12], kd[13]); o1.w = cvt_pk_bf16(kd[14], kd[15]);
                  *(LAS v4u*)(TKD + swz(d, 16 * iq)) = o0; *(LAS v4u*)(TKD + swz(d, 16 * iq + 8)) = o1;
                  o0.x = cvt_pk_bf16(vvv[0], vvv[1]); o0.y = cvt_pk_bf16(vvv[2], vvv[3]); o0.z = cvt_pk_bf16(vvv[4], vvv[5]); o0.w = cvt_pk_bf16(vvv[6], vvv[7]);
                  o1.x = cvt_pk_bf16(vvv[8], vvv[9]); o1.y = cvt_pk_bf16(vvv[10], vvv[11]); o1.z = cvt_pk_bf16(vvv[12], vvv[13]); o1.w = cvt_pk_bf16(vvv[14], vvv[15]);
                  *(LAS v4u*)(TVT + swz(d, 16 * iq)) = o0; *(LAS v4u*)(TVT + swz(d, 16 * iq + 8)) = o1;
                  if (iq == 0) DEC[d] = __expf(g63); }
                store_state_T(TST, S, wm, wn, r, hh);
                if (c + 1 < 36) GLA_LOAD(c + 1);
                LBAR();
                { f32x16 acc = zero16();
                  if (wn >= wm) { const LAS bf16* Ap = (wm == 0 && wn == 0) ? TX + 32 * TS : TK + 32 * wm * TS; const LAS bf16* Bp = (wn == 0) ? TQ : TX;
                      acc = mma64(acc, Ap, Bp, lane); }
                  const int i = 32 * wn + r;
#pragma unroll
                  for (int q = 0; q < 4; ++q) { const int j0 = 32 * wm + 8 * q + 4 * hh;
                      st4bf(TP + i * TS + j0, (j0 <= i) ? acc[4 * q] : 0.f, (j0 + 1 <= i) ? acc[4 * q + 1] : 0.f, (j0 + 2 <= i) ? acc[4 * q + 2] : 0.f, (j0 + 3 <= i) ? acc[4 * q + 3] : 0.f); } }
                LBAR();
                { bf16* sop = so + (size_t)chain_row(b, dir, c, 32 * wm + 4 * hh) * 256; const long sstep = dir ? -256 : 256;
                  f32x16 o = zero16(); o = mma64s<false, true>(o, TP, wm, TVT, wn, lane); o = mma64(o, TQ + 32 * wm * TS, TST + 32 * wn * TS, lane);
                  f32x16 ds = zero16(); ds = mma64s<true, true>(ds, TKD, wm, TVT, wn, lane);
#pragma unroll
                  for (int q = 0; q < 4; ++q) { const f32x4 dv = *(const LAS f32x4*)(DEC + 32 * wm + 8 * q + 4 * hh);
#pragma unroll
                      for (int t = 0; t < 4; ++t) { S[4 * q + t] = dv[t] * S[4 * q + t] + ds[4 * q + t]; sop[(long)(8 * q + t) * sstep] = bfr(o[4 * q + t]); } } }
                LBAR();
            }
#undef GLA_LOAD
        }
    }
    for (int pi = w.bid; pi < 192; pi += w.G) {
        if (pi < 64) continue;
        const int mix = pi >> 6, b = (pi & 63) >> 2, h = pi & 3;
        const int chain = (b * 4 + h) * 2 + dir;
        f32x16 S = zero16();
        bf16* so = SO + (size_t)(mix * 2 + dir) * MT * 256 + h * 64 + 32 * wn + r;
        {
            const int i = tl >> 2, dq = tl & 3;
            const float al = expf(mix == 1 ? a.in[I_GDN_ALOG][(l * 2 + dir) * 4 + h] : a.in[I_SSD_ALOG][(l * 2 + dir) * 4 + h]);
            const float dtb = mix == 1 ? a.in[I_GDN_DTB][(l * 2 + dir) * 4 + h] : a.in[I_SSD_DTB][(l * 2 + dir) * 4 + h];
            v4u rq0s[2], rq1s[2], rk0s[2], rk1s[2], ra0s[2], ra1s[2], rb0s[2], rb1s[2]; float rs0s[2] = {0.f, 0.f}, rs1s[2] = {0.f, 0.f};
#pragma unroll
            for (int u = 0; u < 2; ++u) { rq0s[u] = rq1s[u] = rk0s[u] = rk1s[u] = ra0s[u] = ra1s[u] = rb0s[u] = rb1s[u] = (v4u){0u, 0u, 0u, 0u}; }
#define SD_LOAD(c_, u_) do { const int row_ = chain_row(b, dir, (c_), i); \
                if (mix == 1) { const v4u* pq_ = (const v4u*)(PB + (size_t)row_ * NPB + h * 64 + 16 * dq); const v4u* pk_ = (const v4u*)(PB + (size_t)row_ * NPB + 256 + h * 64 + 16 * dq); rq0s[u_] = pq_[0]; rq1s[u_] = pq_[1]; rk0s[u_] = pk_[0]; rk1s[u_] = pk_[1]; \
                    const v4u* pw_ = (const v4u*)(WW + (size_t)(chain * 36 + (c_)) * 4096 + i * 64 + 16 * dq); const v4u* pu_ = (const v4u*)(UT + (size_t)(chain * 36 + (c_)) * 4096 + i * 64 + 16 * dq); ra0s[u_] = pw_[0]; ra1s[u_] = pw_[1]; rb0s[u_] = pu_[0]; rb1s[u_] = pu_[1]; } \
                else { const v4u* pq_ = (const v4u*)(PB + (size_t)row_ * NPB + 768 + 384 + (h >> 1) * 64 + 16 * dq); const v4u* pk_ = (const v4u*)(PB + (size_t)row_ * NPB + 768 + 256 + (h >> 1) * 64 + 16 * dq); rq0s[u_] = pq_[0]; rq1s[u_] = pq_[1]; rk0s[u_] = pk_[0]; rk1s[u_] = pk_[1]; \
                    const v4u* pv_ = (const v4u*)(PB + (size_t)row_ * NPB + 768 + h * 64 + 16 * dq); ra0s[u_] = pv_[0]; ra1s[u_] = pv_[1]; } \
                if (gw4 == 0) { const int rj_ = chain_row(b, dir, (c_), lane); if (mix == 1) { rs0s[u_] = ZF[(size_t)rj_ * NZF + 512 + dir * 4 + h]; rs1s[u_] = ZF[(size_t)rj_ * NZF + 520 + dir * 4 + h]; } else rs0s[u_] = ZF[(size_t)rj_ * NZF + 528 + dir * 4 + h]; } } while (0)
            SD_LOAD(0, 0); SD_LOAD(1, 1);
            for (int c2 = 0; c2 < 36; c2 += 2) {
#pragma unroll
            for (int u = 0; u < 2; ++u) { const int c = c2 + u;
                if (gw4 == 0) { const float sp = softplus_acc(rs0s[u] + dtb); float g = -al * sp;
#pragma unroll
                    for (int o = 1; o < 64; o <<= 1) { const float y = __shfl_up(g, o); if (lane >= o) g += y; }
                    G[lane] = g; EG[lane] = __expf(g); BD[lane] = (mix == 1) ? sigmoid_acc(rs1s[u]) : sp; }
                LBAR();
                { const float gi = G[i], g63 = G[63]; const float kdsc = __expf(g63 - gi), vsc = (mix == 2) ? BD[i] : 1.0f;
                  const int colsw = ((((i >> 3) ^ dq) << 3) | (i & 7)); LAS bf16* kdb = TKD + 16 * dq * TS + colsw; LAS bf16* vtb = TVT + 16 * dq * TS + colsw;
                  *(LAS v4u*)(TQ + i * TS + 16 * dq) = rq0s[u]; *(LAS v4u*)(TQ + i * TS + 16 * dq + 8) = rq1s[u];
                  *(LAS v4u*)(TK + i * TS + 16 * dq) = rk0s[u]; *(LAS v4u*)(TK + i * TS + 16 * dq + 8) = rk1s[u];
                  float kf[8];
                  unpack8(rk0s[u], kf);
#pragma unroll
                  for (int t = 0; t < 8; ++t) kdb[t * TS] = bfr(kf[t] * kdsc);
                  unpack8(rk1s[u], kf);
#pragma unroll
                  for (int t = 0; t < 8; ++t) kdb[(8 + t) * TS] = bfr(kf[t] * kdsc);
                  if (mix == 2) { unpack8(ra0s[u], kf);
#pragma unroll
                      for (int t = 0; t < 8; ++t) vtb[t * TS] = bfr(kf[t] * vsc);
                      unpack8(ra1s[u], kf);
#pragma unroll
                      for (int t = 0; t < 8; ++t) vtb[(8 + t) * TS] = bfr(kf[t] * vsc); }
                  else { *(LAS v4u*)(TX + i * TS + 16 * dq) = ra0s[u]; *(LAS v4u*)(TX + i * TS + 16 * dq + 8) = ra1s[u];
                         *(LAS v4u*)(TVT + swz(i, 16 * dq)) = rb0s[u]; *(LAS v4u*)(TVT + swz(i, 16 * dq + 8)) = rb1s[u]; } }
                store_state_T(TST, S, wm, wn, r, hh);
                if (c + 2 < 36) SD_LOAD(c + 2, u);
                LBAR();
                { f32x16 acc = zero16();
                  if (wn >= wm) acc = mma64(acc, TK + 32 * wm * TS, TQ + 32 * wn * TS, lane);
                  const int ii = 32 * wn + r; const float gi = G[ii];
#pragma unroll
                  for (int q = 0; q < 4; ++q) { const int j0 = 32 * wm + 8 * q + 4 * hh; const f32x4 gj = *(const LAS f32x4*)(G + j0); float pv[4];
#pragma unroll
                      for (int t = 0; t < 4; ++t) pv[t] = (j0 + t <= ii) ? acc[4 * q + t] * __expf(gi - gj[t]) : 0.f;
                      st4bf(TP + ii * TS + j0, pv[0], pv[1], pv[2], pv[3]); }
                  if (mix == 1) { f32x16 ws_ = zero16(); ws_ = mma64(ws_, TX + 32 * wm * TS, TST + 32 * wn * TS, lane);
#pragma unroll
                      for (int q = 0; q < 4; ++q) { LAS bf16* up = TVT + swz(32 * wn + r, 32 * wm + 8 * q + 4 * hh); const v2u uu = *(const LAS v2u*)up;
                          st4bf(up, bf2f(uu.x & 0xffffu) - ws_[4 * q], bf2f(uu.x >> 16) - ws_[4 * q + 1], bf2f(uu.y & 0xffffu) - ws_[4 * q + 2], bf2f(uu.y >> 16) - ws_[4 * q + 3]); } } }
                LBAR();
                { bf16* sop = so + (size_t)chain_row(b, dir, c, 32 * wm + 4 * hh) * 256; const long sstep = dir ? -256 : 256;
                  f32x16 o = zero16(); o = mma64s<false, true>(o, TP, wm, TVT, wn, lane);
                  f32x16 qs = zero16(); qs = mma64(qs, TQ + 32 * wm * TS, TST + 32 * wn * TS, lane);
                  f32x16 ds = zero16(); ds = mma64s<true, true>(ds, TKD, wm, TVT, wn, lane);
                  const float dsc = EG[63];
#pragma unroll
                  for (int q = 0; q < 4; ++q) { const f32x4 eg = *(const LAS f32x4*)(EG + 32 * wm + 8 * q + 4 * hh);
#pragma unroll
                      for (int t = 0; t < 4; ++t) { S[4 * q + t] = dsc * S[4 * q + t] + ds[4 * q + t]; sop[(long)(8 * q + t) * sstep] = bfr(o[4 * q + t] + eg[t] * qs[4 * q + t]); } } }
                LBAR();
            } }
#undef SD_LOAD
        }
    }
}

constexpr size_t WS_TW = WS_LB + 65536;
__device__ __forceinline__ int fpad(int i) { return i + ((i >> 7) << 3); }
__device__ __forceinline__ void cst16(int k, float& c, float& s) {
    constexpr float C[8] = {1.0f, 0.92387953251128674f, 0.70710678118654752f, 0.38268343236508977f, 0.0f, -0.38268343236508977f, -0.70710678118654752f, -0.92387953251128674f};
    constexpr float S[8] = {0.0f, -0.38268343236508977f, -0.70710678118654752f, -0.92387953251128674f, -1.0f, -0.92387953251128674f, -0.70710678118654752f, -0.38268343236508977f};
    c = C[k]; s = S[k]; }
template <int LOGN, int S0, int R, int NCOL>
__device__ __forceinline__ void fft_pass(LAS float* XR, LAS float* XI, const float* TW, int tid) {
    constexpr int N = 1 << LOGN, G = 1 << R, STR = N >> (S0 + R), NGC = N / G, CS = N + 8 * (N / 128);
    for (int gi = tid; gi < NCOL * NGC; gi += NTHREADS) {
        const int col = gi / NGC, g = gi - col * NGC, lo = g & (STR - 1), hi = g / STR;
        const int i0 = hi * (STR * G) + lo;
        LAS float* xr = XR + col * CS; LAS float* xi = XI + col * CS;
        float er[G], ei[G];
        if constexpr (STR == 1) {
#pragma unroll
            for (int m = 0; m < G; m += 4) { const f32x4 a = *(const LAS f32x4*)(xr + fpad(i0) + m), b = *(const LAS f32x4*)(xi + fpad(i0) + m);
#pragma unroll
                for (int t = 0; t < 4; ++t) { er[m + t] = a[t]; ei[m + t] = b[t]; } }
        } else {
#pragma unroll
            for (int m = 0; m < G; ++m) { er[m] = xr[fpad(i0 + STR * m)]; ei[m] = xi[fpad(i0 + STR * m)]; }
        }
#pragma unroll
        for (int t = 0; t < R; ++t) {
            constexpr int dummy = 0; (void)dummy;
            const int hs = G >> (t + 1), s = S0 + t;
            float wlr = 1.0f, wli = 0.0f;
            if constexpr (STR > 1) { const int ti = (lo << s) * (2048 / N); wlr = TW[2 * ti]; wli = TW[2 * ti + 1]; }
#pragma unroll
            for (int blk = 0; blk < G; blk += 2 * hs)
#pragma unroll
                for (int q = 0; q < hs; ++q) {
                    const float ar = er[blk + q], ai = ei[blk + q], br = er[blk + q + hs], bi = ei[blk + q + hs];
                    const float dr = ar - br, di = ai - bi;
                    er[blk + q] = ar + br; ei[blk + q] = ai + bi;
                    float cr, ci; cst16((q << t) * (16 / G), cr, ci);
                    float tr, tim;
                    if (q == 0) { tr = wlr; tim = wli; } else if constexpr (STR == 1) { tr = cr; tim = ci; } else { tr = wlr * cr - wli * ci; tim = wlr * ci + wli * cr; }
                    er[blk + q + hs] = dr * tr - di * tim; ei[blk + q + hs] = dr * tim + di * tr;
                }
        }
        if constexpr (STR == 1) {
#pragma unroll
            for (int m = 0; m < G; m += 4) { *(LAS f32x4*)(xr + fpad(i0) + m) = (f32x4){er[m], er[m + 1], er[m + 2], er[m + 3]}; *(LAS f32x4*)(xi + fpad(i0) + m) = (f32x4){ei[m], ei[m + 1], ei[m + 2], ei[m + 3]}; }
        } else {
#pragma unroll
            for (int m = 0; m < G; ++m) { xr[fpad(i0 + STR * m)] = er[m]; xi[fpad(i0 + STR * m)] = ei[m]; }
        }
    }
}
template <int LOGN, int NCOL>
__device__ __forceinline__ void fft_items(const Args& a, LAS unsigned char* lds, const WCtx& w, const bf16* VT, float* FO, int rowbase0, float scale) {
    constexpr int N = 1 << LOGN, CS = N + 8 * (N / 128), NCG = 256 / NCOL, TPC = NTHREADS / NCOL;
    LAS float* XR = (LAS float*)lds; LAS float* XI = XR + NCOL * CS; const float* TW = (const float*)(a.ws + WS_TW);
    const int c = w.tid / TPC, j = w.tid - c * TPC;
    for (int it = w.bid; it < 16 * NCG; it += w.G) {
        const int b = it / NCG, cg = it - b * NCG, ch = cg * NCOL + c;
        const bf16* src = VT + (size_t)(b * 256 + ch) * (2 * N);
        for (int m = j; m < N / 8; m += TPC) {
            const v4u vr = *(const v4u*)(src + 8 * m), vi = *(const v4u*)(src + N + 8 * m); float f[8];
            unpack8(vr, f); *(LAS f32x4*)(XR + c * CS + fpad(8 * m)) = (f32x4){f[0], f[1], f[2], f[3]}; *(LAS f32x4*)(XR + c * CS + fpad(8 * m) + 4) = (f32x4){f[4], f[5], f[6], f[7]};
            unpack8(vi, f); *(LAS f32x4*)(XI + c * CS + fpad(8 * m)) = (f32x4){f[0], f[1], f[2], f[3]}; *(LAS f32x4*)(XI + c * CS + fpad(8 * m) + 4) = (f32x4){f[4], f[5], f[6], f[7]}; }
        __syncthreads();
        if constexpr (LOGN == 11) { fft_pass<11, 0, 4, NCOL>(XR, XI, TW, w.tid); __syncthreads(); fft_pass<11, 4, 4, NCOL>(XR, XI, TW, w.tid); __syncthreads(); fft_pass<11, 8, 3, NCOL>(XR, XI, TW, w.tid); }
        else { fft_pass<8, 0, 4, NCOL>(XR, XI, TW, w.tid); __syncthreads(); fft_pass<8, 4, 4, NCOL>(XR, XI, TW, w.tid); }
        __syncthreads();
        { const int oc = w.tid % NCOL, k0 = w.tid / NCOL; float* dst = FO + (size_t)(rowbase0 + b * N) * 256 + cg * NCOL + oc;
          for (int kt = k0; kt < N; kt += TPC) { const int br_ = (int)(__brev((unsigned)kt) >> (32 - LOGN)); dst[(size_t)kt * 256] = XR[oc * CS + fpad(br_)] * scale; } }
        __syncthreads();
    }
}
__device__ __forceinline__ void phase_fourier_time(const Args& a, LAS unsigned char* lds, const WCtx& w) {
    fft_items<11, 8>(a, lds, w, (const bf16*)(a.ws + WS_VTL), (float*)(a.ws + WS_FO), 0, 0.0027621358640099515f);
    fft_items<8, 32>(a, lds, w, (const bf16*)(a.ws + WS_VTC), (float*)(a.ws + WS_FO), ML, 0.0078125f);
}
constexpr int PPL = 13;
constexpr int N_PHASES = 2 + PPL * DEPTH;
#ifndef PHMASK
#define PHMASK 0xFFFFu
#endif
#define EN(k) (((PHMASK) >> (k)) & 1u)
__global__ void __launch_bounds__(NTHREADS, 2) fwd_kernel(Args args) {
    extern __shared__ __attribute__((aligned(16))) unsigned char lds_raw[];
    LAS unsigned char* lds = (LAS unsigned char*)lds_raw;
#define MKW() WCtx w; { int t_ = threadIdx.x; asm volatile("" : "+v"(t_)); w.tid = t_; w.lane = t_ & 63; w.wave = __builtin_amdgcn_readfirstlane(t_ >> 6); { int b_ = blockIdx.x; asm volatile("" : "+s"(b_)); w.bid = b_; } { int g_ = gridDim.x; asm volatile("" : "+s"(g_)); w.G = g_; } w.gw = w.bid * NWAVES + w.wave; w.NGW = w.G * NWAVES; } \
              unsigned char* ws = args.ws; asm volatile("" : "+s"(ws)); const int c = w.bid; (void)c; (void)ws
    for (int u = threadIdx.x; u < (LDS_BYTES - LDSCTL_OFF) / 4; u += NTHREADS) ((LAS unsigned*)(lds + LDSCTL_OFF))[u] = 0u;
    __syncthreads();
    XcdBarrier bar = xcd_barrier_post((unsigned*)(args.ws + WS_CTL) + CW_BAR + args.li * XCD_BAR_WORDS, (volatile LAS unsigned*)(lds + MISC_OFF) + 8);
    const int lo = args.ph_lo, hi = args.ph_hi;
#define INP(k) (lo <= (k) && (k) < hi)
#define SEAM(k) do { if (INP(k) && INP((k) + 1)) xcd_barrier(bar); } while (0)
#ifdef PROBE_MASK
    unsigned long long pr_prev = __builtin_amdgcn_s_memrealtime(), pr_acc = 0ull;
#define STAMP(slot) do { const unsigned long long n_ = __builtin_amdgcn_s_memrealtime(); if (((PROBE_MASK) >> (slot)) & 1u) pr_acc += n_ - pr_prev; pr_prev = n_; } while (0)
#else
#define STAMP(slot) do { } while (0)
#endif
    if (EN(12) && INP(0)) { MKW(); phase_prologue(args, lds, w); }
    SEAM(0); STAMP(12);
    if (EN(13) && INP(1)) { MKW(); phase_mod_rows(args, w, 0); }
    SEAM(1); STAMP(13);
    for (int l = 0; l < DEPTH; ++l) {
        const int pb = 2 + PPL * l;
        const bool lastl = (l == DEPTH - 1);
        const int nrows = lastl ? ML : MT, nMr = nrows / 256;
        if (EN(0) && INP(pb + 0)) { MKW();
            { pg8::Order<MapPlain> S; S.init(MT / 256, 11, w.G, c); S.map = MapPlain{(const char*)(ws + WS_H), (const char*)(ws + WS_WIN), (size_t)256 * 1024 * 2, (size_t)256 * 1024 * 2};
              EpiZB E{(bf16*)(ws + WS_ZB)};
              pg8::gemm_phase<EpiZB, pg8::Order<MapPlain>>(lds, pg8::Gemm{1024, 1024, 1024}, S, E); }
            { pg8::Order<MapPlain> S; S.init(MT / 256, 3, w.G, w.G - 1 - c); S.map = MapPlain{(const char*)(ws + WS_H), (const char*)(ws + WS_WIN) + (size_t)11 * 256 * 1024 * 2, (size_t)256 * 1024 * 2, (size_t)256 * 1024 * 2};
              EpiZF E{(float*)(ws + WS_ZF), (const float*)(ws + WS_LB) + l * 256};
              pg8::gemm_phase<EpiZF, pg8::Order<MapPlain>>(lds, pg8::Gemm{1024, 1024, 1024}, S, E); }
        }
        SEAM(pb + 0); STAMP(0);
        if (EN(1) && INP(pb + 1)) { MKW();
            pg8::Order<MapPlain> S; S.init(2, MT / 256, w.G, c); S.map = MapPlain{(const char*)(ws + WS_DFT64), (const char*)(ws + WS_ZB) + 1792 * 2, (size_t)256 * 256 * 2, (size_t)256 * NZB * 2};
            EpiFour1 E{(bf16*)(ws + WS_VTL), (bf16*)(ws + WS_VTC)};
            pg8::gemm_phase<EpiFour1, pg8::Order<MapPlain>>(lds, pg8::Gemm{256, 256, NZB}, S, E);
            if (EN(15)) phase_prep(args, w, l);
        }
        SEAM(pb + 1); STAMP(1);
        if (EN(2) && INP(pb + 2)) { MKW();
            phase_fourier_time(args, lds, w);
            __syncthreads();
            if (EN(14)) phase_gdn_solve(args, lds, w, l);
            __syncthreads(); convert_rest(args, lds, w.wave, w.lane, w.gw, w.NGW, l, WI_XA, WI_XB);
        }
        SEAM(pb + 2); STAMP(2);
        if (EN(14) && INP(pb + 3)) { MKW();
            if (w.G > 192) { if (w.bid >= 192) convert_rest(args, lds, w.wave, w.lane, (w.bid - 192) * NWAVES + w.wave, (w.G - 192) * NWAVES, l, 0, WI_XA); else phase_scan_chunk(args, lds, w, l); }
            else { phase_scan_chunk(args, lds, w, l); __syncthreads(); convert_rest(args, lds, w.wave, w.lane, w.gw, w.NGW, l, 0, WI_XA); } }
        SEAM(pb + 3); STAMP(14);
        if (EN(3) && INP(pb + 4)) { MKW(); phase_finish(args, w, l, nrows); }
        SEAM(pb + 4); STAMP(3);
        if (EN(4) && INP(pb + 5)) { MKW();
            pg8::Order<MapP> S; S.init(nMr, 16, w.G, c); S.map = MapP{(const char*)(ws + WS_OUTS), (const char*)(ws + WS_WBR)};
            EpiP E{(bf16*)(ws + WS_P)};
            pg8::gemm_phase<EpiP, pg8::Order<MapP>>(lds, pg8::Gemm{256, 1024, 256}, S, E);
        }
        SEAM(pb + 5); STAMP(4);
        if (EN(5) && INP(pb + 6)) { MKW();
            pg8::Order<MapPlain> S; S.init(nMr, 16, w.G, c); S.map = MapPlain{(const char*)(ws + WS_H8), (const char*)(ws + WS_WG), (size_t)256 * 1024, (size_t)256 * 1024};
            EpiMerge E{(const bf16*)(ws + WS_P), (bf16*)(ws + WS_T), args.in[I_BGATE] + (size_t)l * 4096};
            pg8::gemm_phase<EpiMerge, pg8::Order<MapPlain>, true, true, false, 1>(lds, pg8::Gemm{1024, 1024, 1024, 0x79797979, 0x7F7F7F7F}, S, E);
        }
        SEAM(pb + 6); STAMP(5);
        if (EN(6) && INP(pb + 7)) { MKW();
            pg8::Order<MapPlain> S; S.init(nMr, 4, w.G, c); S.map = MapPlain{(const char*)(ws + WS_T), (const char*)(ws + WS_WOUT), (size_t)256 * 1024 * 2, (size_t)256 * 1024 * 2};
            EpiBf E{(bf16*)(ws + WS_Y), 1024, nullptr};
            pg8::gemm_phase<EpiBf, pg8::Order<MapPlain>>(lds, pg8::Gemm{1024, 1024, 1024}, S, E);
        }
        SEAM(pb + 7); STAMP(6);
        if (EN(7) && INP(pb + 8)) { MKW(); phase_ln1(args, lds, w, l, nrows); }
        SEAM(pb + 8); STAMP(7);
        if (EN(8) && INP(pb + 9)) { MKW(); phase_topk(args, lds, w, lastl ? 256 : 512); __syncthreads(); convert_rest(args, lds, w.wave, w.lane, w.gw, w.NGW, l, WI_XB, WI_REST); }
        SEAM(pb + 9); STAMP(8);
        const int nMe = lastl ? 256 : 288;
        if (EN(9) && INP(pb + 10)) { MKW();
            pg8::Order<MapMoEG> S; S.init(nMe, 8, w.G, c); S.map = MapMoEG{(const char*)(ws + WS_H), (const char*)(ws + WS_WGU), (size_t)2048 * 1024, (size_t)256 * 1024};
            EpiSwiGLU E{(unsigned char*)(ws + WS_HID)};
            pg8::gemm_phase<EpiSwiGLU, pg8::Order<MapMoEG>, true, true, true, 1>(lds, pg8::Gemm{1024, 1024, 1024, 0x79797979, 0x7F7F7F7F}, S, E, (const int*)(ws + WS_ROWW + 512 * 1024));
        }
        SEAM(pb + 10); STAMP(9);
        if (EN(10) && INP(pb + 11)) { MKW();
            pg8::Order<MapMoE> S; S.init(nMe, 4, w.G, c); S.map = MapMoE{(const char*)(ws + WS_HID), (const char*)(ws + WS_WDN), (size_t)1024 * 1024, (size_t)256 * 1024};
            EpiF8 E{(unsigned char*)(ws + WS_YE), (const float*)(ws + WS_ROWW)};
            pg8::gemm_phase<EpiF8, pg8::Order<MapMoE>, true, true, false, 1>(lds, pg8::Gemm{1024, 1024, 1024, 0x79797979, 0x7F7F7F7F}, S, E);
        }
        SEAM(pb + 11); STAMP(10);
        if (EN(11) && INP(pb + 12)) { MKW(); phase_ln2(args, lds, w, l, nrows); if (!lastl) { __syncthreads(); convert_win(args, lds, w.wave, w.lane, w.gw, w.NGW, l + 1); } }
        SEAM(pb + 12); STAMP(11);
    }
#ifdef PROBE_MASK
    if (blockIdx.x == 0 && threadIdx.x == 0) { const unsigned long long t0_ = __builtin_amdgcn_s_memrealtime(); while (__builtin_amdgcn_s_memrealtime() - t0_ < 4ull * pr_acc) __builtin_amdgcn_s_sleep(8); }
#endif
#undef INP
#undef SEAM
}

#ifndef MK_SPLIT
#define MK_SPLIT 0
#endif
extern "C" void kernel_launch(void* const* d_in, const int* in_sizes, int n_in, void* d_out, int out_size, void* d_ws, size_t ws_size, hipStream_t stream) {
    static int grid = 0;
    if (grid == 0) {
        if (n_in != 31 || out_size != ML * D || ws_size < WS_END) { fprintf(stderr, "kernel_launch: unexpected problem (n_in %d, out %d, ws %zu, need %zu)\n", n_in, out_size, ws_size, (size_t)WS_END); grid = -1; return; }
        int dev = 0, cus = 0, per_cu = 0;
        if (hipGetDevice(&dev) != hipSuccess || hipDeviceGetAttribute(&cus, hipDeviceAttributeMultiprocessorCount, dev) != hipSuccess) { grid = -1; return; }
        if (hipFuncSetAttribute((const void*)fwd_kernel, hipFuncAttributeMaxDynamicSharedMemorySize, LDS_BYTES) != hipSuccess) { fprintf(stderr, "kernel_launch: hipFuncSetAttribute failed\n"); grid = -1; return; }
        if (hipOccupancyMaxActiveBlocksPerMultiprocessor(&per_cu, (const void*)fwd_kernel, NTHREADS, LDS_BYTES) != hipSuccess || per_cu < 1) fprintf(stderr, "kernel_launch: occupancy query says %d\n", per_cu);
        (void)hipGetLastError();
        grid = cus;
    }
    if (grid < 0) return;
    if (hipMemsetAsync((char*)d_ws + WS_CTL, 0, CTL_ZERO_BYTES, stream) != hipSuccess) return;
    Args a{};
    for (int i = 0; i < 31; ++i) a.in[i] = (const float*)d_in[i];
    a.out = (float*)d_out; a.ws = (unsigned char*)d_ws;
#if MK_SPLIT
    for (int p = 0; p < N_PHASES; ++p) { a.ph_lo = p; a.ph_hi = p + 1; a.li = p; a.pad = 0; hipLaunchKernelGGL(fwd_kernel, dim3(grid), dim3(NTHREADS), LDS_BYTES, stream, a); }
#else
    a.ph_lo = 0; a.ph_hi = N_PHASES; a.li = 0; a.pad = 0;
    hipLaunchKernelGGL(fwd_kernel, dim3(grid), dim3(NTHREADS), LDS_BYTES, stream, a);
#endif
    const hipError_t le = hipPeekAtLastError();
    if (le != hipSuccess) fprintf(stderr, "kernel_launch: launch failed: %s\n", hipGetErrorName(le));
}
```

```cpp
#include <hip/hip_runtime.h>
#include <cstdio>
#include <cstdint>

#define LAS __attribute__((address_space(3)))
typedef unsigned short bf16;
typedef short bf16x8 __attribute__((ext_vector_type(8)));
typedef float f32x4 __attribute__((ext_vector_type(4)));
typedef float f32x2 __attribute__((ext_vector_type(2)));
typedef unsigned v4u __attribute__((ext_vector_type(4)));
typedef unsigned v2u __attribute__((ext_vector_type(2)));

constexpr int D = 1024, BATCH = 16, SEQ = 2048, CTXL = 256, DEPTH = 4, BW = 256, NH = 4, HD = 64, NE = 16, FF = 1024;
constexpr int ML = BATCH * SEQ, MC = BATCH * CTXL, MT = ML + MC;
constexpr int IN_COLS = 3352;
constexpr int NZB = 2816, NZF = 768;
constexpr int NPB = 1280;
constexpr float LN_EPS = 1e-6f;
constexpr float ALPHA = 1.681792830507429f;
constexpr int CAP_L = 256, CAP_C = 32;
constexpr int NWAVES = 8, NTHREADS = 512;

constexpr size_t MiB = 1u << 20;
constexpr size_t WS_CTL = 0, CTL_ZERO_BYTES = 1 * MiB;
constexpr size_t WS_MOD = 1 * MiB;
constexpr size_t WS_LB = 3 * MiB;
constexpr size_t WS_DFT64 = 4 * MiB;
constexpr size_t WS_DFTC = 5 * MiB;
constexpr size_t WS_DFTL = 6 * MiB;
constexpr size_t WS_AFF = 22 * MiB;
constexpr size_t WS_SLOT = 25 * MiB;
constexpr size_t WS_ROWW = 28 * MiB;
constexpr size_t WS_WIN = 32 * MiB;
constexpr size_t WS_WG = 39 * MiB;
constexpr size_t WS_WBR = 47 * MiB;
constexpr size_t WS_WOUT = 49 * MiB;
constexpr size_t WS_WGU = 51 * MiB;
constexpr size_t WS_WDN = 115 * MiB;
constexpr size_t WS_X = 147 * MiB;
constexpr size_t WS_H = 291 * MiB;
constexpr size_t WS_R1 = 364 * MiB;
constexpr size_t WS_ZB = WS_R1;
constexpr size_t WS_ZF = WS_R1 + 198 * MiB;
constexpr size_t WS_PB = WS_R1 + 306 * MiB;
constexpr size_t WS_SO = WS_R1 + 396 * MiB;
constexpr size_t WS_VTL = WS_R1 + 504 * MiB;
constexpr size_t WS_VTC = WS_R1 + 536 * MiB;
constexpr size_t WS_FO = WS_R1 + 540 * MiB;
constexpr size_t WS_OUTS = WS_R1 + 612 * MiB;
constexpr size_t WS_P = WS_R1;
constexpr size_t WS_T = WS_R1 + 288 * MiB;
constexpr size_t WS_Y = WS_R1 + 360 * MiB;
constexpr size_t WS_XE = WS_R1;
constexpr size_t WS_HID = WS_R1 + 144 * MiB;
constexpr size_t WS_YE = WS_R1 + 288 * MiB;
constexpr size_t WS_H8 = WS_R1 + 756 * MiB;
constexpr size_t WS_END = WS_R1 + 792 * MiB;
constexpr int CW_BAR = 4096;

constexpr int RING_BYTES = 131072;
constexpr int LDSCTL_OFF = 145408, MISC_OFF = LDSCTL_OFF + 320;
constexpr int LDS_BYTES = 147456;

__device__ __forceinline__ float bf2f(unsigned b) { return __uint_as_float(b << 16); }
__device__ __forceinline__ unsigned f2bf(float f) { unsigned u = __float_as_uint(f); return (u + 0x7fffu + ((u >> 16) & 1u)) >> 16; }
__device__ __forceinline__ unsigned pk2(float lo, float hi) { return f2bf(lo) | (f2bf(hi) << 16); }
__device__ __forceinline__ unsigned cvt_pk_bf16(float lo, float hi) { unsigned r; asm volatile("v_cvt_pk_bf16_f32 %0, %1, %2" : "=v"(r) : "v"(lo), "v"(hi)); return r; }
__device__ __forceinline__ float dpp_x1(float x) { return __int_as_float(__builtin_amdgcn_mov_dpp(__float_as_int(x), 0xB1, 0xf, 0xf, true)); }
__device__ __forceinline__ float dpp_x2(float x) { return __int_as_float(__builtin_amdgcn_mov_dpp(__float_as_int(x), 0x4E, 0xf, 0xf, true)); }
__device__ __forceinline__ float dpp_x3(float x) { return __int_as_float(__builtin_amdgcn_mov_dpp(__float_as_int(x), 0x1B, 0xf, 0xf, true)); }
__device__ __forceinline__ float dpp_x7(float x) { return __int_as_float(__builtin_amdgcn_mov_dpp(__float_as_int(x), 0x141, 0xf, 0xf, true)); }
__device__ __forceinline__ float dpp_x15(float x) { return __int_as_float(__builtin_amdgcn_mov_dpp(__float_as_int(x), 0x140, 0xf, 0xf, true)); }
__device__ __forceinline__ float dpp_x4(float x) { return dpp_x3(dpp_x7(x)); }
__device__ __forceinline__ float dpp_x8(float x) { return __int_as_float(__builtin_amdgcn_mov_dpp(__float_as_int(x), 0x128, 0xf, 0xf, true)); }
__device__ __forceinline__ float swap16_add(float a, float b) { const auto r = __builtin_amdgcn_permlane16_swap(__float_as_uint(a), __float_as_uint(b), false, false); return __uint_as_float(r[0]) + __uint_as_float(r[1]); }
__device__ __forceinline__ float swap32_add(float a, float b) { const auto r = __builtin_amdgcn_permlane32_swap(__float_as_uint(a), __float_as_uint(b), false, false); return __uint_as_float(r[0]) + __uint_as_float(r[1]); }
__device__ __forceinline__ float swap16_max(float a) { const auto r = __builtin_amdgcn_permlane16_swap(__float_as_uint(a), __float_as_uint(a), false, false); return fmaxf(__uint_as_float(r[0]), __uint_as_float(r[1])); }
__device__ __forceinline__ float swap32_max(float a) { const auto r = __builtin_amdgcn_permlane32_swap(__float_as_uint(a), __float_as_uint(a), false, false); return fmaxf(__uint_as_float(r[0]), __uint_as_float(r[1])); }
__device__ __forceinline__ float wave_sum(float v) {
    v += dpp_x1(v); v += dpp_x2(v); v += dpp_x7(v); v += dpp_x15(v);
    v = swap16_add(v, v); v = swap32_add(v, v);
    return v;
}
__device__ __forceinline__ float sigmoid_fast(float x) { return __builtin_amdgcn_rcpf(1.0f + __expf(-x)); }
__device__ __forceinline__ float sigmoid_acc(float x) { return 1.0f / (1.0f + expf(-x)); }
__device__ __forceinline__ float silu_acc(float x) { return x / (1.0f + expf(-x)); }
__device__ __forceinline__ float softplus_acc(float x) { return x > 20.f ? x : log1pf(expf(x)); }
#define LDS_WAIT() asm volatile("s_waitcnt lgkmcnt(0)" ::: "memory")
#define VM_WAIT() asm volatile("s_waitcnt vmcnt(0)" ::: "memory")

namespace pg8 {
constexpr int BM = 256, BK = 64, HALF = 128, HTB = HALF * BK * 2, STAGE_BYTES = 8 * HTB, NXCD = 8, WGM = 8;
__host__ __device__ __forceinline__ int lds_byte(int r, int c) { const int st = (r >> 4) * 2 + (c >> 5), rr = r & 15, cc = c & 31, ob = rr * 64 + cc * 2; return st * 1024 + (ob ^ (((ob >> 9) & 1) << 5)); }
__host__ __device__ __forceinline__ void stage_rc(int b, int& R, int& C) { const int st = b / 1024, sb = b % 1024, swz = sb ^ (((sb >> 9) & 1) << 5); R = (st >> 1) * 16 + swz / 64; C = (st & 1) * 32 + (swz % 64) / 2; }
__host__ __device__ __forceinline__ int perm32(int rho) { const int n = rho >> 4, i = rho & 15; return 8 * (i >> 2) + 4 * n + (i & 3); }

struct Unit { int pm, pn; const char* A; const char* B; };
struct Gemm { int K, lda, ldb; int sw = 0x7F7F7F7F, sx = 0x7F7F7F7F; };
typedef int v8i __attribute__((ext_vector_type(8)));
typedef int v4i __attribute__((ext_vector_type(4)));

template <class Map> struct Order {
    int nM, nN, nwg, G, c; Map map;
    __device__ __forceinline__ void init(int nM_, int nN_, int G_, int c_) { nM = nM_; nN = nN_; nwg = nM * nN; G = G_; c = c_; }
    __device__ __forceinline__ bool next(int i, Unit& u) const {
        const long L = (long)i * G + c; if (L >= nwg) return false;
        int wgid = (int)L; { const int q = nwg / NXCD, r = nwg % NXCD, xcd = wgid % NXCD, off = wgid / NXCD; wgid = (xcd < r ? xcd * (q + 1) : r * (q + 1) + (xcd - r) * q) + off; }
        const int nig = WGM * nN, gid = wgid / nig, fm = gid * WGM, gsz = (nM - fm) < WGM ? (nM - fm) : WGM;
        u.pm = fm + ((wgid % nig) % gsz); u.pn = (wgid % nig) / gsz; map(u); return true;
    }
    __device__ __forceinline__ void a_ready(const Unit&) const {}
    __device__ __forceinline__ void done(const Unit&) const {}
};

template <class Epi, class Sched, bool ALIGN_EPI = true, bool SP2 = true, bool GATHER = false, int ESZ = 2>
__device__ __forceinline__ void gemm_phase(LAS unsigned char* lds, const Gemm g, const Sched& S, const Epi& E, const int* selrow = nullptr) {
    int tid_ = threadIdx.x; asm volatile("" : "+v"(tid_));
    const int tid = tid_, wid = __builtin_amdgcn_readfirstlane(tid >> 6), lane = tid & 63, wr = wid >> 2, wc = wid & 3, fr = lane & 15, fq = lane >> 4;
    constexpr bool FP8 = (ESZ == 1);
    const int K = g.K, nt = K * ESZ / (BK * 2);
    unsigned voffA[2], voffB[2]; int gR[2]; unsigned gC2[2];
#pragma unroll
    for (int i = 0; i < 2; ++i) { int R, C; stage_rc(tid * 16 + i * 8192, R, C); const int Rb = Epi::PERM ? ((R & ~31) + perm32(R & 31)) : R;
        voffA[i] = (unsigned)(R * g.lda * ESZ + C * 2); voffB[i] = (unsigned)(Rb * g.ldb * ESZ + C * 2); gR[i] = R; gC2[i] = (unsigned)C * 2u; }
    unsigned gc0[2] = {voffA[0], voffA[1]}, gc1[2] = {voffA[0], voffA[1]};
    int gn0r[2] = {0, 0}, gn1r[2] = {0, 0};
    const size_t kstep = (size_t)(BK * 2);
    const size_t hstepA = GATHER ? (size_t)0 : (size_t)HALF * g.lda * ESZ, hstepB = (size_t)HALF * g.ldb * ESZ;
    const unsigned ldsw = (unsigned)wid * 1024u;
    const int aoff = lds_byte(wr * 64 + fr, FP8 ? fq * 16 : fq * 8), boff = lds_byte(wc * 32 + fr, FP8 ? fq * 16 : fq * 8);
    const int sel8 = FP8 ? ((fq & 1) << 4) : 0; const int aoff1 = aoff + sel8, aoff2 = aoff + 16 - sel8, boff1 = boff + sel8, boff2 = boff + 16 - sel8;
#define PG8_SA(b, h) (((b) * 2 + (h)) * HTB)
#define PG8_SB(b, h) ((4 + (b) * 2 + (h)) * HTB)
#define PG8_STAGE(bufoff, gbase, voff) do { _Pragma("unroll") for (int _i = 0; _i < 2; ++_i) \
        __builtin_amdgcn_global_load_lds((const unsigned*)((const char*)(gbase) + (voff)[_i]), (LAS unsigned*)(lds + (bufoff) + ldsw + _i * 8192), 16, 0, 0); } while (0)
#define PG8_CAT(p_, q_) __builtin_shufflevector(*(const LAS v4i*)(p_), *(const LAS v4i*)(q_), 0, 1, 2, 3, 4, 5, 6, 7)
#define PG8_LDA(dst, b, h) do { if constexpr (FP8) { _Pragma("unroll") for (int m = 0; m < 4; ++m) dst##8[m] = PG8_CAT(lds + PG8_SA(b, h) + aoff1 + m * 2048, lds + PG8_SA(b, h) + aoff2 + m * 2048); } \
        else { _Pragma("unroll") for (int m = 0; m < 4; ++m) _Pragma("unroll") for (int k = 0; k < 2; ++k) dst[m][k] = *(const LAS bf16x8*)(lds + PG8_SA(b, h) + aoff + m * 2048 + k * 1024); } } while (0)
#define PG8_LDB(dst, b, h) do { if constexpr (FP8) { _Pragma("unroll") for (int n = 0; n < 2; ++n) dst##8[n] = PG8_CAT(lds + PG8_SB(b, h) + boff1 + n * 2048, lds + PG8_SB(b, h) + boff2 + n * 2048); } \
        else { _Pragma("unroll") for (int n = 0; n < 2; ++n) _Pragma("unroll") for (int k = 0; k < 2; ++k) dst[n][k] = *(const LAS bf16x8*)(lds + PG8_SB(b, h) + boff + n * 2048 + k * 1024); } } while (0)
#define PG8_MMA(ai, bj, At, Bt) do { __builtin_amdgcn_s_setprio(1); \
        if constexpr (FP8) { _Pragma("unroll") for (int m = 0; m < 4; ++m) _Pragma("unroll") for (int n = 0; n < 2; ++n) \
            asm volatile("v_mfma_scale_f32_16x16x128_f8f6f4 %0, %1, %2, %0, %3, %4 op_sel_hi:[0,0,0]" : "+v"(acc[ai][bj][m][n]) : "v"(Bt##8[n]), "v"(At##8[m]), "v"(vsw), "v"(vsx)); } \
        else { _Pragma("unroll") for (int m = 0; m < 4; ++m) _Pragma("unroll") for (int n = 0; n < 2; ++n) _Pragma("unroll") for (int k = 0; k < 2; ++k) \
            acc[ai][bj][m][n] = __builtin_amdgcn_mfma_f32_16x16x32_bf16(Bt[n][k], At[m][k], acc[ai][bj][m][n], 0, 0, 0); } \
        __builtin_amdgcn_s_setprio(0); } while (0)
#define PG8_WAIT_V(n) asm volatile("s_waitcnt vmcnt(" #n ")" ::: "memory")
#define PG8_WAIT_L(n) asm volatile("s_waitcnt lgkmcnt(" #n ")" ::: "memory")
#define PG8_BAR __builtin_amdgcn_s_barrier()
#define PG8_SCHED __builtin_amdgcn_sched_barrier(0)
    Unit cur, nxt; int ui = 0;
    if (!S.next(0, cur)) return;
    f32x4 acc[2][2][4][2];
#pragma unroll
    for (int a = 0; a < 2; ++a)
#pragma unroll
        for (int b = 0; b < 2; ++b)
#pragma unroll
            for (int m = 0; m < 4; ++m)
#pragma unroll
                for (int n = 0; n < 2; ++n) acc[a][b][m][n] = (f32x4){0.f, 0.f, 0.f, 0.f};
    bf16x8 At[4][2], B0[2][2], B1[2][2];
    v8i At8[4], B08[2], B18[2];
    const int vsw = g.sw, vsx = g.sx;
    const char* cA = cur.A; const char* cB = cur.B;
    S.a_ready(cur);
    if constexpr (GATHER) {
#pragma unroll
        for (int i = 0; i < 2; ++i) { gc0[i] = (unsigned)selrow[cur.pm * 256 + gR[i]] * (unsigned)(g.lda * ESZ) + gC2[i]; gc1[i] = (unsigned)selrow[cur.pm * 256 + 128 + gR[i]] * (unsigned)(g.lda * ESZ) + gC2[i]; } }
    if constexpr (SP2) {
        PG8_STAGE(PG8_SB(0, 0), cB, voffB); PG8_STAGE(PG8_SB(0, 1), cB + hstepB, voffB); PG8_STAGE(PG8_SA(0, 0), cA, gc0); PG8_STAGE(PG8_SA(0, 1), cA + hstepA, gc1);
        if (wr == 1) PG8_BAR;
        PG8_WAIT_V(2); PG8_BAR;
        PG8_STAGE(PG8_SB(1, 0), cB + kstep, voffB); PG8_STAGE(PG8_SA(1, 0), cA + kstep, gc0); PG8_STAGE(PG8_SB(1, 1), cB + hstepB + kstep, voffB);
        PG8_WAIT_V(6); PG8_BAR;
    } else {
        PG8_STAGE(PG8_SB(0, 0), cB, voffB); PG8_STAGE(PG8_SA(0, 0), cA, voffA); PG8_STAGE(PG8_SB(0, 1), cB + hstepB, voffB); PG8_STAGE(PG8_SA(0, 1), cA + hstepA, voffA);
        if (wr == 1) PG8_BAR;
        PG8_WAIT_V(4); PG8_BAR;
        PG8_STAGE(PG8_SB(1, 0), cB + kstep, voffB); PG8_STAGE(PG8_SA(1, 0), cA + kstep, voffA); PG8_STAGE(PG8_SB(1, 1), cB + hstepB + kstep, voffB);
        PG8_WAIT_V(6); PG8_BAR;
    }
    for (;;) {
        const bool has_next = S.next(ui + 1, nxt);
        if constexpr (GATHER) { if (has_next) {
#pragma unroll
            for (int i = 0; i < 2; ++i) { gn0r[i] = selrow[nxt.pm * 256 + gR[i]]; gn1r[i] = selrow[nxt.pm * 256 + 128 + gR[i]]; } } }
        const char* nA = has_next ? nxt.A : cA; const char* nB = has_next ? nxt.B : cB;
#pragma unroll 1
        for (int t = 0; t < nt; t += 2) {
            const bool last = (t == nt - 2);
            const char* a1 = cA + (size_t)(t + 1) * kstep;
            const char* a2 = last ? nA : cA + (size_t)(t + 2) * kstep; const char* b2 = last ? nB : cB + (size_t)(t + 2) * kstep;
            const char* a3 = a2 + kstep; const char* b3 = b2 + kstep;
            if (last && has_next) S.a_ready(nxt);
            unsigned s0[2] = {gc0[0], gc0[1]}, s1[2] = {gc1[0], gc1[1]};
            if constexpr (GATHER) { if (last && has_next) { asm volatile("" : "+v"(gn0r[0]), "+v"(gn0r[1]), "+v"(gn1r[0]), "+v"(gn1r[1]));
#pragma unroll
                for (int i = 0; i < 2; ++i) { s0[i] = (unsigned)gn0r[i] * (unsigned)(g.lda * ESZ) + gC2[i]; s1[i] = (unsigned)gn1r[i] * (unsigned)(g.lda * ESZ) + gC2[i]; } } }
            if constexpr (SP2) {
            PG8_LDB(B0, 0, 0); PG8_LDB(B1, 0, 1); PG8_SCHED; PG8_LDA(At, 0, 0); PG8_STAGE(PG8_SA(1, 1), a1 + hstepA, gc1);
            PG8_WAIT_V(8); PG8_WAIT_L(0); PG8_BAR; PG8_MMA(0, 0, At, B0); PG8_MMA(0, 1, At, B1); PG8_BAR; PG8_SCHED;
            PG8_LDA(At, 0, 1); PG8_STAGE(PG8_SB(0, 0), b2, voffB); PG8_STAGE(PG8_SB(0, 1), b2 + hstepB, voffB); PG8_STAGE(PG8_SA(0, 0), a2, s0);
            PG8_WAIT_V(8); PG8_WAIT_L(0); PG8_BAR; PG8_MMA(1, 0, At, B0); PG8_MMA(1, 1, At, B1); PG8_BAR; PG8_SCHED;
            PG8_LDB(B0, 1, 0); PG8_LDB(B1, 1, 1); PG8_SCHED; PG8_LDA(At, 1, 0); PG8_STAGE(PG8_SA(0, 1), a2 + hstepA, s1);
            PG8_WAIT_V(8); PG8_WAIT_L(0); PG8_BAR; PG8_MMA(0, 0, At, B0); PG8_MMA(0, 1, At, B1); PG8_BAR; PG8_SCHED;
            PG8_LDA(At, 1, 1); PG8_STAGE(PG8_SB(1, 0), b3, voffB); PG8_STAGE(PG8_SB(1, 1), b3 + hstepB, voffB); PG8_STAGE(PG8_SA(1, 0), a3, s0);
            PG8_WAIT_V(8); PG8_WAIT_L(0); PG8_BAR; PG8_MMA(1, 0, At, B0); PG8_MMA(1, 1, At, B1); PG8_BAR; PG8_SCHED;
            } else {
            PG8_LDB(B0, 0, 0); PG8_SCHED; PG8_LDA(At, 0, 0); PG8_STAGE(PG8_SA(1, 1), a1 + hstepA, voffA);
            PG8_WAIT_L(8); PG8_BAR; PG8_WAIT_L(0); PG8_MMA(0, 0, At, B0); PG8_BAR; PG8_SCHED;
            PG8_LDB(B1, 0, 1); PG8_STAGE(PG8_SB(0, 0), b2, voffB);
            PG8_BAR; PG8_WAIT_L(0); PG8_MMA(0, 1, At, B1); PG8_BAR;
            PG8_LDA(At, 0, 1); PG8_STAGE(PG8_SA(0, 0), a2, voffA);
            PG8_BAR; PG8_WAIT_L(0); PG8_MMA(1, 0, At, B0); PG8_BAR; PG8_SCHED;
            PG8_STAGE(PG8_SB(0, 1), b2 + hstepB, voffB);
            PG8_WAIT_V(6); PG8_BAR; PG8_MMA(1, 1, At, B1); PG8_BAR;
            PG8_LDB(B0, 1, 0); PG8_SCHED; PG8_LDA(At, 1, 0); PG8_STAGE(PG8_SA(0, 1), a2 + hstepA, voffA);
            PG8_WAIT_L(8); PG8_BAR; PG8_WAIT_L(0); PG8_MMA(0, 0, At, B0); PG8_BAR; PG8_SCHED;
            PG8_LDB(B1, 1, 1); PG8_STAGE(PG8_SB(1, 0), b3, voffB);
            PG8_BAR; PG8_WAIT_L(0); PG8_MMA(0, 1, At, B1); PG8_BAR;
            PG8_LDA(At, 1, 1); PG8_STAGE(PG8_SA(1, 0), a3, voffA);
            PG8_BAR; PG8_WAIT_L(0); PG8_MMA(1, 0, At, B0); PG8_BAR; PG8_SCHED;
            PG8_STAGE(PG8_SB(1, 1), b3 + hstepB, voffB);
            PG8_WAIT_V(6); PG8_BAR; PG8_MMA(1, 1, At, B1); PG8_BAR;
            }
        }
        if constexpr (ALIGN_EPI) { if (wr == 0) PG8_BAR; }
        if constexpr (FP8) asm volatile("s_nop 7\n\ts_nop 7\n\ts_nop 3" ::: "memory");
        E(acc, cur, wr, wc, fr, fq); S.done(cur);
        if (!has_next) break;
#pragma unroll
        for (int a = 0; a < 2; ++a)
#pragma unroll
            for (int b = 0; b < 2; ++b)
#pragma unroll
                for (int m = 0; m < 4; ++m)
#pragma unroll
                    for (int n = 0; n < 2; ++n) acc[a][b][m][n] = (f32x4){0.f, 0.f, 0.f, 0.f};
        cur = nxt; cA = nA; cB = nB; ++ui;
        if constexpr (GATHER) {
#pragma unroll
            for (int i = 0; i < 2; ++i) { gc0[i] = (unsigned)gn0r[i] * (unsigned)(g.lda * ESZ) + gC2[i]; gc1[i] = (unsigned)gn1r[i] * (unsigned)(g.lda * ESZ) + gC2[i]; } }
        if constexpr (ALIGN_EPI) { if (wr == 1) PG8_BAR; }
    }
    PG8_WAIT_V(0);
    if constexpr (!ALIGN_EPI) { if (wr == 0) PG8_BAR; }
    PG8_BAR;
#undef PG8_SA
#undef PG8_SB
#undef PG8_STAGE
#undef PG8_LDA
#undef PG8_LDB
#undef PG8_MMA
#undef PG8_CAT
#undef PG8_WAIT_V
#undef PG8_WAIT_L
#undef PG8_BAR
#undef PG8_SCHED
}
}
using pg8::Unit;

#define XB_TMO      128
#define XB_XCNT(j)  (256  + 64 * (j))
#define XB_XSUB(j)  (1280 + 64 * (j))
#define XB_XGEN(j)  (2304 + 64 * (j))
#define XB_TOP      3328
#define XB_TOPGEN   3392
#define XCD_BAR_WORDS 3456
#define XB_SPIN_CAP (1u << 18)

__device__ __forceinline__ unsigned xb_ld(unsigned* p)              { return __hip_atomic_load(p, __ATOMIC_RELAXED, __HIP_MEMORY_SCOPE_AGENT); }
__device__ __forceinline__ unsigned xb_add(unsigned* p, unsigned v) { return __hip_atomic_fetch_add(p, v, __ATOMIC_RELAXED, __HIP_MEMORY_SCOPE_AGENT); }
__device__ __forceinline__ unsigned xb_xcc_id() { return (unsigned)__builtin_amdgcn_s_getreg((3 << 11) | 20) & 0xFu; }
#define XB_SPIN(cond, bar) do { unsigned _sp = 0; while (cond) { __builtin_amdgcn_s_sleep(1); \
    if ((++_sp & 255u) == 0u) { if (xb_ld(&(bar)[XB_TMO])) break; if (_sp > XB_SPIN_CAP) { atomicAdd(&(bar)[XB_TMO], 1u); break; } } } } while (0)

struct XcdBarrier {
    unsigned* bar; unsigned x;
    volatile LAS unsigned* st;
};

__device__ __forceinline__ XcdBarrier xcd_barrier_post(unsigned* bar, volatile LAS unsigned* st) {
    XcdBarrier b; b.bar = bar; b.x = xb_xcc_id(); b.st = st;
    if (threadIdx.x == 0) (void)xb_add(&bar[XB_XCNT(b.x)], 1u);
    return b;
}
__device__ __forceinline__ void xcd_barrier_complete(unsigned* bar, unsigned x, unsigned& nloc, unsigned& nx) {
    const unsigned G = gridDim.x * gridDim.y * gridDim.z;
    unsigned sum, cnt, mine, sp = 0u;
    for (;;) {
        sum = 0u; cnt = 0u; mine = 0u;
#pragma unroll
        for (unsigned j = 0; j < 16; ++j) { const unsigned c = xb_ld(&bar[XB_XCNT(j)]); sum += c; cnt += (c > 0u) ? 1u : 0u; mine = (j == x) ? c : mine; }
        if (sum == G) break;
        __builtin_amdgcn_s_sleep(1);
        if ((++sp & 255u) == 0u) { if (xb_ld(&bar[XB_TMO])) break; if (sp > XB_SPIN_CAP) { atomicAdd(&bar[XB_TMO], 1u); break; } }
    }
    nloc = mine > 0u ? mine : 1u; nx = cnt > 0u ? cnt : 1u;
}

__device__ __forceinline__ void xcd_barrier(const XcdBarrier& b) {
    asm volatile("s_waitcnt vmcnt(0)" ::: "memory");
    __syncthreads();
    if (threadIdx.x == 0) {
        unsigned* bar = b.bar;
        __builtin_amdgcn_s_waitcnt(0);
        unsigned nloc = b.st[0], nx = b.st[1];
        if (nloc == 0u) { xcd_barrier_complete(bar, b.x, nloc, nx); b.st[0] = nloc; b.st[1] = nx; }
        const unsigned old = xb_add(&bar[XB_XSUB(b.x)], 1u);
        const unsigned gen = old / nloc;
        if (old + 1u == (gen + 1u) * nloc) {
            __builtin_amdgcn_fence(__ATOMIC_RELEASE, "agent");
            asm volatile("s_waitcnt vmcnt(0)" ::: "memory");
            const unsigned og = xb_add(&bar[XB_TOP], 1u);
            const unsigned tg = og / nx;
            if (og + 1u == (tg + 1u) * nx) xb_add(&bar[XB_TOPGEN], 1u);
            else XB_SPIN(xb_ld(&bar[XB_TOPGEN]) == tg, bar);
            __builtin_amdgcn_fence(__ATOMIC_ACQUIRE, "agent");
            xb_add(&bar[XB_XGEN(b.x)], 1u);
            asm volatile("s_waitcnt vmcnt(0)" ::: "memory");
        } else {
            XB_SPIN(xb_ld(&bar[XB_XGEN(b.x)]) == gen, bar);
            __builtin_amdgcn_fence(__ATOMIC_ACQUIRE, "agent");
            asm volatile("s_waitcnt vmcnt(0)" ::: "memory");
        }
    }
    __syncthreads();
}

__device__ __forceinline__ unsigned pk4_fp8(float a, float b, float c, float d) { int w = 0; w = __builtin_amdgcn_cvt_pk_fp8_f32(a, b, w, false); w = __builtin_amdgcn_cvt_pk_fp8_f32(c, d, w, true); return (unsigned)w; }
#define EPI_SIG const f32x4 (&acc)[2][2][4][2], const Unit& u, int wr, int wc, int fr, int fq
struct EpiZ { static constexpr bool PERM = true; bf16* ZB; float* ZF;
    __device__ __forceinline__ void operator()(EPI_SIG) const {
        const int row0 = u.pm * 256 + wr * 64 + fr;
        if (u.pn < 11) {
            const int col0 = u.pn * 256 + wc * 32 + 8 * fq;
#pragma unroll
            for (int ai = 0; ai < 2; ++ai)
#pragma unroll
                for (int m = 0; m < 4; ++m) { bf16* rowp = ZB + (size_t)(row0 + ai * 128 + m * 16) * NZB + col0;
#pragma unroll
                    for (int bj = 0; bj < 2; ++bj) { const f32x4 v0 = acc[ai][bj][m][0], v1 = acc[ai][bj][m][1]; v4u w; w.x = cvt_pk_bf16(v0[0], v0[1]); w.y = cvt_pk_bf16(v0[2], v0[3]); w.z = cvt_pk_bf16(v1[0], v1[1]); w.w = cvt_pk_bf16(v1[2], v1[3]);
                        *(v4u*)(rowp + bj * 128) = w; } }
        } else {
            const int col0 = (u.pn - 11) * 256 + wc * 32 + 8 * fq;
#pragma unroll
            for (int ai = 0; ai < 2; ++ai)
#pragma unroll
                for (int m = 0; m < 4; ++m) { float* rowp = ZF + (size_t)(row0 + ai * 128 + m * 16) * NZF + col0;
#pragma unroll
                    for (int bj = 0; bj < 2; ++bj) { *(f32x4*)(rowp + bj * 128) = acc[ai][bj][m][0]; *(f32x4*)(rowp + bj * 128 + 4) = acc[ai][bj][m][1]; } }
        }
    }
};
struct EpiBf { static constexpr bool PERM = true; bf16* O; int ldc; const float* roww;
    __device__ __forceinline__ void operator()(EPI_SIG) const {
        const int row0 = u.pm * 256 + wr * 64 + fr, col0 = u.pn * 256 + wc * 32 + 8 * fq;
#pragma unroll
        for (int ai = 0; ai < 2; ++ai)
#pragma unroll
            for (int m = 0; m < 4; ++m) { const int row = row0 + ai * 128 + m * 16; const float s = roww ? roww[row] : 1.0f; bf16* rowp = O + (size_t)row * ldc + col0;
#pragma unroll
                for (int bj = 0; bj < 2; ++bj) { const f32x4 v0 = acc[ai][bj][m][0] * s, v1 = acc[ai][bj][m][1] * s; v4u w; w.x = cvt_pk_bf16(v0[0], v0[1]); w.y = cvt_pk_bf16(v0[2], v0[3]); w.z = cvt_pk_bf16(v1[0], v1[1]); w.w = cvt_pk_bf16(v1[2], v1[3]);
                    *(v4u*)(rowp + bj * 128) = w; } }
    }
};
struct EpiFour1 { static constexpr bool PERM = true; bf16* VTL; bf16* VTC;
    __device__ __forceinline__ void operator()(EPI_SIG) const {
        bf16* base; int ldc;
        if (u.pn < 128) { const int b = u.pn >> 3, t0 = (u.pn & 7) * 256; base = VTL + (size_t)b * 256 * 4096 + u.pm * 2048 + t0; ldc = 4096; }
        else { const int b = u.pn - 128; base = VTC + (size_t)b * 256 * 512 + u.pm * 256; ldc = 512; }
        const int r0 = wr * 64 + fr, col0 = wc * 32 + 8 * fq;
#pragma unroll
        for (int ai = 0; ai < 2; ++ai)
#pragma unroll
            for (int m = 0; m < 4; ++m) { bf16* rowp = base + (size_t)(r0 + ai * 128 + m * 16) * ldc + col0;
#pragma unroll
                for (int bj = 0; bj < 2; ++bj) { const f32x4 v0 = acc[ai][bj][m][0], v1 = acc[ai][bj][m][1]; v4u w; w.x = cvt_pk_bf16(v0[0], v0[1]); w.y = cvt_pk_bf16(v0[2], v0[3]); w.z = cvt_pk_bf16(v1[0], v1[1]); w.w = cvt_pk_bf16(v1[2], v1[3]);
                    *(v4u*)(rowp + bj * 128) = w; } }
    }
};
struct EpiF32 { static constexpr bool PERM = false; float* C; int ldc;
    __device__ __forceinline__ void operator()(EPI_SIG) const {
        const int row0 = u.pm * 256 + wr * 64 + fr, col0 = u.pn * 256 + wc * 32 + 4 * fq;
#pragma unroll
        for (int ai = 0; ai < 2; ++ai)
#pragma unroll
            for (int m = 0; m < 4; ++m) { float* rowp = C + (size_t)(row0 + ai * 128 + m * 16) * ldc + col0;
#pragma unroll
                for (int bj = 0; bj < 2; ++bj)
#pragma unroll
                    for (int n = 0; n < 2; ++n) *(f32x4*)(rowp + bj * 128 + n * 16) = acc[ai][bj][m][n]; }
    }
};
struct EpiFourT { static constexpr bool PERM = false; float* FO; int ctx;
    __device__ __forceinline__ void operator()(EPI_SIG) const {
        float* base = ctx ? FO + (size_t)(ML + u.pn * 256) * 256 : FO + (size_t)(u.pn & 1) * MT * 256 + (size_t)((u.pn >> 1) * 2048 + u.pm * 256) * 256;
        const int r0 = wr * 64 + fr, col0 = wc * 32 + 4 * fq;
#pragma unroll
        for (int ai = 0; ai < 2; ++ai)
#pragma unroll
            for (int m = 0; m < 4; ++m) { float* rowp = base + (size_t)(r0 + ai * 128 + m * 16) * 256 + col0;
#pragma unroll
                for (int bj = 0; bj < 2; ++bj)
#pragma unroll
                    for (int n = 0; n < 2; ++n) *(f32x4*)(rowp + bj * 128 + n * 16) = acc[ai][bj][m][n]; }
    }
};
struct EpiP { static constexpr bool PERM = true; bf16* P2;
    __device__ __forceinline__ void operator()(EPI_SIG) const {
        const int g = u.pn >> 2, ct = u.pn & 3;
#pragma unroll
        for (int ai = 0; ai < 2; ++ai)
#pragma unroll
            for (int m = 0; m < 4; ++m)
#pragma unroll
                for (int bj = 0; bj < 2; ++bj) { const int pn = ct * 4 + bj * 2 + (wc >> 1), wave_m = wr * 4 + (wc & 1) * 2 + (fq >> 1);
#pragma unroll
                    for (int n = 0; n < 2; ++n) { const int lane_m = ((fq & 1) * 2 + n) * 16 + fr; const f32x4 v = acc[ai][bj][m][n];
                        v2u w; w.x = cvt_pk_bf16(v[0], v[1]); w.y = cvt_pk_bf16(v[2], v[3]);
                        *(v2u*)(P2 + ((((((size_t)u.pm * 16 + pn) * 2 + ai) * 4 + m) * 8 + wave_m) * 4 + g) * 256 + lane_m * 4) = w; } }
    }
};
struct EpiMerge { static constexpr bool PERM = false; const bf16* P; bf16* T; const float* bg;
    __device__ __forceinline__ void operator()(EPI_SIG) const {
        const int row0 = u.pm * 256 + wr * 64 + fr, oc = u.pn * 64 + wc * 16 + 4 * fq;
        f32x4 bv[4];
#pragma unroll
        for (int g = 0; g < 4; ++g) bv[g] = *(const f32x4*)(bg + g * 1024 + oc);
#pragma unroll
        for (int ai = 0; ai < 2; ++ai)
#pragma unroll
            for (int m = 0; m < 4; ++m) { const int row = row0 + ai * 128 + m * 16; const bf16* prow = P + (((((size_t)u.pm * 16 + u.pn) * 2 + ai) * 4 + m) * 8 + (wr * 4 + wc)) * 1024 + (fq * 16 + fr) * 4;
                v2u pw[4];
#pragma unroll
                for (int g = 0; g < 4; ++g) pw[g] = *(const v2u*)(prow + g * 256);
                f32x4 t = (f32x4){0.f, 0.f, 0.f, 0.f};
#pragma unroll
                for (int bj = 0; bj < 2; ++bj)
#pragma unroll
                    for (int n = 0; n < 2; ++n) { const int g = 2 * bj + n; const f32x4 a = acc[ai][bj][m][n] + bv[g];
                        t[0] += sigmoid_fast(a[0]) * bf2f(pw[g].x & 0xffffu); t[1] += sigmoid_fast(a[1]) * bf2f(pw[g].x >> 16);
                        t[2] += sigmoid_fast(a[2]) * bf2f(pw[g].y & 0xffffu); t[3] += sigmoid_fast(a[3]) * bf2f(pw[g].y >> 16); }
                v2u w; w.x = cvt_pk_bf16(t[0], t[1]); w.y = cvt_pk_bf16(t[2], t[3]);
                *(v2u*)(T + (size_t)row * 1024 + oc) = w; }
    }
};
struct EpiSwiGLU { static constexpr bool PERM = true; unsigned char* HID;
    __device__ __forceinline__ void operator()(EPI_SIG) const {
        const int row0 = u.pm * 256 + wr * 64 + fr, col0 = u.pn * 128 + wc * 32 + 8 * fq;
#pragma unroll
        for (int ai = 0; ai < 2; ++ai)
#pragma unroll
            for (int m = 0; m < 4; ++m) { unsigned char* rowp = HID + (size_t)(row0 + ai * 128 + m * 16) * 1024 + col0; float o[8];
#pragma unroll
                for (int n = 0; n < 2; ++n)
#pragma unroll
                    for (int j = 0; j < 4; ++j) { const float gv = acc[ai][0][m][n][j], uv = acc[ai][1][m][n][j]; o[4 * n + j] = fminf(fmaxf(gv * sigmoid_fast(gv) * uv, -448.f), 448.f); }
                v2u w; w.x = pk4_fp8(o[0], o[1], o[2], o[3]); w.y = pk4_fp8(o[4], o[5], o[6], o[7]);
                *(v2u*)rowp = w; }
    }
};
struct EpiZB { static constexpr bool PERM = true; bf16* O;
    __device__ __forceinline__ void operator()(EPI_SIG) const {
        const int row0 = u.pm * 256 + wr * 64 + fr, col0 = u.pn * 256 + wc * 32 + 8 * fq; const bool sl = (u.pn == 0);
#pragma unroll
        for (int ai = 0; ai < 2; ++ai)
#pragma unroll
            for (int m = 0; m < 4; ++m) { bf16* rowp = O + (size_t)(row0 + ai * 128 + m * 16) * NZB + col0;
#pragma unroll
                for (int bj = 0; bj < 2; ++bj) { f32x4 v0 = acc[ai][bj][m][0], v1 = acc[ai][bj][m][1];
                    if (sl) {
#pragma unroll
                        for (int t = 0; t < 4; ++t) { v0[t] *= sigmoid_fast(v0[t]); v1[t] *= sigmoid_fast(v1[t]); } }
                    v4u w; w.x = cvt_pk_bf16(v0[0], v0[1]); w.y = cvt_pk_bf16(v0[2], v0[3]); w.z = cvt_pk_bf16(v1[0], v1[1]); w.w = cvt_pk_bf16(v1[2], v1[3]);
                    *(v4u*)(rowp + bj * 128) = w; } }
    }
};
struct EpiZF { static constexpr bool PERM = false; float* C; const float* lb;
    __device__ __forceinline__ void operator()(EPI_SIG) const {
        const int row0 = u.pm * 256 + wr * 64 + fr, cc = wc * 32 + 4 * fq;
        f32x4 lbv[2][2];
#pragma unroll
        for (int bj = 0; bj < 2; ++bj)
#pragma unroll
            for (int n = 0; n < 2; ++n) lbv[bj][n] = (u.pn < 2) ? *(const f32x4*)(lb + u.pn * 1024 + cc + bj * 128 + n * 16) : (f32x4){0.f, 0.f, 0.f, 0.f};
#pragma unroll
        for (int ai = 0; ai < 2; ++ai)
#pragma unroll
            for (int m = 0; m < 4; ++m) { float* rowp = C + (size_t)(row0 + ai * 128 + m * 16) * NZF + u.pn * 256 + cc;
#pragma unroll
                for (int bj = 0; bj < 2; ++bj)
#pragma unroll
                    for (int n = 0; n < 2; ++n) { f32x4 v = acc[ai][bj][m][n];
                        if (u.pn < 2) {
#pragma unroll
                            for (int t = 0; t < 4; ++t) v[t] = __logf(fmaxf(lbv[bj][n][t] + (1.0f - lbv[bj][n][t]) * sigmoid_fast(v[t]), 1e-30f)); }
                        if (u.pn < 2 || (bj == 0 && wc == 0 && (n == 0 || fq < 2))) *(f32x4*)(rowp + bj * 128 + n * 16) = v; } }
    }
};
struct EpiF8 { static constexpr bool PERM = true; unsigned char* O; const float* roww;
    __device__ __forceinline__ void operator()(EPI_SIG) const {
        const int row0 = u.pm * 256 + wr * 64 + fr, col0 = u.pn * 256 + wc * 32 + 8 * fq;
#pragma unroll
        for (int ai = 0; ai < 2; ++ai)
#pragma unroll
            for (int m = 0; m < 4; ++m) { const int row = row0 + ai * 128 + m * 16; const float s = roww[row] * 64.0f; unsigned char* rowp = O + (size_t)row * 1024 + col0;
#pragma unroll
                for (int bj = 0; bj < 2; ++bj) { const f32x4 v0 = acc[ai][bj][m][0] * s, v1 = acc[ai][bj][m][1] * s; v2u w;
                    w.x = pk4_fp8(fminf(fmaxf(v0[0], -448.f), 448.f), fminf(fmaxf(v0[1], -448.f), 448.f), fminf(fmaxf(v0[2], -448.f), 448.f), fminf(fmaxf(v0[3], -448.f), 448.f));
                    w.y = pk4_fp8(fminf(fmaxf(v1[0], -448.f), 448.f), fminf(fmaxf(v1[1], -448.f), 448.f), fminf(fmaxf(v1[2], -448.f), 448.f), fminf(fmaxf(v1[3], -448.f), 448.f));
                    *(v2u*)(rowp + bj * 128) = w; } }
    }
};
struct MapPlain { const char* A; const char* B; size_t sa, sb; __device__ __forceinline__ void operator()(Unit& u) const { u.A = A + (size_t)u.pm * sa; u.B = B + (size_t)u.pn * sb; } };
struct MapP { const char* OUTS; const char* WBR; __device__ __forceinline__ void operator()(Unit& u) const { const int g = u.pn >> 2; u.A = OUTS + (size_t)u.pm * (256 * 1024 * 2) + g * 512; u.B = WBR + (size_t)g * (1024 * 256 * 2) + (size_t)(u.pn & 3) * (256 * 256 * 2); } };
struct MapFourT { const char* DFTL; const char* VTL; __device__ __forceinline__ void operator()(Unit& u) const { const int kh = u.pn & 1; u.A = DFTL + (size_t)u.pm * (256 * 4096 * 2) + kh * 4096; u.B = VTL + (size_t)(u.pn >> 1) * (256 * 4096 * 2) + kh * 4096; } };
struct MapMoE { const char* A; const char* W; size_t se, st; __device__ __forceinline__ void operator()(Unit& u) const { const int e = u.pm < 256 ? (u.pm >> 4) : ((u.pm - 256) >> 1); u.A = A + (size_t)u.pm * st; u.B = W + (size_t)e * se + (size_t)u.pn * st; } };
struct MapMoEG { const char* A; const char* W; size_t se, st; __device__ __forceinline__ void operator()(Unit& u) const { const int e = u.pm < 256 ? (u.pm >> 4) : ((u.pm - 256) >> 1); u.A = A; u.B = W + (size_t)e * se + (size_t)u.pn * st; } };
struct Args { const float* in[31]; float* out; unsigned char* ws; int ph_lo, ph_hi, li, pad; };
enum { I_X = 0, I_C, I_CTX, I_CCTX, I_ADAW, I_ADAB, I_WIN, I_LBLOG, I_HGRN_NW, I_GDN_CW, I_GDN_ALOG, I_GDN_DTB, I_GDN_NW, I_SSD_CW, I_SSD_CB, I_SSD_ALOG, I_SSD_DTB, I_SSD_D, I_SSD_NW,
       I_WGATE, I_BGATE, I_WBR, I_WOUT, I_LN1G, I_LN1B, I_WROUTER, I_WFFG, I_WFFU, I_WFFD, I_LN2G, I_LN2B };
struct WCtx { int tid, lane, wave, bid, G, gw, NGW; };

__device__ __forceinline__ float dpp_xor1(float x) { return __int_as_float(__builtin_amdgcn_mov_dpp(__float_as_int(x), 0xB1, 0xf, 0xf, true)); }
__device__ __forceinline__ float dpp_xor2(float x) { return __int_as_float(__builtin_amdgcn_mov_dpp(__float_as_int(x), 0x4E, 0xf, 0xf, true)); }
__device__ __forceinline__ int zrow(int n) {
    if (n < 256) return n;
    if (n < 512) return 11 * 256 + (n - 256);
    if (n < 768) return 12 * 256 + (n - 512);
    if (n < 1024) return 1 * 256 + (n - 768);
    if (n < 1280) return 2 * 256 + (n - 1024);
    if (n < 2048) return 3 * 256 + (n - 1280);
    if (n < 2304) return 6 * 256 + (n - 2048);
    if (n < 2312) return 13 * 256 + (n - 2304);
    if (n < 2320) return 13 * 256 + 8 + (n - 2312);
    if (n < 2576) return 7 * 256 + (n - 2320);
    if (n < 3088) return 8 * 256 + (n - 2576);
    if (n < 3344) return 10 * 256 + (n - 3088);
    return 13 * 256 + 16 + (n - 3344);
}
__device__ __forceinline__ int rowmap(int mode, int aux, int n) {
    if (mode == 0) return n;
    if (mode == 1) return zrow(n);
    if (mode == 2) return 256 * (n >> 6) + 128 * (aux >> 1) + 32 * ((n & 63) >> 4) + 16 * (aux & 1) + (n & 15);
    if (mode == 3) return 256 * (n >> 7) + (n & 127);
    return 256 * (n >> 7) + 128 + (n & 127);
}
__device__ __forceinline__ void transpose_item(const float* W, int N, bf16* WT, int ldt, LAS unsigned* scr, int item, int lane, int mode, int aux) {
    const int nblk = (N + 63) >> 6, kb = item / nblk, nb = item - kb * nblk, k0 = 64 * kb, n0 = 64 * nb;
    const int ncol = n0 + lane; const bool okc = ncol < N;
    const float* wp = W + (size_t)k0 * N + (okc ? ncol : 0);
    float v[64];
#pragma unroll
    for (int i = 0; i < 64; ++i) v[i] = wp[(size_t)i * N];
#pragma unroll
    for (int i = 0; i < 32; ++i) scr[i * 65 + lane] = okc ? pk2(v[2 * i], v[2 * i + 1]) : 0u;
    LDS_WAIT();
    const int c = lane & 7;
#pragma unroll
    for (int j = 0; j < 8; ++j) { const int nn = (lane >> 3) + 8 * j, n = n0 + nn;
        v4u o; o.x = scr[(4 * c + 0) * 65 + nn]; o.y = scr[(4 * c + 1) * 65 + nn]; o.z = scr[(4 * c + 2) * 65 + nn]; o.w = scr[(4 * c + 3) * 65 + nn];
        if (n < N) *(v4u*)(WT + (size_t)rowmap(mode, aux, n) * ldt + k0 + 8 * c) = o; }
    LDS_WAIT();
}
__device__ __forceinline__ void transpose_item8(const float* W, int N, unsigned char* WT, int ldt, int item, int lane, int mode, int aux) {
    const int nblk = (N + 63) >> 6, kb = item / nblk, nb = item - kb * nblk, k0 = 64 * kb, n0 = 64 * nb;
    const int ncol = n0 + lane;
    const float* wp = W + (size_t)k0 * N + ncol;
    float v[64];
#pragma unroll
    for (int i = 0; i < 64; ++i) v[i] = wp[(size_t)i * N];
    unsigned o[16];
#pragma unroll
    for (int q = 0; q < 16; ++q) o[q] = pk4_fp8(fminf(fmaxf(v[4 * q] * 64.f, -448.f), 448.f), fminf(fmaxf(v[4 * q + 1] * 64.f, -448.f), 448.f), fminf(fmaxf(v[4 * q + 2] * 64.f, -448.f), 448.f), fminf(fmaxf(v[4 * q + 3] * 64.f, -448.f), 448.f));
    v4u* dst = (v4u*)(WT + (size_t)rowmap(mode, aux, ncol) * ldt + k0);
#pragma unroll
    for (int q = 0; q < 4; ++q) dst[q] = (v4u){o[4 * q], o[4 * q + 1], o[4 * q + 2], o[4 * q + 3]};
}
constexpr int WI_IN = 16 * 53, WI_G = 4 * 256, WI_BR = 4 * 64, WI_OUT = 256, WI_FF = 16 * 256;
constexpr int WI_REST = WI_G + WI_BR + WI_OUT + 3 * WI_FF;
constexpr int WI_XA = 9216, WI_XB = 10368;
__device__ __forceinline__ void convert_win(const Args& a, LAS unsigned char* lds, int wave, int lane, int gw, int ngw, int l) {
    LAS unsigned* scr = (LAS unsigned*)(lds + wave * 8448);
    for (int it = gw; it < WI_IN; it += ngw) transpose_item(a.in[I_WIN] + (size_t)l * 1024 * IN_COLS, IN_COLS, (bf16*)(a.ws + WS_WIN), 1024, scr, it, lane, 1, 0);
}
__device__ __forceinline__ void convert_rest(const Args& a, LAS unsigned char* lds, int wave, int lane, int gw, int ngw, int l, int it0, int it1) {
    LAS unsigned* scr = (LAS unsigned*)(lds + wave * 8448);
    unsigned char* ws = a.ws;
    for (int it = it0 + gw; it < it1; it += ngw) {
        int r = it;
        if (r < WI_G) { const int g = r >> 8; transpose_item8(a.in[I_WGATE] + (size_t)(l * 4 + g) * 1024 * 1024, 1024, ws + WS_WG, 1024, r & 255, lane, 2, g); continue; } r -= WI_G;
        if (r < WI_BR) { const int g = r >> 6; transpose_item(a.in[I_WBR] + (size_t)(l * 4 + g) * 256 * 1024, 1024, (bf16*)(ws + WS_WBR) + (size_t)g * 1024 * 256, 256, scr, r & 63, lane, 0, 0); continue; } r -= WI_BR;
        if (r < WI_OUT) { transpose_item(a.in[I_WOUT] + (size_t)l * 1024 * 1024, 1024, (bf16*)(ws + WS_WOUT), 1024, scr, r, lane, 0, 0); continue; } r -= WI_OUT;
        if (r < WI_FF) { const int e = r >> 8; transpose_item8(a.in[I_WFFG] + (size_t)(l * 16 + e) * 1024 * 1024, 1024, ws + WS_WGU + (size_t)e * 2048 * 1024, 1024, r & 255, lane, 3, 0); continue; } r -= WI_FF;
        if (r < WI_FF) { const int e = r >> 8; transpose_item8(a.in[I_WFFU] + (size_t)(l * 16 + e) * 1024 * 1024, 1024, ws + WS_WGU + (size_t)e * 2048 * 1024, 1024, r & 255, lane, 4, 0); continue; } r -= WI_FF;
        { const int e = r >> 8; transpose_item8(a.in[I_WFFD] + (size_t)(l * 16 + e) * 1024 * 1024, 1024, ws + WS_WDN + (size_t)e * 1024 * 1024, 1024, r & 255, lane, 0, 0); }
    }
}

__device__ __forceinline__ void row_load(const float* p, int lane, f32x4 (&v)[4]) { const f32x4* xr = (const f32x4*)p + lane;
#pragma unroll
    for (int j = 0; j < 4; ++j) v[j] = xr[64 * j]; }
__device__ __forceinline__ void row_store(float* p, int lane, const f32x4 (&v)[4]) { f32x4* xr = (f32x4*)p + lane;
#pragma unroll
    for (int j = 0; j < 4; ++j) xr[64 * j] = v[j]; }
__device__ __forceinline__ void ln_stats(const f32x4 (&v)[4], float& mean, float& rstd) {
    float s = 0.f;
#pragma unroll
    for (int j = 0; j < 4; ++j) s += (v[j][0] + v[j][1]) + (v[j][2] + v[j][3]);
    mean = wave_sum(s) * (1.f / 1024.f); float q = 0.f;
#pragma unroll
    for (int j = 0; j < 4; ++j) { const f32x4 d = v[j] - mean; q += (d[0] * d[0] + d[1] * d[1]) + (d[2] * d[2] + d[3] * d[3]); }
    rstd = 1.0f / sqrtf(wave_sum(q) * (1.f / 1024.f) + LN_EPS);
}
__device__ __forceinline__ unsigned pk4c_fp8(f32x4 v) { return pk4_fp8(fminf(fmaxf(v[0], -448.f), 448.f), fminf(fmaxf(v[1], -448.f), 448.f), fminf(fmaxf(v[2], -448.f), 448.f), fminf(fmaxf(v[3], -448.f), 448.f)); }
__device__ __forceinline__ void modulate_row(const f32x4 (&v)[4], const float* sh, const float* sc, bf16* hrow, unsigned* h8row, int lane, f32x4 (&hv)[4]) {
    float mean, rstd; ln_stats(v, mean, rstd);
#pragma unroll
    for (int j = 0; j < 4; ++j) { const f32x4 s = *((const f32x4*)sc + lane + 64 * j), t = *((const f32x4*)sh + lane + 64 * j);
        hv[j] = (v[j] - mean) * rstd * (s + 1.0f) + t;
        v2u w; w.x = cvt_pk_bf16(hv[j][0], hv[j][1]); w.y = cvt_pk_bf16(hv[j][2], hv[j][3]); *((v2u*)hrow + lane + 64 * j) = w; h8row[lane + 64 * j] = pk4c_fp8(hv[j]); }
}
__device__ __forceinline__ const float* mod_ptr(const Args& a, int l, int row, int chunk) { const int r = row < ML ? (row >> 11) : 16; return (const float*)(a.ws + WS_MOD) + ((size_t)(l * 17 + r) * 6144 + chunk * 1024); }

__device__ __forceinline__ void phase_prologue(const Args& a, LAS unsigned char* lds, const WCtx& w) {
    {
        LAS float* SC = (LAS float*)lds; LAS float* RED = (LAS float*)(lds + 17 * 1024 * 4);
        for (int i = w.tid; i < 17 * 1024; i += NTHREADS) { const int r = i >> 10, k = i & 1023; const float v = r < 16 ? a.in[I_C][r * 1024 + k] : a.in[I_CCTX][k]; SC[i] = silu_acc(v); }
        __syncthreads();
        float* MOD = (float*)(a.ws + WS_MOD);
        for (int it = w.bid; it < 4 * 96; it += w.G) {
            const int l = it / 96, cg = it - l * 96;
            const float* wp = a.in[I_ADAW] + (size_t)l * 1024 * 6144 + cg * 64 + w.lane;
            float acc[17];
#pragma unroll
            for (int r = 0; r < 17; ++r) acc[r] = 0.f;
            const int k0 = w.wave * 128;
            const float* wq = wp + (size_t)k0 * 6144;
            float a0 = wq[0], a1 = wq[6144], a2 = wq[2 * 6144], a3 = wq[3 * 6144], b0 = wq[4 * 6144], b1 = wq[5 * 6144], b2 = wq[6 * 6144], b3 = wq[7 * 6144];
#pragma unroll 1
            for (int k = k0; k < k0 + 128; k += 4) {
                const float w0 = a0, w1 = a1, w2 = a2, w3 = a3; a0 = b0; a1 = b1; a2 = b2; a3 = b3;
                if (k + 8 < k0 + 128) { const float* wn = wp + (size_t)(k + 8) * 6144; b0 = wn[0]; b1 = wn[6144]; b2 = wn[2 * 6144]; b3 = wn[3 * 6144]; }
#pragma unroll
                for (int r = 0; r < 17; ++r) { const f32x4 s = *(const LAS f32x4*)(SC + r * 1024 + k); acc[r] += (s[0] * w0 + s[1] * w1) + (s[2] * w2 + s[3] * w3); }
            }
#pragma unroll
            for (int r = 0; r < 17; ++r) RED[(w.wave * 17 + r) * 64 + w.lane] = acc[r];
            __syncthreads();
            for (int i = w.tid; i < 17 * 64; i += NTHREADS) { const int r = i >> 6, col = i & 63; float s = 0.f;
#pragma unroll
                for (int q = 0; q < 8; ++q) s += RED[(q * 17 + r) * 64 + col];
                MOD[(size_t)(l * 17 + r) * 6144 + cg * 64 + col] = s + a.in[I_ADAB][l * 6144 + cg * 64 + col]; }
            __syncthreads();
        }
    }
    {
        float* X = (float*)(a.ws + WS_X);
        float om[4];
#pragma unroll
        for (int e = 0; e < 4; ++e) om[e] = 1.0f / powf(10000.0f, (float)(4 * w.lane + e) * (1.0f / 256.0f));
        int tcur = -1; f32x4 pos[4];
#pragma unroll
        for (int j = 0; j < 4; ++j) pos[j] = (f32x4){0.f, 0.f, 0.f, 0.f};
        for (int row = w.gw; row < MT; row += w.NGW) {
            f32x4 v[4];
            if (row < ML) { row_load(a.in[I_X] + (size_t)row * 1024, w.lane, v); const int t = row & 2047;
                if (t != tcur) { tcur = t; const float pr = (float)(t >> 6), pc = (float)(t & 63);
#pragma unroll
                    for (int e = 0; e < 4; ++e) { pos[0][e] = sinf(pr * om[e]); pos[1][e] = cosf(pr * om[e]); pos[2][e] = sinf(pc * om[e]); pos[3][e] = cosf(pc * om[e]); } }
#pragma unroll
                for (int j = 0; j < 4; ++j) v[j] += pos[j]; }
            else row_load(a.in[I_CTX] + (size_t)(row - ML) * 1024, w.lane, v);
            row_store(X + (size_t)row * 1024, w.lane, v);
        }
    }
    {
        { float* TWg = (float*)(a.ws + WS_LB + 65536);
          for (int i = w.bid * NTHREADS + w.tid; i < 1024; i += w.G * NTHREADS) { float s, c; sincospif((float)i * (1.0f / 1024.0f), &s, &c); TWg[2 * i] = c; TWg[2 * i + 1] = -s; } }
        bf16* D6 = (bf16*)(a.ws + WS_DFT64);
        for (int i = w.bid * NTHREADS + w.tid; i < 512 * 256; i += w.G * NTHREADS) { const int j = i >> 8, k = i & 255; const int g = (j & 255) >> 6, kc = j & 63; float val = 0.f;
            if ((k >> 6) == g) { const int m = (kc * (k & 63)) & 63; float s, c; sincospif((float)m * (1.0f / 32.0f), &s, &c); val = (j >> 8) ? -s : c; }
            D6[i] = (bf16)f2bf(val); }
        if (w.bid == 0) { float* LB = (float*)(a.ws + WS_LB); const int d = w.tid >> 8, ch = w.tid & 255; float lg[4], mx = -1e30f;
#pragma unroll
            for (int l = 0; l < 4; ++l) { lg[l] = a.in[I_LBLOG][(d * 4 + l) * 256 + ch]; mx = fmaxf(mx, lg[l]); }
            float s = 0.f;
#pragma unroll
            for (int l = 0; l < 4; ++l) { lg[l] = expf(lg[l] - mx); s += lg[l]; }
            float cum = 0.f;
#pragma unroll
            for (int l = 0; l < 4; ++l) { if (l > 0) cum += lg[l] / s; LB[(d * 4 + l) * 256 + ch] = cum; } }
    }
    __syncthreads();
    convert_win(a, lds, w.wave, w.lane, w.gw, w.NGW, 0);
}
__device__ __forceinline__ void phase_mod_rows(const Args& a, const WCtx& w, int l) {
    const float* X = (const float*)(a.ws + WS_X); bf16* H = (bf16*)(a.ws + WS_H);
    for (int row = w.gw; row < MT; row += w.NGW) { f32x4 v[4], hv[4]; row_load(X + (size_t)row * 1024, w.lane, v);
        modulate_row(v, mod_ptr(a, l, row, 0), mod_ptr(a, l, row, 1), H + (size_t)row * 1024, (unsigned*)(a.ws + WS_H8 + (size_t)row * 1024), w.lane, hv); }
}

__device__ __forceinline__ f32x4 ld_bf4(const bf16* p) { const v2u u = *(const v2u*)p; return (f32x4){bf2f(u.x & 0xffffu), bf2f(u.x >> 16), bf2f(u.y & 0xffffu), bf2f(u.y >> 16)}; }
__device__ __forceinline__ void st_bf4(bf16* p, f32x4 v) { v2u w; w.x = cvt_pk_bf16(v[0], v[1]); w.y = cvt_pk_bf16(v[2], v[3]); *(v2u*)p = w; }
__device__ __forceinline__ void phase_prep(const Args& a, const WCtx& w, int l) {
    const bf16* ZB = (const bf16*)(a.ws + WS_ZB); bf16* PB = (bf16*)(a.ws + WS_PB);
    constexpr int NSEG = 16 * 128 + 16 * 16;
    for (int it = w.gw; it < NSEG * 3; it += w.NGW) {
        const int seg = it / 3, bg = it - seg * 3;
        int T, t0, rowbase;
        if (seg < 2048) { const int b = seg >> 7; t0 = (seg & 127) * 16; T = 2048; rowbase = b * 2048; } else { const int s2 = seg - 2048; const int b = s2 >> 4; t0 = (s2 & 15) * 16; T = 256; rowbase = ML + b * 256; }
        const int blk = bg * 8 + (w.lane >> 3), c8 = (w.lane & 7) * 8;
        if (blk < 20) {
            int zcol, pcol; float cw[5][8], bias[8];
            if (blk < 12) { const int c = blk * 64 + c8; zcol = 768 + c; pcol = c;
#pragma unroll
                for (int k = 0; k < 5; ++k) { const f32x4 w0 = *(const f32x4*)(a.in[I_GDN_CW] + (size_t)(l * 5 + k) * 768 + c), w1 = *(const f32x4*)(a.in[I_GDN_CW] + (size_t)(l * 5 + k) * 768 + c + 4);
#pragma unroll
                    for (int i = 0; i < 4; ++i) { cw[k][i] = w0[i]; cw[k][4 + i] = w1[i]; } }
#pragma unroll
                for (int i = 0; i < 8; ++i) bias[i] = 0.f; }
            else { const int c = (blk - 12) * 64 + c8; zcol = 2048 + c; pcol = 768 + c;
#pragma unroll
                for (int k = 0; k < 5; ++k) { const f32x4 w0 = *(const f32x4*)(a.in[I_SSD_CW] + (size_t)(l * 5 + k) * 512 + c), w1 = *(const f32x4*)(a.in[I_SSD_CW] + (size_t)(l * 5 + k) * 512 + c + 4);
#pragma unroll
                    for (int i = 0; i < 4; ++i) { cw[k][i] = w0[i]; cw[k][4 + i] = w1[i]; } }
                const f32x4 b0 = *(const f32x4*)(a.in[I_SSD_CB] + l * 512 + c), b1 = *(const f32x4*)(a.in[I_SSD_CB] + l * 512 + c + 4);
#pragma unroll
                for (int i = 0; i < 4; ++i) { bias[i] = b0[i]; bias[4 + i] = b1[i]; } }
            const bf16* zp = ZB + (size_t)rowbase * NZB + zcol;
            v4u raw[20];
#pragma unroll
            for (int r = 0; r < 20; ++r) { const int t = t0 - 2 + r; raw[r] = (t >= 0 && t < T) ? *(const v4u*)(zp + (size_t)t * NZB) : (v4u){0u, 0u, 0u, 0u}; }
#pragma unroll
            for (int i = 0; i < 16; ++i) {
                float y[8];
#pragma unroll
                for (int q = 0; q < 8; ++q) y[q] = bias[q];
#pragma unroll
                for (int k = 0; k < 5; ++k) { const v4u rr = raw[i + k]; const unsigned uu[4] = {rr.x, rr.y, rr.z, rr.w};
#pragma unroll
                    for (int q = 0; q < 4; ++q) { y[2 * q] += cw[k][2 * q] * bf2f(uu[q] & 0xffffu); y[2 * q + 1] += cw[k][2 * q + 1] * bf2f(uu[q] >> 16); } }
                float ss = 0.f;
#pragma unroll
                for (int q = 0; q < 8; ++q) { y[q] = y[q] * sigmoid_fast(y[q]); ss += y[q] * y[q]; }
                if (blk < 8) { ss += dpp_xor1(ss); ss += dpp_xor2(ss); ss += __shfl_xor(ss, 4); float r = __builtin_amdgcn_rsqf(ss + LN_EPS); if (blk < 4) r *= 0.125f;
#pragma unroll
                    for (int q = 0; q < 8; ++q) y[q] *= r; }
                v4u o; o.x = cvt_pk_bf16(y[0], y[1]); o.y = cvt_pk_bf16(y[2], y[3]); o.z = cvt_pk_bf16(y[4], y[5]); o.w = cvt_pk_bf16(y[6], y[7]);
                *(v4u*)(PB + (size_t)(rowbase + t0 + i) * NPB + pcol) = o;
            }
        }
    }
}

__device__ __forceinline__ float red4(float x) { x += dpp_xor1(x); x += dpp_xor2(x); return x; }
__device__ __forceinline__ void phase_scan(const Args& a, LAS unsigned char* lds, const WCtx& w, int l) {
    LAS float* Qs = (LAS float*)lds; LAS float* Ks = Qs + 4096; LAS float* Dd = Qs + 8192; LAS float* Vs = Qs + 12288; LAS float* As = Qs + 16384; LAS float* Bs = As + 64;
    LAS bf16* Os = (LAS bf16*)(lds + 66048);
    const bf16* ZB = (const bf16*)(a.ws + WS_ZB); const float* ZF = (const float*)(a.ws + WS_ZF); const bf16* PB = (const bf16*)(a.ws + WS_PB); bf16* SO = (bf16*)(a.ws + WS_SO);
    const int sdir = w.tid >> 8, sr = (w.tid & 255) >> 3, c0 = (w.tid & 7) * 8;
    const int cdir = w.wave >> 2, eg = w.wave & 3, el = w.lane >> 2, dq = w.lane & 3;
    for (int pi = w.bid; pi < 192; pi += w.G) {
        const int mix = pi >> 6, b = (pi & 63) >> 2, h = pi & 3;
        float lbv[8]; float alog = 0.f, dtb = 0.f;
#pragma unroll
        for (int i = 0; i < 8; ++i) lbv[i] = 0.f;
        if (mix == 0) {
#pragma unroll
            for (int i = 0; i < 8; ++i) lbv[i] = ((const float*)(a.ws + WS_LB))[(sdir * 4 + l) * 256 + h * 64 + c0 + i]; }
        else if (mix == 1) { alog = expf(a.in[I_GDN_ALOG][(l * 2 + sdir) * 4 + h]); dtb = a.in[I_GDN_DTB][(l * 2 + sdir) * 4 + h]; }
        else { alog = expf(a.in[I_SSD_ALOG][(l * 2 + sdir) * 4 + h]); dtb = a.in[I_SSD_DTB][(l * 2 + sdir) * 4 + h]; }
        float S[16];
#pragma unroll
        for (int i = 0; i < 16; ++i) S[i] = 0.f;
        v4u rA, rB, rC; f32x4 rF0, rF1; float rs0 = 0.f, rs1 = 0.f;
        rA = rB = rC = (v4u){0u, 0u, 0u, 0u}; rF0 = rF1 = (f32x4){0.f, 0.f, 0.f, 0.f};
#define SCAN_ROW(dir_, sg_) (((sg_) < 256) ? (ML + b * 256 + ((dir_) ? 255 - (sg_) : (sg_))) : (b * 2048 + ((dir_) ? 2047 - ((sg_) - 256) : ((sg_) - 256))))
#define SCAN_LOAD(tb_) do { const int row_ = SCAN_ROW(sdir, (tb_) * 32 + sr); \
            if (mix == 0) { rA = *(const v4u*)(ZB + (size_t)row_ * NZB + h * 64 + c0); rC = *(const v4u*)(ZB + (size_t)row_ * NZB + 256 + h * 64 + c0); \
                            rF0 = *(const f32x4*)(ZF + (size_t)row_ * NZF + sdir * 256 + h * 64 + c0); rF1 = *(const f32x4*)(ZF + (size_t)row_ * NZF + sdir * 256 + h * 64 + c0 + 4); } \
            else if (mix == 1) { rA = *(const v4u*)(PB + (size_t)row_ * NPB + h * 64 + c0); rB = *(const v4u*)(PB + (size_t)row_ * NPB + 256 + h * 64 + c0); rC = *(const v4u*)(PB + (size_t)row_ * NPB + 512 + h * 64 + c0); \
                            rs0 = ZF[(size_t)row_ * NZF + 512 + sdir * 4 + h]; rs1 = ZF[(size_t)row_ * NZF + 520 + sdir * 4 + h]; } \
            else { rA = *(const v4u*)(PB + (size_t)row_ * NPB + 768 + 384 + (h >> 1) * 64 + c0); rB = *(const v4u*)(PB + (size_t)row_ * NPB + 768 + 256 + (h >> 1) * 64 + c0); rC = *(const v4u*)(PB + (size_t)row_ * NPB + 768 + h * 64 + c0); \
                            rs0 = ZF[(size_t)row_ * NZF + 528 + sdir * 4 + h]; } } while (0)
#define SCAN_STORE() do { const int o_ = (sdir * 32 + sr) * 64 + c0; float qa[8], ka[8], va[8], da[8]; \
            const unsigned ua[4] = {rA.x, rA.y, rA.z, rA.w}, ub[4] = {rB.x, rB.y, rB.z, rB.w}, uc[4] = {rC.x, rC.y, rC.z, rC.w}; \
            _Pragma("unroll") for (int i_ = 0; i_ < 4; ++i_) { qa[2 * i_] = bf2f(ua[i_] & 0xffffu); qa[2 * i_ + 1] = bf2f(ua[i_] >> 16); ka[2 * i_] = bf2f(ub[i_] & 0xffffu); ka[2 * i_ + 1] = bf2f(ub[i_] >> 16); \
                va[2 * i_] = bf2f(uc[i_] & 0xffffu); va[2 * i_ + 1] = bf2f(uc[i_] >> 16); } \
            if (mix == 0) { const float zf_[8] = {rF0[0], rF0[1], rF0[2], rF0[3], rF1[0], rF1[1], rF1[2], rF1[3]}; \
                _Pragma("unroll") for (int i_ = 0; i_ < 8; ++i_) { const float sg_ = sigmoid_acc(zf_[i_]); da[i_] = lbv[i_] + (1.0f - lbv[i_]) * sg_; ka[i_] = (1.0f - lbv[i_]) * (1.0f - sg_); qa[i_] = silu_acc(qa[i_]); } \
                if (c0 == 0) { As[sdir * 32 + sr] = 0.f; Bs[sdir * 32 + sr] = 0.f; } } \
            else if (mix == 1) { const float av_ = expf(-alog * softplus_acc(rs0 + dtb)); _Pragma("unroll") for (int i_ = 0; i_ < 8; ++i_) da[i_] = av_; \
                if (c0 == 0) { As[sdir * 32 + sr] = av_; Bs[sdir * 32 + sr] = sigmoid_acc(rs1); } } \
            else { const float dt_ = softplus_acc(rs0 + dtb); const float av_ = expf(-alog * dt_); _Pragma("unroll") for (int i_ = 0; i_ < 8; ++i_) { da[i_] = av_; va[i_] *= dt_; } \
                if (c0 == 0) { As[sdir * 32 + sr] = av_; Bs[sdir * 32 + sr] = 0.f; } } \
            *(LAS f32x4*)(Qs + o_) = (f32x4){qa[0], qa[1], qa[2], qa[3]}; *(LAS f32x4*)(Qs + o_ + 4) = (f32x4){qa[4], qa[5], qa[6], qa[7]}; \
            *(LAS f32x4*)(Ks + o_) = (f32x4){ka[0], ka[1], ka[2], ka[3]}; *(LAS f32x4*)(Ks + o_ + 4) = (f32x4){ka[4], ka[5], ka[6], ka[7]}; \
            *(LAS f32x4*)(Dd + o_) = (f32x4){da[0], da[1], da[2], da[3]}; *(LAS f32x4*)(Dd + o_ + 4) = (f32x4){da[4], da[5], da[6], da[7]}; \
            *(LAS f32x4*)(Vs + o_) = (f32x4){va[0], va[1], va[2], va[3]}; *(LAS f32x4*)(Vs + o_ + 4) = (f32x4){va[4], va[5], va[6], va[7]}; } while (0)
        SCAN_LOAD(0); SCAN_STORE(); __syncthreads();
        for (int tb = 0; tb < 72; ++tb) {
            if (tb + 1 < 72) SCAN_LOAD(tb + 1);
#pragma unroll 2
            for (int s = 0; s < 32; ++s) {
                const int base = (cdir * 32 + s) * 64 + dq * 16;
                f32x4 q4[4], k4[4];
#pragma unroll
                for (int i = 0; i < 4; ++i) { q4[i] = *(const LAS f32x4*)(Qs + base + 4 * i); k4[i] = *(const LAS f32x4*)(Ks + base + 4 * i); }
                float vv = Vs[(cdir * 32 + s) * 64 + eg * 16 + el];
                const float av = As[cdir * 32 + s];
                float o0 = 0.f, o1 = 0.f, o2 = 0.f, o3 = 0.f;
                if (mix == 0) {
                    f32x4 d4[4];
#pragma unroll
                    for (int i = 0; i < 4; ++i) d4[i] = *(const LAS f32x4*)(Dd + base + 4 * i);
#pragma unroll
                    for (int i = 0; i < 4; ++i) {
                        S[4 * i + 0] = d4[i][0] * S[4 * i + 0] + k4[i][0] * vv; o0 += q4[i][0] * S[4 * i + 0];
                        S[4 * i + 1] = d4[i][1] * S[4 * i + 1] + k4[i][1] * vv; o1 += q4[i][1] * S[4 * i + 1];
                        S[4 * i + 2] = d4[i][2] * S[4 * i + 2] + k4[i][2] * vv; o2 += q4[i][2] * S[4 * i + 2];
                        S[4 * i + 3] = d4[i][3] * S[4 * i + 3] + k4[i][3] * vv; o3 += q4[i][3] * S[4 * i + 3]; }
                } else {
                    if (mix == 1) { const float be = Bs[cdir * 32 + s]; float k0 = 0.f, k1 = 0.f, k2 = 0.f, k3 = 0.f;
#pragma unroll
                        for (int i = 0; i < 4; ++i) { k0 += k4[i][0] * S[4 * i + 0]; k1 += k4[i][1] * S[4 * i + 1]; k2 += k4[i][2] * S[4 * i + 2]; k3 += k4[i][3] * S[4 * i + 3]; }
                        const float ks = red4((k0 + k1) + (k2 + k3)); vv = be * (vv - av * ks); }
#pragma unroll
                    for (int i = 0; i < 4; ++i) {
                        S[4 * i + 0] = av * S[4 * i + 0] + k4[i][0] * vv; o0 += q4[i][0] * S[4 * i + 0];
                        S[4 * i + 1] = av * S[4 * i + 1] + k4[i][1] * vv; o1 += q4[i][1] * S[4 * i + 1];
                        S[4 * i + 2] = av * S[4 * i + 2] + k4[i][2] * vv; o2 += q4[i][2] * S[4 * i + 2];
                        S[4 * i + 3] = av * S[4 * i + 3] + k4[i][3] * vv; o3 += q4[i][3] * S[4 * i + 3]; }
                }
                const float o = red4((o0 + o1) + (o2 + o3));
                if (dq == 0) Os[(w.wave * 32 + s) * 16 + el] = (bf16)f2bf(o);
            }
            LDS_WAIT();
            { const int r = w.lane >> 1, hf = w.lane & 1; const int row = SCAN_ROW(cdir, tb * 32 + r);
              const v4u ov = *(const LAS v4u*)(Os + (w.wave * 32 + r) * 16 + hf * 8);
              *(v4u*)(SO + ((size_t)(mix * 2 + cdir) * MT + row) * 256 + h * 64 + eg * 16 + hf * 8) = ov; }
            __syncthreads();
            if (tb + 1 < 72) SCAN_STORE();
            __syncthreads();
        }
#undef SCAN_ROW
#undef SCAN_LOAD
#undef SCAN_STORE
    }
}

__device__ __forceinline__ f32x4 silu4(f32x4 x) { return (f32x4){silu_acc(x[0]), silu_acc(x[1]), silu_acc(x[2]), silu_acc(x[3])}; }
__device__ __forceinline__ f32x4 silu4f(f32x4 x) { return (f32x4){x[0] * sigmoid_fast(x[0]), x[1] * sigmoid_fast(x[1]), x[2] * sigmoid_fast(x[2]), x[3] * sigmoid_fast(x[3])}; }
__device__ __forceinline__ f32x4 bf4(v2u u) { return (f32x4){bf2f(u.x & 0xffffu), bf2f(u.x >> 16), bf2f(u.y & 0xffffu), bf2f(u.y >> 16)}; }
struct FinRow { v2u so[6], zg[3], px; f32x4 fo0, fo1; };
__device__ __forceinline__ void fin_load(FinRow& R, const bf16* ZB, const bf16* PB, const bf16* SO, const float* FO, int row, int ch) {
#pragma unroll
    for (int k = 0; k < 6; ++k) R.so[k] = *(const v2u*)(SO + ((size_t)k * MT + row) * 256 + ch);
    R.zg[0] = *(const v2u*)(ZB + (size_t)row * NZB + 512 + ch); R.zg[1] = *(const v2u*)(ZB + (size_t)row * NZB + 1536 + ch); R.zg[2] = *(const v2u*)(ZB + (size_t)row * NZB + 2560 + ch);
    R.px = *(const v2u*)(PB + (size_t)row * NPB + 768 + ch);
    R.fo0 = *(const f32x4*)(FO + (size_t)row * 256 + ch); R.fo1 = (f32x4){0.f, 0.f, 0.f, 0.f};
}
__device__ __forceinline__ void phase_finish(const Args& a, const WCtx& w, int l, int nrows) {
    const bf16* ZB = (const bf16*)(a.ws + WS_ZB); const bf16* PB = (const bf16*)(a.ws + WS_PB); const bf16* SO = (const bf16*)(a.ws + WS_SO); const float* FO = (const float*)(a.ws + WS_FO);
    bf16* OUTS = (bf16*)(a.ws + WS_OUTS);
    const int ch = 4 * w.lane, hd = w.lane >> 4;
    const f32x4 nwa = *(const f32x4*)(a.in[I_HGRN_NW] + l * 256 + ch), nwb = *(const f32x4*)(a.in[I_GDN_NW] + l * 256 + ch), nwd = *(const f32x4*)(a.in[I_SSD_NW] + l * 256 + ch);
    const float dsk = a.in[I_SSD_D][l * 4 + hd];
    int row = w.gw; FinRow R, Rn;
    if (row < nrows) fin_load(R, ZB, PB, SO, FO, row, ch);
    while (row < nrows) {
        const int nrow = row + w.NGW;
        if (nrow < nrows) fin_load(Rn, ZB, PB, SO, FO, nrow, ch);
        asm volatile("" ::: "memory");
        bf16* orow = OUTS + (size_t)row * 1024 + ch;
        { f32x4 o = bf4(R.so[0]) + bf4(R.so[1]);
          float ss = (o[0] * o[0] + o[1] * o[1]) + (o[2] * o[2] + o[3] * o[3]); ss += dpp_xor1(ss); ss += dpp_xor2(ss); ss += __shfl_xor(ss, 4); ss += __shfl_xor(ss, 8);
          const float r = __builtin_amdgcn_rsqf(ss * (1.f / 64.f) + LN_EPS); st_bf4(orow, o * r * nwa * silu4f(bf4(R.zg[0]))); }
        { f32x4 o = bf4(R.so[2]) + bf4(R.so[3]);
          float ss = (o[0] * o[0] + o[1] * o[1]) + (o[2] * o[2] + o[3] * o[3]); ss += dpp_xor1(ss); ss += dpp_xor2(ss); ss += __shfl_xor(ss, 4); ss += __shfl_xor(ss, 8);
          const float r = __builtin_amdgcn_rsqf(ss * (1.f / 64.f) + LN_EPS); st_bf4(orow + 256, o * r * nwb * silu4f(bf4(R.zg[1]))); }
        st_bf4(orow + 512, R.fo0 + R.fo1);
        { f32x4 o = bf4(R.so[4]) + bf4(R.so[5]); f32x4 y = (o + bf4(R.px) * dsk) * silu4f(bf4(R.zg[2]));
          const float ss = wave_sum((y[0] * y[0] + y[1] * y[1]) + (y[2] * y[2] + y[3] * y[3]));
          const float r = __builtin_amdgcn_rsqf(ss * (1.f / 256.f) + LN_EPS); st_bf4(orow + 768, y * r * nwd); }
        R = Rn; row = nrow;
    }
}

__device__ __forceinline__ int row_batch(int row) { return row < ML ? (row >> 11) : 16; }
__device__ __forceinline__ void phase_ln1(const Args& a, LAS unsigned char* lds, const WCtx& w, int l, int nrows) {
    LAS float* WRT = (LAS float*)lds;
    LAS float* LNG = WRT + 16384; LAS float* LNB = LNG + 1024; LAS float* BV = LNB + 1024;
    const int rpb = (nrows + w.G - 1) / w.G, r0 = w.bid * rpb, r1 = (r0 + rpb < nrows) ? r0 + rpb : nrows;
    const int b_lo = row_batch(r0 < nrows ? r0 : 0), b_hi = row_batch(r1 > r0 ? r1 - 1 : 0);
    for (int i = w.tid; i < 16384; i += NTHREADS) { const int d = i >> 4, e = i & 15; WRT[e * 1024 + d] = a.in[I_WROUTER][(size_t)l * 16384 + i]; }
    for (int i = w.tid; i < 1024; i += NTHREADS) { LNG[i] = a.in[I_LN1G][l * 1024 + i]; LNB[i] = a.in[I_LN1B][l * 1024 + i];
#pragma unroll
        for (int s = 0; s < 2; ++s) { const float* mp = (const float*)(a.ws + WS_MOD) + (size_t)(l * 17 + (s ? b_hi : b_lo)) * 6144;
            BV[(s * 3 + 0) * 1024 + i] = mp[2048 + i]; BV[(s * 3 + 1) * 1024 + i] = mp[3072 + i]; BV[(s * 3 + 2) * 1024 + i] = mp[4096 + i]; } }
    __syncthreads();
    float* X = (float*)(a.ws + WS_X); const bf16* Y = (const bf16*)(a.ws + WS_Y); bf16* H = (bf16*)(a.ws + WS_H); float* AFF = (float*)(a.ws + WS_AFF);
    int row = r0 + w.wave;
    f32x4 x[4]; v2u yb[4];
#pragma unroll
    for (int j = 0; j < 4; ++j) { x[j] = (f32x4){0.f, 0.f, 0.f, 0.f}; yb[j] = (v2u){0u, 0u}; }
    if (row < r1) { row_load(X + (size_t)row * 1024, w.lane, x);
#pragma unroll
        for (int j = 0; j < 4; ++j) yb[j] = *((const v2u*)(Y + (size_t)row * 1024) + w.lane + 64 * j); }
    while (row < r1) {
        const int nrow = row + NWAVES; f32x4 xn[4]; v2u ybn[4];
#pragma unroll
        for (int j = 0; j < 4; ++j) { xn[j] = (f32x4){0.f, 0.f, 0.f, 0.f}; ybn[j] = (v2u){0u, 0u}; }
        if (nrow < r1) { row_load(X + (size_t)nrow * 1024, w.lane, xn);
#pragma unroll
            for (int j = 0; j < 4; ++j) ybn[j] = *((const v2u*)(Y + (size_t)nrow * 1024) + w.lane + 64 * j); }
        asm volatile("" ::: "memory");
        const LAS float* bv = BV + ((row_batch(row) != b_lo) ? 3 * 1024 : 0);
        f32x4 hv[4];
#pragma unroll
        for (int j = 0; j < 4; ++j) { const f32x4 g1 = *(const LAS f32x4*)(bv + 4 * w.lane + 256 * j);
            const f32x4 yv = (f32x4){bf2f(yb[j].x & 0xffffu), bf2f(yb[j].x >> 16), bf2f(yb[j].y & 0xffffu), bf2f(yb[j].y >> 16)};
            x[j] = x[j] * ALPHA + g1 * yv; }
        float mean, rstd; ln_stats(x, mean, rstd);
#pragma unroll
        for (int j = 0; j < 4; ++j) x[j] = (x[j] - mean) * rstd * *(const LAS f32x4*)(LNG + 4 * w.lane + 256 * j) + *(const LAS f32x4*)(LNB + 4 * w.lane + 256 * j);
        row_store(X + (size_t)row * 1024, w.lane, x);
        ln_stats(x, mean, rstd);
        { unsigned* hrow = (unsigned*)((unsigned char*)H + (size_t)row * 1024);
#pragma unroll
          for (int j = 0; j < 4; ++j) { const f32x4 sh = *(const LAS f32x4*)(bv + 1024 + 4 * w.lane + 256 * j), sc = *(const LAS f32x4*)(bv + 2048 + 4 * w.lane + 256 * j);
              hv[j] = (x[j] - mean) * rstd * (sc + 1.0f) + sh;
              hrow[w.lane + 64 * j] = pk4_fp8(fminf(fmaxf(hv[j][0], -448.f), 448.f), fminf(fmaxf(hv[j][1], -448.f), 448.f), fminf(fmaxf(hv[j][2], -448.f), 448.f), fminf(fmaxf(hv[j][3], -448.f), 448.f)); } }
        float pe[16];
#pragma unroll
        for (int e = 0; e < 16; ++e) { float p = 0.f;
#pragma unroll
            for (int j = 0; j < 4; ++j) { const f32x4 wv = *(const LAS f32x4*)(WRT + e * 1024 + 256 * j + 4 * w.lane); p += (hv[j][0] * wv[0] + hv[j][1] * wv[1]) + (hv[j][2] * wv[2] + hv[j][3] * wv[3]); }
            pe[e] = p; }
        float q8[8], q4[4], q2[2];
#pragma unroll
        for (int k = 0; k < 8; ++k) q8[k] = swap32_add(pe[k], pe[k + 8]);
#pragma unroll
        for (int k = 0; k < 4; ++k) q4[k] = swap16_add(q8[k], q8[k + 4]);
        { const bool hi = (w.lane & 8) != 0;
#pragma unroll
          for (int k = 0; k < 2; ++k) { const float mine = hi ? q4[k + 2] : q4[k], oth = hi ? q4[k] : q4[k + 2]; q2[k] = mine + dpp_x8(oth); } }
        float lg;
        { const bool hi = (w.lane & 4) != 0; const float mine = hi ? q2[1] : q2[0], oth = hi ? q2[0] : q2[1]; lg = mine + dpp_x4(oth); }
        lg += dpp_xor1(lg); lg += dpp_xor2(lg);
        float mx = lg;
        mx = fmaxf(mx, dpp_x4(mx)); mx = fmaxf(mx, dpp_x8(mx)); mx = swap16_max(mx); mx = swap32_max(mx);
        const float ex = __expf(lg - mx); float s = ex;
        s += dpp_x4(s); s += dpp_x8(s); s = swap16_add(s, s); s = swap32_add(s, s);
        if ((w.lane & 3) == 0) AFF[(size_t)row * 16 + (w.lane >> 2)] = ex / s;
#pragma unroll
        for (int j = 0; j < 4; ++j) { x[j] = xn[j]; yb[j] = ybn[j]; }
        row = nrow;
    }
}

__device__ __forceinline__ void phase_topk(const Args& a, LAS unsigned char* lds, const WCtx& w, int nitems) {
    LAS int* CNT = (LAS int*)lds;
    LAS int* WS1 = CNT + 16;
    LAS int* WS2 = WS1 + 8;
    LAS int* SEL = WS2 + 8;
    LAS int* SELW = SEL + 256;
    const float* AFF = (const float*)(a.ws + WS_AFF); int* SLOT = (int*)(a.ws + WS_SLOT); float* ROWW = (float*)(a.ws + WS_ROWW);
    int* SELROW = (int*)(a.ws + WS_ROWW + 512 * 1024);
    for (int it2 = w.gw; it2 < nitems - 256; it2 += w.NGW) {
        const int b = it2 >> 4, e = it2 & 15, rowbase = ML + b * 256, xebase = 65536 + e * 512 + b * 32;
        unsigned key[4];
#pragma unroll
        for (int j = 0; j < 4; ++j) key[j] = __float_as_uint(AFF[(size_t)(rowbase + w.lane * 4 + j) * 16 + e]);
        unsigned T = 0u;
        for (int bit = 29; bit >= 0; --bit) { const unsigned trial = T | (1u << bit); int tot = 0;
#pragma unroll
            for (int j = 0; j < 4; ++j) tot += __popcll(__ballot(key[j] >= trial));
            if (tot >= CAP_C) T = trial; }
        int ngt = 0, ceq = 0;
#pragma unroll
        for (int j = 0; j < 4; ++j) { ngt += (key[j] > T) ? 1 : 0; ceq += (key[j] == T) ? 1 : 0; }
        int xg = ngt, xq = ceq;
#pragma unroll
        for (int o = 1; o < 64; o <<= 1) { const int yg = __shfl_up(xg, o), yq = __shfl_up(xq, o); if (w.lane >= o) { xg += yg; xq += yq; } }
        const int need_eq = CAP_C - __shfl(xg, 63); int eqrank = xq - ceq;
        int sel[4], csel = 0;
#pragma unroll
        for (int j = 0; j < 4; ++j) { const bool iseq = key[j] == T; sel[j] = (key[j] > T) || (iseq && eqrank < need_eq); if (iseq) ++eqrank; csel += sel[j]; }
        int xs = csel;
#pragma unroll
        for (int o = 1; o < 64; o <<= 1) { const int ys = __shfl_up(xs, o); if (w.lane >= o) xs += ys; }
        int slot = xs - csel;
#pragma unroll
        for (int j = 0; j < 4; ++j) { const int t = w.lane * 4 + j; int sv = -1; if (sel[j] && slot < CAP_C) { sv = slot; ROWW[xebase + slot] = __uint_as_float(key[j]); ++slot; }
            SLOT[(size_t)(rowbase + t) * 16 + e] = sv;
            if (sv >= 0) SELW[w.wave * 32 + sv] = t; }
        LDS_WAIT();
        if (w.lane < CAP_C) SELROW[xebase + w.lane] = rowbase + SELW[w.wave * 32 + w.lane];
        LDS_WAIT();
    }
    __syncthreads();
    for (int item = w.bid; item < (nitems < 256 ? nitems : 256); item += w.G) {
        int b, e, n, cap, rowbase, xebase;
        if (item < 256) { b = item >> 4; e = item & 15; n = 2048; cap = CAP_L; rowbase = b * 2048; xebase = e * 4096 + b * 256; }
        else { const int it2 = item - 256; b = it2 >> 4; e = it2 & 15; n = 256; cap = CAP_C; rowbase = ML + b * 256; xebase = 65536 + e * 512 + b * 32; }
        unsigned key[4];
#pragma unroll
        for (int j = 0; j < 4; ++j) { const int t = w.tid * 4 + j; key[j] = t < n ? __float_as_uint(AFF[(size_t)(rowbase + t) * 16 + e]) : 0u; }
        unsigned T = 0u;
        for (int bit = 29; bit >= 0; --bit) {
            const unsigned trial = T | (1u << bit); int c = 0;
#pragma unroll
            for (int j = 0; j < 4; ++j) c += (key[j] >= trial) ? 1 : 0;
#pragma unroll
            for (int o = 1; o < 64; o <<= 1) c += __shfl_xor(c, o);
            LAS int* cb = CNT + (bit & 1) * 8;
            if (w.lane == 0) cb[w.wave] = c;
            __syncthreads();
            int tot = 0;
#pragma unroll
            for (int q = 0; q < 8; ++q) tot += cb[q];
            if (tot >= cap) T = trial;
        }
        int ngt = 0, ceq = 0;
#pragma unroll
        for (int j = 0; j < 4; ++j) { ngt += (key[j] > T) ? 1 : 0; ceq += (key[j] == T && key[j] != 0u) ? 1 : 0; }
        int xg = ngt, xe = ceq;
#pragma unroll
        for (int o = 1; o < 64; o <<= 1) { const int yg = __shfl_up(xg, o), ye = __shfl_up(xe, o); if (w.lane >= o) { xg += yg; xe += ye; } }
        __syncthreads();
        if (w.lane == 63) { WS1[w.wave] = xg; WS2[w.wave] = xe; }
        __syncthreads();
        int totg = 0, offe = 0;
#pragma unroll
        for (int q = 0; q < 8; ++q) { totg += WS1[q]; if (q < w.wave) offe += WS2[q]; }
        const int need_eq = cap - totg; int eqrank = offe + xe - ceq;
        int sel[4], csel = 0;
#pragma unroll
        for (int j = 0; j < 4; ++j) { const bool iseq = (key[j] == T && key[j] != 0u); sel[j] = (key[j] > T) || (iseq && eqrank < need_eq); if (iseq) ++eqrank; csel += sel[j]; }
        int xs = csel;
#pragma unroll
        for (int o = 1; o < 64; o <<= 1) { const int ys = __shfl_up(xs, o); if (w.lane >= o) xs += ys; }
        __syncthreads();
        if (w.lane == 63) WS1[w.wave] = xs;
        __syncthreads();
        int offs = 0;
#pragma unroll
        for (int q = 0; q < 8; ++q) if (q < w.wave) offs += WS1[q];
        int slot = offs + xs - csel;
#pragma unroll
        for (int j = 0; j < 4; ++j) { const int t = w.tid * 4 + j; if (t < n) { int sv = -1; if (sel[j]) { sv = slot; if (slot < cap) { SEL[slot] = t; ROWW[xebase + slot] = __uint_as_float(key[j]); } ++slot; }
                SLOT[(size_t)(rowbase + t) * 16 + e] = (sv < cap) ? sv : -1; } }
        __syncthreads();
        for (int s = w.tid; s < cap; s += NTHREADS) SELROW[xebase + s] = rowbase + SEL[s];
        __syncthreads();
    }
}

__device__ __forceinline__ void phase_ln2(const Args& a, LAS unsigned char* lds, const WCtx& w, int l, int nrows) {
    LAS float* LNG = (LAS float*)lds; LAS float* LNB = LNG + 1024; LAS float* BV = LNB + 1024;
    const int rpb = (nrows + w.G - 1) / w.G, r0 = w.bid * rpb, r1 = (r0 + rpb < nrows) ? r0 + rpb : nrows;
    const int b_lo = row_batch(r0 < nrows ? r0 : 0), b_hi = row_batch(r1 > r0 ? r1 - 1 : 0);
    const int ln = (l + 1 < DEPTH) ? l + 1 : l;
    for (int i = w.tid; i < 1024; i += NTHREADS) { LNG[i] = a.in[I_LN2G][l * 1024 + i]; LNB[i] = a.in[I_LN2B][l * 1024 + i];
#pragma unroll
        for (int s = 0; s < 2; ++s) { const int bb = s ? b_hi : b_lo; const float* mp = (const float*)(a.ws + WS_MOD) + (size_t)(l * 17 + bb) * 6144; const float* mn = (const float*)(a.ws + WS_MOD) + (size_t)(ln * 17 + bb) * 6144;
            BV[(s * 3 + 0) * 1024 + i] = mp[5120 + i]; BV[(s * 3 + 1) * 1024 + i] = mn[i]; BV[(s * 3 + 2) * 1024 + i] = mn[1024 + i]; } }
    __syncthreads();
    float* X = (float*)(a.ws + WS_X); bf16* H = (bf16*)(a.ws + WS_H); const unsigned char* YE = (const unsigned char*)(a.ws + WS_YE);   const int* SLOT = (const int*)(a.ws + WS_SLOT);
    int row = r0 + w.wave;
    f32x4 x[4]; int myslot = -1;
#pragma unroll
    for (int j = 0; j < 4; ++j) x[j] = (f32x4){0.f, 0.f, 0.f, 0.f};
    if (row < r1) { row_load(X + (size_t)row * 1024, w.lane, x); myslot = SLOT[(size_t)row * 16 + (w.lane & 15)]; }
    while (row < r1) {
        const int nrow = row + NWAVES; f32x4 xn[4]; int nslot = -1;
#pragma unroll
        for (int j = 0; j < 4; ++j) xn[j] = (f32x4){0.f, 0.f, 0.f, 0.f};
        f32x4 mo[4];
#pragma unroll
        for (int j = 0; j < 4; ++j) mo[j] = (f32x4){0.f, 0.f, 0.f, 0.f};
        const int b = row < ML ? (row >> 11) : ((row - ML) >> 8);
        unsigned m = (unsigned)(__ballot(myslot >= 0) & 0xFFFFull);
        while (m) {
            unsigned t[4][4];
#pragma unroll
            for (int k = 0; k < 4; ++k) {
#pragma unroll
                for (int j = 0; j < 4; ++j) t[k][j] = 0u;
                if (m) { const int e = __builtin_ctz(m); m &= m - 1u; const int s = __shfl(myslot, e);
                    const size_t xr = row < ML ? (size_t)(e * 4096 + b * 256 + s) : (size_t)(65536 + e * 512 + b * 32 + s); const unsigned* yr = (const unsigned*)(YE + xr * 1024) + w.lane;
#pragma unroll
                    for (int j = 0; j < 4; ++j) t[k][j] = yr[64 * j]; } }
#pragma unroll
            for (int k = 0; k < 4; ++k)
#pragma unroll
                for (int j = 0; j < 4; ++j) { const f32x2 lo = __builtin_amdgcn_cvt_pk_f32_fp8((int)t[k][j], false), hi = __builtin_amdgcn_cvt_pk_f32_fp8((int)t[k][j], true); mo[j][0] += lo[0]; mo[j][1] += lo[1]; mo[j][2] += hi[0]; mo[j][3] += hi[1]; }
        }
#pragma unroll
        for (int j = 0; j < 4; ++j) mo[j] = mo[j] * (1.0f / 64.0f);
        if (nrow < r1) { row_load(X + (size_t)nrow * 1024, w.lane, xn); nslot = SLOT[(size_t)nrow * 16 + (w.lane & 15)]; }
        asm volatile("" ::: "memory");
        const LAS float* bv = BV + ((row_batch(row) != b_lo) ? 3 * 1024 : 0);
#pragma unroll
        for (int j = 0; j < 4; ++j) x[j] = x[j] * ALPHA + *(const LAS f32x4*)(bv + 4 * w.lane + 256 * j) * mo[j];
        float mean, rstd; ln_stats(x, mean, rstd);
#pragma unroll
        for (int j = 0; j < 4; ++j) x[j] = (x[j] - mean) * rstd * *(const LAS f32x4*)(LNG + 4 * w.lane + 256 * j) + *(const LAS f32x4*)(LNB + 4 * w.lane + 256 * j);
        if (l == DEPTH - 1) row_store(a.out + (size_t)row * 1024, w.lane, x);
        else { row_store(X + (size_t)row * 1024, w.lane, x);
            ln_stats(x, mean, rstd); bf16* hrow = H + (size_t)row * 1024;
#pragma unroll
            for (int j = 0; j < 4; ++j) { const f32x4 sh = *(const LAS f32x4*)(bv + 1024 + 4 * w.lane + 256 * j), sc = *(const LAS f32x4*)(bv + 2048 + 4 * w.lane + 256 * j);
                const f32x4 hv = (x[j] - mean) * rstd * (sc + 1.0f) + sh;
                v2u wv; wv.x = cvt_pk_bf16(hv[0], hv[1]); wv.y = cvt_pk_bf16(hv[2], hv[3]); *((v2u*)hrow + w.lane + 64 * j) = wv;
                ((unsigned*)(a.ws + WS_H8 + (size_t)row * 1024))[w.lane + 64 * j] = pk4c_fp8(hv); } }
#pragma unroll
        for (int j = 0; j < 4; ++j) x[j] = xn[j];
        myslot = nslot; row = nrow;
    }
}
typedef float f32x16 __attribute__((ext_vector_type(16)));
constexpr int TS = 72, TILE_BYTES = 64 * TS * 2;
constexpr int SCG_BYTES = 7 * TILE_BYTES + 2048;
constexpr size_t WS_UT = WS_R1 + 684 * MiB;
constexpr size_t WS_WW = WS_R1 + 720 * MiB;
__device__ __forceinline__ f32x16 mma64(f32x16 acc, const LAS bf16* A, const LAS bf16* BT, int lane) {
    const int r = lane & 31, h = lane >> 5;
    const LAS bf16* ap = A + r * TS + 8 * h; const LAS bf16* bp = BT + r * TS + 8 * h;
#pragma unroll
    for (int ks = 0; ks < 4; ++ks) { const bf16x8 av = *(const LAS bf16x8*)(ap + ks * 16), bv = *(const LAS bf16x8*)(bp + ks * 16); acc = __builtin_amdgcn_mfma_f32_32x32x16_bf16(av, bv, acc, 0, 0, 0); }
    return acc;
}
__device__ __forceinline__ int swz(int row, int col) { return row * TS + ((((col >> 3) ^ ((row >> 4) & 3)) << 3) | (col & 7)); }
template <bool SWA, bool SWB>
__device__ __forceinline__ f32x16 mma64s(f32x16 acc, const LAS bf16* A, int ablk, const LAS bf16* BT, int bblk, int lane) {
    const int r = lane & 31, h = lane >> 5;
    const int sa = SWA ? ((2 * ablk + (r >> 4)) & 3) : 0, sb = SWB ? ((2 * bblk + (r >> 4)) & 3) : 0;
    const LAS bf16* ap = A + (32 * ablk + r) * TS; const LAS bf16* bp = BT + (32 * bblk + r) * TS;
#pragma unroll
    for (int ks = 0; ks < 4; ++ks) { const bf16x8 av = *(const LAS bf16x8*)(ap + (((2 * ks + h) ^ sa) << 3)), bv = *(const LAS bf16x8*)(bp + (((2 * ks + h) ^ sb) << 3)); acc = __builtin_amdgcn_mfma_f32_32x32x16_bf16(av, bv, acc, 0, 0, 0); }
    return acc;
}
__device__ __forceinline__ f32x16 zero16() { f32x16 z;
#pragma unroll
    for (int i = 0; i < 16; ++i) z[i] = 0.f;
    return z; }
__device__ __forceinline__ int chain_row(int b, int dir, int c, int i) {
    if (c < 4) { const int p = 64 * c + i; return ML + b * 256 + (dir ? 255 - p : p); }
    const int p = 64 * (c - 4) + i; return b * 2048 + (dir ? 2047 - p : p);
}
__device__ __forceinline__ float expc(float x) { return __expf(fminf(x, 80.f)); }
__device__ __forceinline__ bf16 bfr(float x) { return (bf16)cvt_pk_bf16(x, x); }
__device__ __forceinline__ void st4bf(LAS bf16* p, float a, float b, float c, float d) { v2u w; w.x = cvt_pk_bf16(a, b); w.y = cvt_pk_bf16(c, d); *(LAS v2u*)p = w; }
__device__ __forceinline__ void unpack8(const v4u u, float (&f)[8]) { f[0] = bf2f(u.x & 0xffffu); f[1] = bf2f(u.x >> 16); f[2] = bf2f(u.y & 0xffffu); f[3] = bf2f(u.y >> 16); f[4] = bf2f(u.z & 0xffffu); f[5] = bf2f(u.z >> 16); f[6] = bf2f(u.w & 0xffffu); f[7] = bf2f(u.w >> 16); }
__device__ __forceinline__ void store_state_T(LAS bf16* TST, const f32x16& S, int wm, int wn, int r, int hh) {
#pragma unroll
    for (int q = 0; q < 4; ++q) st4bf(TST + (32 * wn + r) * TS + 32 * wm + 8 * q + 4 * hh, S[4 * q], S[4 * q + 1], S[4 * q + 2], S[4 * q + 3]);
}

constexpr int SOLVE_ITEM_BYTES = 33024;
__device__ __forceinline__ void solve_diag(float (&x)[64], const LAS float* AT, const int o, const int ja, const int jb) {
#pragma unroll
    for (int j = ja; j < jb; ++j) { const float xj = x[o + j];
        int z = 0; if (j >= 2) asm("" : "+v"(z) : "v"(x[o + j - 2]));
        const LAS float* ATj = AT + z;
#pragma unroll
        for (int i4 = ((j + 1) >> 2) << 2; i4 < 32; i4 += 4) { const f32x4 av = *(const LAS f32x4*)(ATj + j * 36 + i4);
#pragma unroll
            for (int t = 0; t < 4; ++t) if (i4 + t > j) x[o + i4 + t] -= av[t] * xj; } }
}
__device__ __forceinline__ void phase_gdn_solve(const Args& a, LAS unsigned char* lds, const WCtx& w, int l) {
    const int sub = w.wave >> 1, wv = w.wave & 1;
    LAS unsigned char* gb = lds + sub * SOLVE_ITEM_BYTES;
    LAS bf16* TK = (LAS bf16*)gb; LAS float* A11T = (LAS float*)(gb + 9216); LAS float* A22T = (LAS float*)(gb + 13824); LAS bf16* A21 = (LAS bf16*)(gb + 18432);
    LAS bf16* XT = (wv == 0) ? TK : (LAS bf16*)(gb + 23040); LAS float* G = (LAS float*)(gb + 32256); LAS float* BETA = G + 64;
    const bf16* PB = (const bf16*)(a.ws + WS_PB); const float* ZF = (const float*)(a.ws + WS_ZF);
    bf16* UT = (bf16*)(a.ws + WS_UT); bf16* WW = (bf16*)(a.ws + WS_WW);
    const int rounds = (128 * 36 + 4 * w.G - 1) / (4 * w.G);
    for (int k = 0; k < rounds; ++k) {
        int tl_ = w.tid; asm volatile("" : "+v"(tl_));
        const int t2 = tl_ & 127, lane = tl_ & 63, r = lane & 31, hh = lane >> 5;
        const int it = k * 4 * w.G + w.bid * 4 + sub;
        const bool live = it < 128 * 36;
        const int chain = live ? it / 36 : 0, c = live ? it - chain * 36 : 0; const int b = chain >> 3, h = (chain >> 1) & 3, dir = chain & 1;
        const int row0 = chain_row(b, dir, c, 0); const long sg = dir ? -1 : 1;
        float x[64];
        { const bf16* xp = PB + (size_t)row0 * NPB + (wv == 0 ? 512 : 256) + h * 64 + lane;
#pragma unroll
          for (int i = 0; i < 32; ++i) x[i] = bf2f(xp[sg * i * NPB]); }
        { const int i = t2 >> 1, hf = t2 & 1; const v4u* src = (const v4u*)(PB + (size_t)(row0 + sg * i) * NPB + 256 + h * 64 + 32 * hf);
          const v4u k0 = src[0], k1 = src[1], k2 = src[2], k3 = src[3]; LAS v4u* dst = (LAS v4u*)(TK + i * TS + 32 * hf); dst[0] = k0; dst[1] = k1; dst[2] = k2; dst[3] = k3; }
        if (wv == 0) { const int row = row0 + (int)sg * lane;
            const float al = expf(a.in[I_GDN_ALOG][(l * 2 + dir) * 4 + h]), dtb = a.in[I_GDN_DTB][(l * 2 + dir) * 4 + h];
            float g = -al * softplus_acc(ZF[(size_t)row * NZF + 512 + dir * 4 + h] + dtb);
#pragma unroll
            for (int o = 1; o < 64; o <<= 1) { const float y = __shfl_up(g, o); if (lane >= o) g += y; }
            const float be = sigmoid_acc(ZF[(size_t)row * NZF + 520 + dir * 4 + h]); G[lane] = g; BETA[lane] = be; BETA[64 + lane] = be * __expf(g); }
        __syncthreads();
        if (wv == 0) {
#pragma unroll
            for (int bi = 0; bi < 2; ++bi) {
                f32x16 acc = zero16(); acc = mma64(acc, TK + 32 * bi * TS, TK + 32 * bi * TS, lane);
                LAS float* AT = bi ? A22T : A11T; const float gj = G[32 * bi + r];
#pragma unroll
                for (int q = 0; q < 4; ++q) { const int i0 = 8 * q + 4 * hh; const f32x4 gi = *(const LAS f32x4*)(G + 32 * bi + i0), bi4 = *(const LAS f32x4*)(BETA + 32 * bi + i0); f32x4 o;
#pragma unroll
                    for (int t = 0; t < 4; ++t) o[t] = (r < i0 + t) ? bi4[t] * acc[4 * q + t] * __expf(gi[t] - gj) : 0.f;
                    *(LAS f32x4*)(AT + r * 36 + i0) = o; } }
        } else {
            f32x16 acc = zero16(); acc = mma64(acc, TK, TK + 32 * TS, lane);
            const float gi = G[32 + r], bi = BETA[32 + r];
#pragma unroll
            for (int q = 0; q < 4; ++q) { const int j0 = 8 * q + 4 * hh; const f32x4 gj = *(const LAS f32x4*)(G + j0);
                st4bf(A21 + r * TS + j0, bi * acc[4 * q] * __expf(gi - gj[0]), bi * acc[4 * q + 1] * __expf(gi - gj[1]), bi * acc[4 * q + 2] * __expf(gi - gj[2]), bi * acc[4 * q + 3] * __expf(gi - gj[3])); }
        }
        __syncthreads();
        {
#pragma unroll
            for (int i = 0; i < 32; i += 4) { const f32x4 sc = *(const LAS f32x4*)(BETA + 64 * wv + i);
#pragma unroll
                for (int t = 0; t < 4; ++t) x[i + t] *= sc[t]; }
            solve_diag(x, A11T, 0, 0, 12);
            { long zz = 0; asm volatile("" : "+v"(zz) : "v"(x[11]));
              const bf16* xp = PB + (size_t)row0 * NPB + (wv == 0 ? 512 : 256) + h * 64 + lane + zz;
#pragma unroll
              for (int i = 32; i < 64; ++i) x[i] = bf2f(xp[sg * i * NPB]); }
            solve_diag(x, A11T, 0, 12, 31);
#pragma unroll
            for (int i = 32; i < 64; i += 4) { const f32x4 sc = *(const LAS f32x4*)(BETA + 64 * wv + i);
#pragma unroll
                for (int t = 0; t < 4; ++t) x[i + t] *= sc[t]; }
#pragma unroll
            for (int q = 0; q < 4; ++q) { v4u o; o.x = cvt_pk_bf16(x[8 * q], x[8 * q + 1]); o.y = cvt_pk_bf16(x[8 * q + 2], x[8 * q + 3]); o.z = cvt_pk_bf16(x[8 * q + 4], x[8 * q + 5]); o.w = cvt_pk_bf16(x[8 * q + 6], x[8 * q + 7]); *(LAS v4u*)(XT + lane * TS + 8 * q) = o; }
            f32x16 d0 = zero16(), d1 = zero16();
#pragma unroll
            for (int ks = 0; ks < 2; ++ks) { const bf16x8 av = *(const LAS bf16x8*)(A21 + r * TS + 8 * hh + 16 * ks);
                const bf16x8 b0 = *(const LAS bf16x8*)(XT + r * TS + 8 * hh + 16 * ks), b1 = *(const LAS bf16x8*)(XT + (32 + r) * TS + 8 * hh + 16 * ks);
                d0 = __builtin_amdgcn_mfma_f32_32x32x16_bf16(av, b0, d0, 0, 0, 0); d1 = __builtin_amdgcn_mfma_f32_32x32x16_bf16(av, b1, d1, 0, 0, 0); }
#pragma unroll
            for (int e = 0; e < 16; ++e) { const auto sw = __builtin_amdgcn_permlane32_swap(__float_as_uint(d0[e]), __float_as_uint(d1[e]), false, false);
                x[32 + 8 * (e >> 2) + (e & 3)] -= __uint_as_float(sw[0]); x[32 + 8 * (e >> 2) + 4 + (e & 3)] -= __uint_as_float(sw[1]); }
            solve_diag(x, A22T, 32, 0, 31);
            if (live) {
                if (wv == 0) { bf16* dst = UT + ((size_t)(chain * 36 + c) * 64 + lane) * 64;
#pragma unroll
                    for (int q = 0; q < 8; ++q) { v4u o; o.x = cvt_pk_bf16(x[8 * q], x[8 * q + 1]); o.y = cvt_pk_bf16(x[8 * q + 2], x[8 * q + 3]); o.z = cvt_pk_bf16(x[8 * q + 4], x[8 * q + 5]); o.w = cvt_pk_bf16(x[8 * q + 6], x[8 * q + 7]); *(v4u*)(dst + 8 * q) = o; } }
                else { bf16* dst = WW + (size_t)(chain * 36 + c) * 4096 + lane;
#pragma unroll
                    for (int j = 0; j < 64; ++j) dst[j * 64] = (bf16)f2bf(x[j]); }
            }
        }
        __syncthreads();
    }
}
#define LBAR() asm volatile("s_waitcnt lgkmcnt(0)\n\ts_barrier" ::: "memory")
__device__ __forceinline__ void phase_scan_chunk(const Args& a, LAS unsigned char* lds, const WCtx& w, int l) {
    const int grp = w.tid >> 8, tl = w.tid & 255, gw4 = w.wave & 3, wm = gw4 >> 1, wn = gw4 & 1, lane = w.lane, r = lane & 31, hh = lane >> 5;
    const int dir = grp;
    LAS unsigned char* gb = lds + grp * SCG_BYTES;
    LAS bf16* TQ = (LAS bf16*)gb; LAS bf16* TK = TQ + 64 * TS; LAS bf16* TX = TK + 64 * TS; LAS bf16* TKD = TX + 64 * TS; LAS bf16* TVT = TKD + 64 * TS; LAS bf16* TST = TVT + 64 * TS; LAS bf16* TP = TST + 64 * TS;
    LAS float* G = (LAS float*)(gb + 7 * TILE_BYTES); LAS float* EG = G + 64; LAS float* DEC = G + 128; LAS float* BD = G + 192; LAS float* QSUM = G + 256;
    const bf16* ZB = (const bf16*)(a.ws + WS_ZB); const float* ZF = (const float*)(a.ws + WS_ZF); const bf16* PB = (const bf16*)(a.ws + WS_PB); bf16* SO = (bf16*)(a.ws + WS_SO);
    const bf16* UT = (const bf16*)(a.ws + WS_UT); const bf16* WW = (const bf16*)(a.ws + WS_WW);
    for (int pi = w.bid; pi < 64; pi += w.G) {
        const int mix = 0, b = (pi & 63) >> 2, h = pi & 3;
        f32x16 S = zero16();
        bf16* so = SO + (size_t)(mix * 2 + dir) * MT * 256 + h * 64 + 32 * wn + r;
        {
            const int d = tl & 63, iq = tl >> 6;
            unsigned short rq[16], rv[16]; float rz[16];
#define GLA_LOAD(c_) do { const int row0_ = chain_row(b, dir, (c_), 16 * iq); const long sg_ = dir ? -1 : 1; \
                const bf16* pq_ = ZB + (size_t)row0_ * NZB + h * 64 + d; const float* pz_ = ZF + (size_t)row0_ * NZF + dir * 256 + h * 64 + d; \
                _Pragma("unroll") for (int ii = 0; ii < 16; ++ii) rq[ii] = pq_[sg_ * ii * NZB]; asm volatile("" ::: "memory"); \
                _Pragma("unroll") for (int ii = 0; ii < 16; ++ii) rv[ii] = pq_[sg_ * ii * NZB + 256]; asm volatile("" ::: "memory"); \
                _Pragma("unroll") for (int ii = 0; ii < 16; ++ii) rz[ii] = pz_[sg_ * ii * NZF]; asm volatile("" ::: "memory"); } while (0)
            GLA_LOAD(0);
            for (int c = 0; c < 36; ++c) {
                float lc[16], kk[16], qq[16], vvv[16]; float run = 0.f;
#pragma unroll
                for (int ii = 0; ii < 16; ++ii) { kk[ii] = 1.0f - __expf(rz[ii]); run += rz[ii]; lc[ii] = run; qq[ii] = bf2f(rq[ii]); vvv[ii] = bf2f(rv[ii]); }
                QSUM[iq * 64 + d] = run;
                LBAR();
                const float s0 = QSUM[d], s1 = QSUM[64 + d], s2 = QSUM[128 + d], s3 = QSUM[192 + d];
                const float off = (iq > 0 ? s0 : 0.f) + (iq > 1 ? s1 : 0.f) + (iq > 2 ? s2 : 0.f), g31 = s0 + s1, g63 = g31 + s2 + s3;
                { float kd[16];
                  const float e2 = __expf(g63 - g31);
#pragma unroll
                  for (int ii = 0; ii < 16; ++ii) { const int i = 16 * iq + ii; const float gi = off + lc[ii]; const float ea = __expf(gi), eb = expc(g31 - gi);
                      TQ[i * TS + d] = bfr(qq[ii] * ea);
                      TK[i * TS + d] = bfr(kk[ii] * eb);
                      if (iq >= 2) TX[(i - 32) * TS + d] = bfr(qq[ii] * __builtin_amdgcn_rcpf(eb));
                      else TX[(32 + i) * TS + d] = bfr(kk[ii] * __builtin_amdgcn_rcpf(fmaxf(ea, 1e-35f)));
                      kd[ii] = kk[ii] * eb * e2; }
                  v4u o0, o1; o0.x = cvt_pk_bf16(kd[0], kd[1]); o0.y = cvt_pk_bf16(kd[2], kd[3]); o0.z = cvt_pk_bf16(kd[4], kd[5]); o0.w = cvt_pk_bf16(kd[6], kd[7]);
                  o1.x = cvt_pk_bf16(kd[8], kd[9]); o1.y = cvt_pk_bf16(kd[10], kd[11]); o1.z = cvt_pk_bf16(kd[12], kd[13]); o1.w = cvt_pk_bf16(kd[14], kd[15]);
                  *(LAS v4u*)(TKD + swz(d, 16 * iq)) = o0; *(LAS v4u*)(TKD + swz(d, 16 * iq + 8)) = o1;
                  o0.x = cvt_pk_bf16(vvv[0], vvv[1]); o0.y = cvt_pk_bf16(vvv[2], vvv[3]); o0.z = cvt_pk_bf16(vvv[4], vvv[5]); o0.w = cvt_pk_bf16(vvv[6], vvv[7]);
                  o1.x = cvt_pk_bf16(vvv[8], vvv[9]); o1.y = cvt_pk_bf16(vvv[10], vvv[11]); o1.z = cvt_pk_bf16(vvv[12], vvv[13]); o1.w = cvt_pk_bf16(vvv[14], vvv[15]);
                  *(LAS v4u*)(TVT + swz(d, 16 * iq)) = o0; *(LAS v4u*)(TVT + swz(d, 16 * iq + 8)) = o1;
                  if (iq == 0) DEC[d] = __expf(g63); }
                store_state_T(TST, S, wm, wn, r, hh);
                if (c + 1 < 36) GLA_LOAD(c + 1);
                LBAR();
                { f32x16 acc = zero16();
                  if (wn >= wm) { const LAS bf16* Ap = (wm == 0 && wn == 0) ? TX + 32 * TS : TK + 32 * wm * TS; const LAS bf16* Bp = (wn == 0) ? TQ : TX;
                      acc = mma64(acc, Ap, Bp, lane); }
                  const int i = 32 * wn + r;
#pragma unroll
                  for (int q = 0; q < 4; ++q) { const int j0 = 32 * wm + 8 * q + 4 * hh;
                      st4bf(TP + i * TS + j0, (j0 <= i) ? acc[4 * q] : 0.f, (j0 + 1 <= i) ? acc[4 * q + 1] : 0.f, (j0 + 2 <= i) ? acc[4 * q + 2] : 0.f, (j0 + 3 <= i) ? acc[4 * q + 3] : 0.f); } }
                LBAR();
                { bf16* sop = so + (size_t)chain_row(b, dir, c, 32 * wm + 4 * hh) * 256; const long sstep = dir ? -256 : 256;
                  f32x16 o = zero16(); o = mma64s<false, true>(o, TP, wm, TVT, wn, lane); o = mma64(o, TQ + 32 * wm * TS, TST + 32 * wn * TS, lane);
                  f32x16 ds = zero16(); ds = mma64s<true, true>(ds, TKD, wm, TVT, wn, lane);
#pragma unroll
                  for (int q = 0; q < 4; ++q) { const f32x4 dv = *(const LAS f32x4*)(DEC + 32 * wm + 8 * q + 4 * hh);
#pragma unroll
                      for (int t = 0; t < 4; ++t) { S[4 * q + t] = dv[t] * S[4 * q + t] + ds[4 * q + t]; sop[(long)(8 * q + t) * sstep] = bfr(o[4 * q + t]); } } }
                LBAR();
            }
#undef GLA_LOAD
        }
    }
    for (int pi = w.bid; pi < 192; pi += w.G) {
        if (pi < 64) continue;
        const int mix = pi >> 6, b = (pi & 63) >> 2, h = pi & 3;
        const int chain = (b * 4 + h) * 2 + dir;
        f32x16 S = zero16();
        bf16* so = SO + (size_t)(mix * 2 + dir) * MT * 256 + h * 64 + 32 * wn + r;
        {
            const int i = tl >> 2, dq = tl & 3;
            const float al = expf(mix == 1 ? a.in[I_GDN_ALOG][(l * 2 + dir) * 4 + h] : a.in[I_SSD_ALOG][(l * 2 + dir) * 4 + h]);
            const float dtb = mix == 1 ? a.in[I_GDN_DTB][(l * 2 + dir) * 4 + h] : a.in[I_SSD_DTB][(l * 2 + dir) * 4 + h];
            v4u rq0s[2], rq1s[2], rk0s[2], rk1s[2], ra0s[2], ra1s[2], rb0s[2], rb1s[2]; float rs0s[2] = {0.f, 0.f}, rs1s[2] = {0.f, 0.f};
#pragma unroll
            for (int u = 0; u < 2; ++u) { rq0s[u] = rq1s[u] = rk0s[u] = rk1s[u] = ra0s[u] = ra1s[u] = rb0s[u] = rb1s[u] = (v4u){0u, 0u, 0u, 0u}; }
#define SD_LOAD(c_, u_) do { const int row_ = chain_row(b, dir, (c_), i); \
                if (mix == 1) { const v4u* pq_ = (const v4u*)(PB + (size_t)row_ * NPB + h * 64 + 16 * dq); const v4u* pk_ = (const v4u*)(PB + (size_t)row_ * NPB + 256 + h * 64 + 16 * dq); rq0s[u_] = pq_[0]; rq1s[u_] = pq_[1]; rk0s[u_] = pk_[0]; rk1s[u_] = pk_[1]; \
                    const v4u* pw_ = (const v4u*)(WW + (size_t)(chain * 36 + (c_)) * 4096 + i * 64 + 16 * dq); const v4u* pu_ = (const v4u*)(UT + (size_t)(chain * 36 + (c_)) * 4096 + i * 64 + 16 * dq); ra0s[u_] = pw_[0]; ra1s[u_] = pw_[1]; rb0s[u_] = pu_[0]; rb1s[u_] = pu_[1]; } \
                else { const v4u* pq_ = (const v4u*)(PB + (size_t)row_ * NPB + 768 + 384 + (h >> 1) * 64 + 16 * dq); const v4u* pk_ = (const v4u*)(PB + (size_t)row_ * NPB + 768 + 256 + (h >> 1) * 64 + 16 * dq); rq0s[u_] = pq_[0]; rq1s[u_] = pq_[1]; rk0s[u_] = pk_[0]; rk1s[u_] = pk_[1]; \
                    const v4u* pv_ = (const v4u*)(PB + (size_t)row_ * NPB + 768 + h * 64 + 16 * dq); ra0s[u_] = pv_[0]; ra1s[u_] = pv_[1]; } \
                if (gw4 == 0) { const int rj_ = chain_row(b, dir, (c_), lane); if (mix == 1) { rs0s[u_] = ZF[(size_t)rj_ * NZF + 512 + dir * 4 + h]; rs1s[u_] = ZF[(size_t)rj_ * NZF + 520 + dir * 4 + h]; } else rs0s[u_] = ZF[(size_t)rj_ * NZF + 528 + dir * 4 + h]; } } while (0)
            SD_LOAD(0, 0); SD_LOAD(1, 1);
            for (int c2 = 0; c2 < 36; c2 += 2) {
#pragma unroll
            for (int u = 0; u < 2; ++u) { const int c = c2 + u;
                if (gw4 == 0) { const float sp = softplus_acc(rs0s[u] + dtb); float g = -al * sp;
#pragma unroll
                    for (int o = 1; o < 64; o <<= 1) { const float y = __shfl_up(g, o); if (lane >= o) g += y; }
                    G[lane] = g; EG[lane] = __expf(g); BD[lane] = (mix == 1) ? sigmoid_acc(rs1s[u]) : sp; }
                LBAR();
                { const float gi = G[i], g63 = G[63]; const float kdsc = __expf(g63 - gi), vsc = (mix == 2) ? BD[i] : 1.0f;
                  const int colsw = ((((i >> 3) ^ dq) << 3) | (i & 7)); LAS bf16* kdb = TKD + 16 * dq * TS + colsw; LAS bf16* vtb = TVT + 16 * dq * TS + colsw;
                  *(LAS v4u*)(TQ + i * TS + 16 * dq) = rq0s[u]; *(LAS v4u*)(TQ + i * TS + 16 * dq + 8) = rq1s[u];
                  *(LAS v4u*)(TK + i * TS + 16 * dq) = rk0s[u]; *(LAS v4u*)(TK + i * TS + 16 * dq + 8) = rk1s[u];
                  float kf[8];
                  unpack8(rk0s[u], kf);
#pragma unroll
                  for (int t = 0; t < 8; ++t) kdb[t * TS] = bfr(kf[t] * kdsc);
                  unpack8(rk1s[u], kf);
#pragma unroll
                  for (int t = 0; t < 8; ++t) kdb[(8 + t) * TS] = bfr(kf[t] * kdsc);
                  if (mix == 2) { unpack8(ra0s[u], kf);
#pragma unroll
                      for (int t = 0; t < 8; ++t) vtb[t * TS] = bfr(kf[t] * vsc);
                      unpack8(ra1s[u], kf);
#pragma unroll
                      for (int t = 0; t < 8; ++t) vtb[(8 + t) * TS] = bfr(kf[t] * vsc); }
                  else { *(LAS v4u*)(TX + i * TS + 16 * dq) = ra0s[u]; *(LAS v4u*)(TX + i * TS + 16 * dq + 8) = ra1s[u];
                         *(LAS v4u*)(TVT + swz(i, 16 * dq)) = rb0s[u]; *(LAS v4u*)(TVT + swz(i, 16 * dq + 8)) = rb1s[u]; } }
                store_state_T(TST, S, wm, wn, r, hh);
                if (c + 2 < 36) SD_LOAD(c + 2, u);
                LBAR();
                { f32x16 acc = zero16();
                  if (wn >= wm) acc = mma64(acc, TK + 32 * wm * TS, TQ + 32 * wn * TS, lane);
                  const int ii = 32 * wn + r; const float gi = G[ii];
#pragma unroll
                  for (int q = 0; q < 4; ++q) { const int j0 = 32 * wm + 8 * q + 4 * hh; const f32x4 gj = *(const LAS f32x4*)(G + j0); float pv[4];
#pragma unroll
                      for (int t = 0; t < 4; ++t) pv[t] = (j0 + t <= ii) ? acc[4 * q + t] * __expf(gi - gj[t]) : 0.f;
                      st4bf(TP + ii * TS + j0, pv[0], pv[1], pv[2], pv[3]); }
                  if (mix == 1) { f32x16 ws_ = zero16(); ws_ = mma64(ws_, TX + 32 * wm * TS, TST + 32 * wn * TS, lane);
#pragma unroll
                      for (int q = 0; q < 4; ++q) { LAS bf16* up = TVT + swz(32 * wn + r, 32 * wm + 8 * q + 4 * hh); const v2u uu = *(const LAS v2u*)up;
                          st4bf(up, bf2f(uu.x & 0xffffu) - ws_[4 * q], bf2f(uu.x >> 16) - ws_[4 * q + 1], bf2f(uu.y & 0xffffu) - ws_[4 * q + 2], bf2f(uu.y >> 16) - ws_[4 * q + 3]); } } }
                LBAR();
                { bf16* sop = so + (size_t)chain_row(b, dir, c, 32 * wm + 4 * hh) * 256; const long sstep = dir ? -256 : 256;
                  f32x16 o = zero16(); o = mma64s<false, true>(o, TP, wm, TVT, wn, lane);
                  f32x16 qs = zero16(); qs = mma64(qs, TQ + 32 * wm * TS, TST + 32 * wn * TS, lane);
                  f32x16 ds = zero16(); ds = mma64s<true, true>(ds, TKD, wm, TVT, wn, lane);
                  const float dsc = EG[63];
#pragma unroll
                  for (int q = 0; q < 4; ++q) { const f32x4 eg = *(const LAS f32x4*)(EG + 32 * wm + 8 * q + 4 * hh);
#pragma unroll
                      for (int t = 0; t < 4; ++t) { S[4 * q + t] = dsc * S[4 * q + t] + ds[4 * q + t]; sop[(long)(8 * q + t) * sstep] = bfr(o[4 * q + t] + eg[t] * qs[4 * q + t]); } } }
                LBAR();
            } }
#undef SD_LOAD
        }
    }
}

constexpr size_t WS_TW = WS_LB + 65536;
__device__ __forceinline__ int fpad(int i) { return i + ((i >> 7) << 3); }
__device__ __forceinline__ void cst16(int k, float& c, float& s) {
    constexpr float C[8] = {1.0f, 0.92387953251128674f, 0.70710678118654752f, 0.38268343236508977f, 0.0f, -0.38268343236508977f, -0.70710678118654752f, -0.92387953251128674f};
    constexpr float S[8] = {0.0f, -0.38268343236508977f, -0.70710678118654752f, -0.92387953251128674f, -1.0f, -0.92387953251128674f, -0.70710678118654752f, -0.38268343236508977f};
    c = C[k]; s = S[k]; }
template <int LOGN, int S0, int R, int NCOL>
__device__ __forceinline__ void fft_pass(LAS float* XR, LAS float* XI, const float* TW, int tid) {
    constexpr int N = 1 << LOGN, G = 1 << R, STR = N >> (S0 + R), NGC = N / G, CS = N + 8 * (N / 128);
    for (int gi = tid; gi < NCOL * NGC; gi += NTHREADS) {
        const int col = gi / NGC, g = gi - col * NGC, lo = g & (STR - 1), hi = g / STR;
        const int i0 = hi * (STR * G) + lo;
        LAS float* xr = XR + col * CS; LAS float* xi = XI + col * CS;
        float er[G], ei[G];
        if constexpr (STR == 1) {
#pragma unroll
            for (int m = 0; m < G; m += 4) { const f32x4 a = *(const LAS f32x4*)(xr + fpad(i0) + m), b = *(const LAS f32x4*)(xi + fpad(i0) + m);
#pragma unroll
                for (int t = 0; t < 4; ++t) { er[m + t] = a[t]; ei[m + t] = b[t]; } }
        } else {
#pragma unroll
            for (int m = 0; m < G; ++m) { er[m] = xr[fpad(i0 + STR * m)]; ei[m] = xi[fpad(i0 + STR * m)]; }
        }
#pragma unroll
        for (int t = 0; t < R; ++t) {
            constexpr int dummy = 0; (void)dummy;
            const int hs = G >> (t + 1), s = S0 + t;
            float wlr = 1.0f, wli = 0.0f;
            if constexpr (STR > 1) { const int ti = (lo << s) * (2048 / N); wlr = TW[2 * ti]; wli = TW[2 * ti + 1]; }
#pragma unroll
            for (int blk = 0; blk < G; blk += 2 * hs)
#pragma unroll
                for (int q = 0; q < hs; ++q) {
                    const float ar = er[blk + q], ai = ei[blk + q], br = er[blk + q + hs], bi = ei[blk + q + hs];
                    const float dr = ar - br, di = ai - bi;
                    er[blk + q] = ar + br; ei[blk + q] = ai + bi;
                    float cr, ci; cst16((q << t) * (16 / G), cr, ci);
                    float tr, tim;
                    if (q == 0) { tr = wlr; tim = wli; } else if constexpr (STR == 1) { tr = cr; tim = ci; } else { tr = wlr * cr - wli * ci; tim = wlr * ci + wli * cr; }
                    er[blk + q + hs] = dr * tr - di * tim; ei[blk + q + hs] = dr * tim + di * tr;
                }
        }
        if constexpr (STR == 1) {
#pragma unroll
            for (int m = 0; m < G; m += 4) { *(LAS f32x4*)(xr + fpad(i0) + m) = (f32x4){er[m], er[m + 1], er[m + 2], er[m + 3]}; *(LAS f32x4*)(xi + fpad(i0) + m) = (f32x4){ei[m], ei[m + 1], ei[m + 2], ei[m + 3]}; }
        } else {
#pragma unroll
            for (int m = 0; m < G; ++m) { xr[fpad(i0 + STR * m)] = er[m]; xi[fpad(i0 + STR * m)] = ei[m]; }
        }
    }
}
template <int LOGN, int NCOL>
__device__ __forceinline__ void fft_items(const Args& a, LAS unsigned char* lds, const WCtx& w, const bf16* VT, float* FO, int rowbase0, float scale) {
    constexpr int N = 1 << LOGN, CS = N + 8 * (N / 128), NCG = 256 / NCOL, TPC = NTHREADS / NCOL;
    LAS float* XR = (LAS float*)lds; LAS float* XI = XR + NCOL * CS; const float* TW = (const float*)(a.ws + WS_TW);
    const int c = w.tid / TPC, j = w.tid - c * TPC;
    for (int it = w.bid; it < 16 * NCG; it += w.G) {
        const int b = it / NCG, cg = it - b * NCG, ch = cg * NCOL + c;
        const bf16* src = VT + (size_t)(b * 256 + ch) * (2 * N);
        for (int m = j; m < N / 8; m += TPC) {
            const v4u vr = *(const v4u*)(src + 8 * m), vi = *(const v4u*)(src + N + 8 * m); float f[8];
            unpack8(vr, f); *(LAS f32x4*)(XR + c * CS + fpad(8 * m)) = (f32x4){f[0], f[1], f[2], f[3]}; *(LAS f32x4*)(XR + c * CS + fpad(8 * m) + 4) = (f32x4){f[4], f[5], f[6], f[7]};
            unpack8(vi, f); *(LAS f32x4*)(XI + c * CS + fpad(8 * m)) = (f32x4){f[0], f[1], f[2], f[3]}; *(LAS f32x4*)(XI + c * CS + fpad(8 * m) + 4) = (f32x4){f[4], f[5], f[6], f[7]}; }
        __syncthreads();
        if constexpr (LOGN == 11) { fft_pass<11, 0, 4, NCOL>(XR, XI, TW, w.tid); __syncthreads(); fft_pass<11, 4, 4, NCOL>(XR, XI, TW, w.tid); __syncthreads(); fft_pass<11, 8, 3, NCOL>(XR, XI, TW, w.tid); }
        else { fft_pass<8, 0, 4, NCOL>(XR, XI, TW, w.tid); __syncthreads(); fft_pass<8, 4, 4, NCOL>(XR, XI, TW, w.tid); }
        __syncthreads();
        { const int oc = w.tid % NCOL, k0 = w.tid / NCOL; float* dst = FO + (size_t)(rowbase0 + b * N) * 256 + cg * NCOL + oc;
          for (int kt = k0; kt < N; kt += TPC) { const int br_ = (int)(__brev((unsigned)kt) >> (32 - LOGN)); dst[(size_t)kt * 256] = XR[oc * CS + fpad(br_)] * scale; } }
        __syncthreads();
    }
}
__device__ __forceinline__ void phase_fourier_time(const Args& a, LAS unsigned char* lds, const WCtx& w) {
    fft_items<11, 8>(a, lds, w, (const bf16*)(a.ws + WS_VTL), (float*)(a.ws + WS_FO), 0, 0.0027621358640099515f);
    fft_items<8, 32>(a, lds, w, (const bf16*)(a.ws + WS_VTC), (float*)(a.ws + WS_FO), ML, 0.0078125f);
}
constexpr int PPL = 13;
constexpr int N_PHASES = 2 + PPL * DEPTH;
#ifndef PHMASK
#define PHMASK 0xFFFFu
#endif
#define EN(k) (((PHMASK) >> (k)) & 1u)
__global__ void __launch_bounds__(NTHREADS, 2) fwd_kernel(Args args) {
    extern __shared__ __attribute__((aligned(16))) unsigned char lds_raw[];
    LAS unsigned char* lds = (LAS unsigned char*)lds_raw;
#define MKW() WCtx w; { int t_ = threadIdx.x; asm volatile("" : "+v"(t_)); w.tid = t_; w.lane = t_ & 63; w.wave = __builtin_amdgcn_readfirstlane(t_ >> 6); { int b_ = blockIdx.x; asm volatile("" : "+s"(b_)); w.bid = b_; } { int g_ = gridDim.x; asm volatile("" : "+s"(g_)); w.G = g_; } w.gw = w.bid * NWAVES + w.wave; w.NGW = w.G * NWAVES; } \
              unsigned char* ws = args.ws; asm volatile("" : "+s"(ws)); const int c = w.bid; (void)c; (void)ws
    for (int u = threadIdx.x; u < (LDS_BYTES - LDSCTL_OFF) / 4; u += NTHREADS) ((LAS unsigned*)(lds + LDSCTL_OFF))[u] = 0u;
    __syncthreads();
    XcdBarrier bar = xcd_barrier_post((unsigned*)(args.ws + WS_CTL) + CW_BAR + args.li * XCD_BAR_WORDS, (volatile LAS unsigned*)(lds + MISC_OFF) + 8);
    const int lo = args.ph_lo, hi = args.ph_hi;
#define INP(k) (lo <= (k) && (k) < hi)
#define SEAM(k) do { if (INP(k) && INP((k) + 1)) xcd_barrier(bar); } while (0)
#ifdef PROBE_MASK
    unsigned long long pr_prev = __builtin_amdgcn_s_memrealtime(), pr_acc = 0ull;
#define STAMP(slot) do { const unsigned long long n_ = __builtin_amdgcn_s_memrealtime(); if (((PROBE_MASK) >> (slot)) & 1u) pr_acc += n_ - pr_prev; pr_prev = n_; } while (0)
#else
#define STAMP(slot) do { } while (0)
#endif
    if (EN(12) && INP(0)) { MKW(); phase_prologue(args, lds, w); }
    SEAM(0); STAMP(12);
    if (EN(13) && INP(1)) { MKW(); phase_mod_rows(args, w, 0); }
    SEAM(1); STAMP(13);
    for (int l = 0; l < DEPTH; ++l) {
        const int pb = 2 + PPL * l;
        const bool lastl = (l == DEPTH - 1);
        const int nrows = lastl ? ML : MT, nMr = nrows / 256;
        if (EN(0) && INP(pb + 0)) { MKW();
            { pg8::Order<MapPlain> S; S.init(MT / 256, 11, w.G, c); S.map = MapPlain{(const char*)(ws + WS_H), (const char*)(ws + WS_WIN), (size_t)256 * 1024 * 2, (size_t)256 * 1024 * 2};
              EpiZB E{(bf16*)(ws + WS_ZB)};
              pg8::gemm_phase<EpiZB, pg8::Order<MapPlain>>(lds, pg8::Gemm{1024, 1024, 1024}, S, E); }
            { pg8::Order<MapPlain> S; S.init(MT / 256, 3, w.G, w.G - 1 - c); S.map = MapPlain{(const char*)(ws + WS_H), (const char*)(ws + WS_WIN) + (size_t)11 * 256 * 1024 * 2, (size_t)256 * 1024 * 2, (size_t)256 * 1024 * 2};
              EpiZF E{(float*)(ws + WS_ZF), (const float*)(ws + WS_LB) + l * 256};
              pg8::gemm_phase<EpiZF, pg8::Order<MapPlain>>(lds, pg8::Gemm{1024, 1024, 1024}, S, E); }
        }
        SEAM(pb + 0); STAMP(0);
        if (EN(1) && INP(pb + 1)) { MKW();
            pg8::Order<MapPlain> S; S.init(2, MT / 256, w.G, c); S.map = MapPlain{(const char*)(ws + WS_DFT64), (const char*)(ws + WS_ZB) + 1792 * 2, (size_t)256 * 256 * 2, (size_t)256 * NZB * 2};
            EpiFour1 E{(bf16*)(ws + WS_VTL), (bf16*)(ws + WS_VTC)};
            pg8::gemm_phase<EpiFour1, pg8::Order<MapPlain>>(lds, pg8::Gemm{256, 256, NZB}, S, E);
            if (EN(15)) phase_prep(args, w, l);
        }
        SEAM(pb + 1); STAMP(1);
        if (EN(2) && INP(pb + 2)) { MKW();
            phase_fourier_time(args, lds, w);
            __syncthreads();
            if (EN(14)) phase_gdn_solve(args, lds, w, l);
            __syncthreads(); convert_rest(args, lds, w.wave, w.lane, w.gw, w.NGW, l, WI_XA, WI_XB);
        }
        SEAM(pb + 2); STAMP(2);
        if (EN(14) && INP(pb + 3)) { MKW();
            if (w.G > 192) { if (w.bid >= 192) convert_rest(args, lds, w.wave, w.lane, (w.bid - 192) * NWAVES + w.wave, (w.G - 192) * NWAVES, l, 0, WI_XA); else phase_scan_chunk(args, lds, w, l); }
            else { phase_scan_chunk(args, lds, w, l); __syncthreads(); convert_rest(args, lds, w.wave, w.lane, w.gw, w.NGW, l, 0, WI_XA); } }
        SEAM(pb + 3); STAMP(14);
        if (EN(3) && INP(pb + 4)) { MKW(); phase_finish(args, w, l, nrows); }
        SEAM(pb + 4); STAMP(3);
        if (EN(4) && INP(pb + 5)) { MKW();
            pg8::Order<MapP> S; S.init(nMr, 16, w.G, c); S.map = MapP{(const char*)(ws + WS_OUTS), (const char*)(ws + WS_WBR)};
            EpiP E{(bf16*)(ws + WS_P)};
            pg8::gemm_phase<EpiP, pg8::Order<MapP>>(lds, pg8::Gemm{256, 1024, 256}, S, E);
        }
        SEAM(pb + 5); STAMP(4);
        if (EN(5) && INP(pb + 6)) { MKW();
            pg8::Order<MapPlain> S; S.init(nMr, 16, w.G, c); S.map = MapPlain{(const char*)(ws + WS_H8), (const char*)(ws + WS_WG), (size_t)256 * 1024, (size_t)256 * 1024};
            EpiMerge E{(const bf16*)(ws + WS_P), (bf16*)(ws + WS_T), args.in[I_BGATE] + (size_t)l * 4096};
            pg8::gemm_phase<EpiMerge, pg8::Order<MapPlain>, true, true, false, 1>(lds, pg8::Gemm{1024, 1024, 1024, 0x79797979, 0x7F7F7F7F}, S, E);
        }
        SEAM(pb + 6); STAMP(5);
        if (EN(6) && INP(pb + 7)) { MKW();
            pg8::Order<MapPlain> S; S.init(nMr, 4, w.G, c); S.map = MapPlain{(const char*)(ws + WS_T), (const char*)(ws + WS_WOUT), (size_t)256 * 1024 * 2, (size_t)256 * 1024 * 2};
            EpiBf E{(bf16*)(ws + WS_Y), 1024, nullptr};
            pg8::gemm_phase<EpiBf, pg8::Order<MapPlain>>(lds, pg8::Gemm{1024, 1024, 1024}, S, E);
        }
        SEAM(pb + 7); STAMP(6);
        if (EN(7) && INP(pb + 8)) { MKW(); phase_ln1(args, lds, w, l, nrows); }
        SEAM(pb + 8); STAMP(7);
        if (EN(8) && INP(pb + 9)) { MKW(); phase_topk(args, lds, w, lastl ? 256 : 512); __syncthreads(); convert_rest(args, lds, w.wave, w.lane, w.gw, w.NGW, l, WI_XB, WI_REST); }
        SEAM(pb + 9); STAMP(8);
        const int nMe = lastl ? 256 : 288;
        if (EN(9) && INP(pb + 10)) { MKW();
            pg8::Order<MapMoEG> S; S.init(nMe, 8, w.G, c); S.map = MapMoEG{(const char*)(ws + WS_H), (const char*)(ws + WS_WGU), (size_t)2048 * 1024, (size_t)256 * 1024};
            EpiSwiGLU E{(unsigned char*)(ws + WS_HID)};
            pg8::gemm_phase<EpiSwiGLU, pg8::Order<MapMoEG>, true, true, true, 1>(lds, pg8::Gemm{1024, 1024, 1024, 0x79797979, 0x7F7F7F7F}, S, E, (const int*)(ws + WS_ROWW + 512 * 1024));
        }
        SEAM(pb + 10); STAMP(9);
        if (EN(10) && INP(pb + 11)) { MKW();
            pg8::Order<MapMoE> S; S.init(nMe, 4, w.G, c); S.map = MapMoE{(const char*)(ws + WS_HID), (const char*)(ws + WS_WDN), (size_t)1024 * 1024, (size_t)256 * 1024};
            EpiF8 E{(unsigned char*)(ws + WS_YE), (const float*)(ws + WS_ROWW)};
            pg8::gemm_phase<EpiF8, pg8::Order<MapMoE>, true, true, false, 1>(lds, pg8::Gemm{1024, 1024, 1024, 0x79797979, 0x7F7F7F7F}, S, E);
        }
        SEAM(pb + 11); STAMP(10);
        if (EN(11) && INP(pb + 12)) { MKW(); phase_ln2(args, lds, w, l, nrows); if (!lastl) { __syncthreads(); convert_win(args, lds, w.wave, w.lane, w.gw, w.NGW, l + 1); } }
        SEAM(pb + 12); STAMP(11);
    }
#ifdef PROBE_MASK
    if (blockIdx.x == 0 && threadIdx.x == 0) { const unsigned long long t0_ = __builtin_amdgcn_s_memrealtime(); while (__builtin_amdgcn_s_memrealtime() - t0_ < 4ull * pr_acc) __builtin_amdgcn_s_sleep(8); }
#endif
#undef INP
#undef SEAM
}

#ifndef MK_SPLIT
#define MK_SPLIT 0
#endif
extern "C" void kernel_launch(void* const* d_in, const int* in_sizes, int n_in, void* d_out, int out_size, void* d_ws, size_t ws_size, hipStream_t stream) {
    static int grid = 0;
    if (grid == 0) {
        if (n_in != 31 || out_size != ML * D || ws_size < WS_END) { fprintf(stderr, "kernel_launch: unexpected problem (n_in %d, out %d, ws %zu, need %zu)\n", n_in, out_size, ws_size, (size_t)WS_END); grid = -1; return; }
        int dev = 0, cus = 0, per_cu = 0;
        if (hipGetDevice(&dev) != hipSuccess || hipDeviceGetAttribute(&cus, hipDeviceAttributeMultiprocessorCount, dev) != hipSuccess) { grid = -1; return; }
        if (hipFuncSetAttribute((const void*)fwd_kernel, hipFuncAttributeMaxDynamicSharedMemorySize, LDS_BYTES) != hipSuccess) { fprintf(stderr, "kernel_launch: hipFuncSetAttribute failed\n"); grid = -1; return; }
        if (hipOccupancyMaxActiveBlocksPerMultiprocessor(&per_cu, (const void*)fwd_kernel, NTHREADS, LDS_BYTES) != hipSuccess || per_cu < 1) fprintf(stderr, "kernel_launch: occupancy query says %d\n", per_cu);
        (void)hipGetLastError();
        grid = cus;
    }
    if (grid < 0) return;
    if (hipMemsetAsync((char*)d_ws + WS_CTL, 0, CTL_ZERO_BYTES, stream) != hipSuccess) return;
    Args a{};
    for (int i = 0; i < 31; ++i) a.in[i] = (const float*)d_in[i];
    a.out = (float*)d_out; a.ws = (unsigned char*)d_ws;
#if MK_SPLIT
    for (int p = 0; p < N_PHASES; ++p) { a.ph_lo = p; a.ph_hi = p + 1; a.li = p; a.pad = 0; hipLaunchKernelGGL(fwd_kernel, dim3(grid), dim3(NTHREADS), LDS_BYTES, stream, a); }
#else
    a.ph_lo = 0; a.ph_hi = N_PHASES; a.li = 0; a.pad = 0;
    hipLaunchKernelGGL(fwd_kernel, dim3(grid), dim3(NTHREADS), LDS_BYTES, stream, a);
#endif
    const hipError_t le = hipPeekAtLastError();
    if (le != hipSuccess) fprintf(stderr, "kernel_launch: launch failed: %s\n", hipGetErrorName(le));
}
```

```cpp
#include <hip/hip_runtime.h>
#include <cstdio>
#include <cstdint>

#define LAS __attribute__((address_space(3)))
typedef unsigned short bf16;
typedef short bf16x8 __attribute__((ext_vector_type(8)));
typedef float f32x4 __attribute__((ext_vector_type(4)));
typedef float f32x2 __attribute__((ext_vector_type(2)));
typedef unsigned v4u __attribute__((ext_vector_type(4)));
typedef unsigned v2u __attribute__((ext_vector_type(2)));

constexpr int D = 1024, BATCH = 16, SEQ = 2048, CTXL = 256, DEPTH = 4, BW = 256, NH = 4, HD = 64, NE = 16, FF = 1024;
constexpr int ML = BATCH * SEQ, MC = BATCH * CTXL, MT = ML + MC;
constexpr int IN_COLS = 3352;
constexpr int NZB = 2816, NZF = 768;
constexpr int NPB = 1280;
constexpr float LN_EPS = 1e-6f;
constexpr float ALPHA = 1.681792830507429f;
constexpr int CAP_L = 256, CAP_C = 32;
constexpr int NWAVES = 8, NTHREADS = 512;

constexpr size_t MiB = 1u << 20;
constexpr size_t WS_CTL = 0, CTL_ZERO_BYTES = 1 * MiB;
constexpr size_t WS_MOD = 1 * MiB;
constexpr size_t WS_LB = 3 * MiB;
constexpr size_t WS_DFT64 = 4 * MiB;
constexpr size_t WS_DFTC = 5 * MiB;
constexpr size_t WS_DFTL = 6 * MiB;
constexpr size_t WS_AFF = 22 * MiB;
constexpr size_t WS_SLOT = 25 * MiB;
constexpr size_t WS_ROWW = 28 * MiB;
constexpr size_t WS_WIN = 32 * MiB;
constexpr size_t WS_WG = 39 * MiB;
constexpr size_t WS_WBR = 47 * MiB;
constexpr size_t WS_WOUT = 49 * MiB;
constexpr size_t WS_WGU = 51 * MiB;
constexpr size_t WS_WDN = 115 * MiB;
constexpr size_t WS_X = 147 * MiB;
constexpr size_t WS_H = 291 * MiB;
constexpr size_t WS_R1 = 364 * MiB;
constexpr size_t WS_ZB = WS_R1;
constexpr size_t WS_ZF = WS_R1 + 198 * MiB;
constexpr size_t WS_PB = WS_R1 + 306 * MiB;
constexpr size_t WS_SO = WS_R1 + 396 * MiB;
constexpr size_t WS_VTL = WS_R1 + 504 * MiB;
constexpr size_t WS_VTC = WS_R1 + 536 * MiB;
constexpr size_t WS_FO = WS_R1 + 540 * MiB;
constexpr size_t WS_OUTS = WS_R1 + 612 * MiB;
constexpr size_t WS_P = WS_R1;
constexpr size_t WS_T = WS_R1 + 288 * MiB;
constexpr size_t WS_Y = WS_R1 + 360 * MiB;
constexpr size_t WS_XE = WS_R1;
constexpr size_t WS_HID = WS_R1 + 144 * MiB;
constexpr size_t WS_YE = WS_R1 + 288 * MiB;
constexpr size_t WS_H8 = WS_R1 + 756 * MiB;
constexpr size_t WS_END = WS_R1 + 792 * MiB;
constexpr int CW_BAR = 4096;

constexpr int RING_BYTES = 131072;
constexpr int LDSCTL_OFF = 145408, MISC_OFF = LDSCTL_OFF + 320;
constexpr int LDS_BYTES = 147456;

__device__ __forceinline__ float bf2f(unsigned b) { return __uint_as_float(b << 16); }
__device__ __forceinline__ unsigned f2bf(float f) { unsigned u = __float_as_uint(f); return (u + 0x7fffu + ((u >> 16) & 1u)) >> 16; }
__device__ __forceinline__ unsigned pk2(float lo, float hi) { return f2bf(lo) | (f2bf(hi) << 16); }
__device__ __forceinline__ unsigned cvt_pk_bf16(float lo, float hi) { unsigned r; asm volatile("v_cvt_pk_bf16_f32 %0, %1, %2" : "=v"(r) : "v"(lo), "v"(hi)); return r; }
__device__ __forceinline__ float dpp_x1(float x) { return __int_as_float(__builtin_amdgcn_mov_dpp(__float_as_int(x), 0xB1, 0xf, 0xf, true)); }
__device__ __forceinline__ float dpp_x2(float x) { return __int_as_float(__builtin_amdgcn_mov_dpp(__float_as_int(x), 0x4E, 0xf, 0xf, true)); }
__device__ __forceinline__ float dpp_x3(float x) { return __int_as_float(__builtin_amdgcn_mov_dpp(__float_as_int(x), 0x1B, 0xf, 0xf, true)); }
__device__ __forceinline__ float dpp_x7(float x) { return __int_as_float(__builtin_amdgcn_mov_dpp(__float_as_int(x), 0x141, 0xf, 0xf, true)); }
__device__ __forceinline__ float dpp_x15(float x) { return __int_as_float(__builtin_amdgcn_mov_dpp(__float_as_int(x), 0x140, 0xf, 0xf, true)); }
__device__ __forceinline__ float dpp_x4(float x) { return dpp_x3(dpp_x7(x)); }
__device__ __forceinline__ float dpp_x8(float x) { return __int_as_float(__builtin_amdgcn_mov_dpp(__float_as_int(x), 0x128, 0xf, 0xf, true)); }
__device__ __forceinline__ float swap16_add(float a, float b) { const auto r = __builtin_amdgcn_permlane16_swap(__float_as_uint(a), __float_as_uint(b), false, false); return __uint_as_float(r[0]) + __uint_as_float(r[1]); }
__device__ __forceinline__ float swap32_add(float a, float b) { const auto r = __builtin_amdgcn_permlane32_swap(__float_as_uint(a), __float_as_uint(b), false, false); return __uint_as_float(r[0]) + __uint_as_float(r[1]); }
__device__ __forceinline__ float swap16_max(float a) { const auto r = __builtin_amdgcn_permlane16_swap(__float_as_uint(a), __float_as_uint(a), false, false); return fmaxf(__uint_as_float(r[0]), __uint_as_float(r[1])); }
__device__ __forceinline__ float swap32_max(float a) { const auto r = __builtin_amdgcn_permlane32_swap(__float_as_uint(a), __float_as_uint(a), false, false); return fmaxf(__uint_as_float(r[0]), __uint_as_float(r[1])); }
template <int CTRL, int RM> __device__ __forceinline__ float dpp0f(float x) { return __int_as_float(__builtin_amdgcn_update_dpp(0, __float_as_int(x), CTRL, RM, 0xf, false)); }
template <int CTRL, int RM> __device__ __forceinline__ int dpp0i(int x) { return __builtin_amdgcn_update_dpp(0, x, CTRL, RM, 0xf, false); }
__device__ __forceinline__ float wave_scan(float v) {
    v += dpp0f<0x111, 0xf>(v); v += dpp0f<0x112, 0xf>(v); v += dpp0f<0x114, 0xf>(v); v += dpp0f<0x118, 0xf>(v);
    v += dpp0f<0x142, 0xa>(v); v += dpp0f<0x143, 0xc>(v);
    return v;
}
__device__ __forceinline__ float wave_scan_s(float v, int lane) {
    v += dpp0f<0x111, 0xf>(v); v += dpp0f<0x112, 0xf>(v); v += dpp0f<0x114, 0xf>(v); v += dpp0f<0x118, 0xf>(v);
    const float t0 = __int_as_float(__builtin_amdgcn_readlane(__float_as_int(v), 15)), t1 = __int_as_float(__builtin_amdgcn_readlane(__float_as_int(v), 31)), t2 = __int_as_float(__builtin_amdgcn_readlane(__float_as_int(v), 47));
    if (lane >= 16) v += t0;
    if (lane >= 32) v += t1;
    if (lane >= 48) v += t2;
    return v;
}
__device__ __forceinline__ int wave_scan(int v) {
    v += dpp0i<0x111, 0xf>(v); v += dpp0i<0x112, 0xf>(v); v += dpp0i<0x114, 0xf>(v); v += dpp0i<0x118, 0xf>(v);
    v += dpp0i<0x142, 0xa>(v); v += dpp0i<0x143, 0xc>(v);
    return v;
}
__device__ __forceinline__ float wave_sum(float v) {
    v += dpp_x1(v); v += dpp_x2(v); v += dpp_x7(v); v += dpp_x15(v);
    v = swap16_add(v, v); v = swap32_add(v, v);
    return v;
}
__device__ __forceinline__ float sigmoid_fast(float x) { return __builtin_amdgcn_rcpf(1.0f + __expf(-x)); }
__device__ __forceinline__ float sigmoid_acc(float x) { return 1.0f / (1.0f + expf(-x)); }
__device__ __forceinline__ float silu_acc(float x) { return x / (1.0f + expf(-x)); }
__device__ __forceinline__ float softplus_acc(float x) { return x > 20.f ? x : log1pf(expf(x)); }
#define LDS_WAIT() asm volatile("s_waitcnt lgkmcnt(0)" ::: "memory")
#define VM_WAIT() asm volatile("s_waitcnt vmcnt(0)" ::: "memory")

namespace pg8 {
constexpr int BM = 256, BK = 64, HALF = 128, HTB = HALF * BK * 2, STAGE_BYTES = 8 * HTB, NXCD = 8, WGM = 8;
__host__ __device__ __forceinline__ int lds_byte(int r, int c) { const int st = (r >> 4) * 2 + (c >> 5), rr = r & 15, cc = c & 31, ob = rr * 64 + cc * 2; return st * 1024 + (ob ^ (((ob >> 9) & 1) << 5)); }
__host__ __device__ __forceinline__ void stage_rc(int b, int& R, int& C) { const int st = b / 1024, sb = b % 1024, swz = sb ^ (((sb >> 9) & 1) << 5); R = (st >> 1) * 16 + swz / 64; C = (st & 1) * 32 + (swz % 64) / 2; }
__host__ __device__ __forceinline__ int perm32(int rho) { const int n = rho >> 4, i = rho & 15; return 8 * (i >> 2) + 4 * n + (i & 3); }

struct Unit { int pm, pn; const char* A; const char* B; };
struct Gemm { int K, lda, ldb; int sw = 0x7F7F7F7F, sx = 0x7F7F7F7F; };
typedef int v8i __attribute__((ext_vector_type(8)));
typedef int v4i __attribute__((ext_vector_type(4)));

template <class Map> struct Order {
    int nM, nN, nwg, G, c; Map map;
    __device__ __forceinline__ void init(int nM_, int nN_, int G_, int c_) { nM = nM_; nN = nN_; nwg = nM * nN; G = G_; c = c_; }
    __device__ __forceinline__ bool next(int i, Unit& u) const {
        const long L = (long)i * G + c; if (L >= nwg) return false;
        int wgid = (int)L; { const int q = nwg / NXCD, r = nwg % NXCD, xcd = wgid % NXCD, off = wgid / NXCD; wgid = (xcd < r ? xcd * (q + 1) : r * (q + 1) + (xcd - r) * q) + off; }
        const int nig = WGM * nN, gid = wgid / nig, fm = gid * WGM, gsz = (nM - fm) < WGM ? (nM - fm) : WGM;
        u.pm = fm + ((wgid % nig) % gsz); u.pn = (wgid % nig) / gsz; map(u); return true;
    }
    __device__ __forceinline__ void a_ready(const Unit&) const {}
    __device__ __forceinline__ void done(const Unit&) const {}
};

template <class Epi, class Sched, bool ALIGN_EPI = true, bool SP2 = true, bool GATHER = false, int ESZ = 2>
__device__ __forceinline__ void gemm_phase(LAS unsigned char* lds, const Gemm g, const Sched& S, const Epi& E, const int* selrow = nullptr) {
    int tid_ = threadIdx.x; asm volatile("" : "+v"(tid_));
    const int tid = tid_, wid = __builtin_amdgcn_readfirstlane(tid >> 6), lane = tid & 63, wr = wid >> 2, wc = wid & 3, fr = lane & 15, fq = lane >> 4;
    constexpr bool FP8 = (ESZ == 1);
    const int K = g.K, nt = K * ESZ / (BK * 2);
    unsigned voffA[2], voffB[2]; int gR[2]; unsigned gC2[2];
#pragma unroll
    for (int i = 0; i < 2; ++i) { int R, C; stage_rc(tid * 16 + i * 8192, R, C); const int Rb = Epi::PERM ? ((R & ~31) + perm32(R & 31)) : R;
        voffA[i] = (unsigned)(R * g.lda * ESZ + C * 2); voffB[i] = (unsigned)(Rb * g.ldb * ESZ + C * 2); gR[i] = R; gC2[i] = (unsigned)C * 2u; }
    unsigned gc0[2] = {voffA[0], voffA[1]}, gc1[2] = {voffA[0], voffA[1]};
    int gn0r[2] = {0, 0}, gn1r[2] = {0, 0};
    const size_t kstep = (size_t)(BK * 2);
    const size_t hstepA = GATHER ? (size_t)0 : (size_t)HALF * g.lda * ESZ, hstepB = (size_t)HALF * g.ldb * ESZ;
    const unsigned ldsw = (unsigned)wid * 1024u;
    const int aoff = lds_byte(wr * 64 + fr, FP8 ? fq * 16 : fq * 8), boff = lds_byte(wc * 32 + fr, FP8 ? fq * 16 : fq * 8);
    const int sel8 = FP8 ? ((fq & 1) << 4) : 0; const int aoff1 = aoff + sel8, aoff2 = aoff + 16 - sel8, boff1 = boff + sel8, boff2 = boff + 16 - sel8;
#define PG8_SA(b, h) (((b) * 2 + (h)) * HTB)
#define PG8_SB(b, h) ((4 + (b) * 2 + (h)) * HTB)
#define PG8_STAGE(bufoff, gbase, voff) do { _Pragma("unroll") for (int _i = 0; _i < 2; ++_i) \
        __builtin_amdgcn_global_load_lds((const unsigned*)((const char*)(gbase) + (voff)[_i]), (LAS unsigned*)(lds + (bufoff) + ldsw + _i * 8192), 16, 0, 0); } while (0)
#define PG8_CAT(p_, q_) __builtin_shufflevector(*(const LAS v4i*)(p_), *(const LAS v4i*)(q_), 0, 1, 2, 3, 4, 5, 6, 7)
#define PG8_LDA(dst, b, h) do { if constexpr (FP8) { _Pragma("unroll") for (int m = 0; m < 4; ++m) dst##8[m] = PG8_CAT(lds + PG8_SA(b, h) + aoff1 + m * 2048, lds + PG8_SA(b, h) + aoff2 + m * 2048); } \
        else { _Pragma("unroll") for (int m = 0; m < 4; ++m) _Pragma("unroll") for (int k = 0; k < 2; ++k) dst[m][k] = *(const LAS bf16x8*)(lds + PG8_SA(b, h) + aoff + m * 2048 + k * 1024); } } while (0)
#define PG8_LDB(dst, b, h) do { if constexpr (FP8) { _Pragma("unroll") for (int n = 0; n < 2; ++n) dst##8[n] = PG8_CAT(lds + PG8_SB(b, h) + boff1 + n * 2048, lds + PG8_SB(b, h) + boff2 + n * 2048); } \
        else { _Pragma("unroll") for (int n = 0; n < 2; ++n) _Pragma("unroll") for (int k = 0; k < 2; ++k) dst[n][k] = *(const LAS bf16x8*)(lds + PG8_SB(b, h) + boff + n * 2048 + k * 1024); } } while (0)
#define PG8_MMA(ai, bj, At, Bt) do { __builtin_amdgcn_s_setprio(1); \
        if constexpr (FP8) { _Pragma("unroll") for (int m = 0; m < 4; ++m) _Pragma("unroll") for (int n = 0; n < 2; ++n) \
            asm volatile("v_mfma_scale_f32_16x16x128_f8f6f4 %0, %1, %2, %0, %3, %4 op_sel_hi:[0,0,0]" : "+v"(acc[ai][bj][m][n]) : "v"(Bt##8[n]), "v"(At##8[m]), "v"(vsw), "v"(vsx)); } \
        else { _Pragma("unroll") for (int m = 0; m < 4; ++m) _Pragma("unroll") for (int n = 0; n < 2; ++n) _Pragma("unroll") for (int k = 0; k < 2; ++k) \
            acc[ai][bj][m][n] = __builtin_amdgcn_mfma_f32_16x16x32_bf16(Bt[n][k], At[m][k], acc[ai][bj][m][n], 0, 0, 0); } \
        __builtin_amdgcn_s_setprio(0); } while (0)
#define PG8_WAIT_V(n) asm volatile("s_waitcnt vmcnt(" #n ")" ::: "memory")
#define PG8_WAIT_L(n) asm volatile("s_waitcnt lgkmcnt(" #n ")" ::: "memory")
#define PG8_BAR __builtin_amdgcn_s_barrier()
#define PG8_SCHED __builtin_amdgcn_sched_barrier(0)
    Unit cur, nxt; int ui = 0;
    if (!S.next(0, cur)) return;
    f32x4 acc[2][2][4][2];
#pragma unroll
    for (int a = 0; a < 2; ++a)
#pragma unroll
        for (int b = 0; b < 2; ++b)
#pragma unroll
            for (int m = 0; m < 4; ++m)
#pragma unroll
                for (int n = 0; n < 2; ++n) acc[a][b][m][n] = (f32x4){0.f, 0.f, 0.f, 0.f};
    bf16x8 At[4][2], B0[2][2], B1[2][2];
    v8i At8[4], B08[2], B18[2];
    const int vsw = g.sw, vsx = g.sx;
    const char* cA = cur.A; const char* cB = cur.B;
    S.a_ready(cur);
    if constexpr (GATHER) {
#pragma unroll
        for (int i = 0; i < 2; ++i) { gc0[i] = (unsigned)selrow[cur.pm * 256 + gR[i]] * (unsigned)(g.lda * ESZ) + gC2[i]; gc1[i] = (unsigned)selrow[cur.pm * 256 + 128 + gR[i]] * (unsigned)(g.lda * ESZ) + gC2[i]; } }
    if constexpr (SP2) {
        PG8_STAGE(PG8_SB(0, 0), cB, voffB); PG8_STAGE(PG8_SB(0, 1), cB + hstepB, voffB); PG8_STAGE(PG8_SA(0, 0), cA, gc0); PG8_STAGE(PG8_SA(0, 1), cA + hstepA, gc1);
        if (wr == 1) PG8_BAR;
        PG8_WAIT_V(2); PG8_BAR;
        PG8_STAGE(PG8_SB(1, 0), cB + kstep, voffB); PG8_STAGE(PG8_SA(1, 0), cA + kstep, gc0); PG8_STAGE(PG8_SB(1, 1), cB + hstepB + kstep, voffB);
        PG8_WAIT_V(6); PG8_BAR;
    } else {
        PG8_STAGE(PG8_SB(0, 0), cB, voffB); PG8_STAGE(PG8_SA(0, 0), cA, voffA); PG8_STAGE(PG8_SB(0, 1), cB + hstepB, voffB); PG8_STAGE(PG8_SA(0, 1), cA + hstepA, voffA);
        if (wr == 1) PG8_BAR;
        PG8_WAIT_V(4); PG8_BAR;
        PG8_STAGE(PG8_SB(1, 0), cB + kstep, voffB); PG8_STAGE(PG8_SA(1, 0), cA + kstep, voffA); PG8_STAGE(PG8_SB(1, 1), cB + hstepB + kstep, voffB);
        PG8_WAIT_V(6); PG8_BAR;
    }
    for (;;) {
        const bool has_next = S.next(ui + 1, nxt);
        if constexpr (GATHER) { if (has_next) {
#pragma unroll
            for (int i = 0; i < 2; ++i) { gn0r[i] = selrow[nxt.pm * 256 + gR[i]]; gn1r[i] = selrow[nxt.pm * 256 + 128 + gR[i]]; } } }
        const char* nA = has_next ? nxt.A : cA; const char* nB = has_next ? nxt.B : cB;
#pragma unroll 1
        for (int t = 0; t < nt; t += 2) {
            const bool last = (t == nt - 2);
            const char* a1 = cA + (size_t)(t + 1) * kstep;
            const char* a2 = last ? nA : cA + (size_t)(t + 2) * kstep; const char* b2 = last ? nB : cB + (size_t)(t + 2) * kstep;
            const char* a3 = a2 + kstep; const char* b3 = b2 + kstep;
            if (last && has_next) S.a_ready(nxt);
            unsigned s0[2] = {gc0[0], gc0[1]}, s1[2] = {gc1[0], gc1[1]};
            if constexpr (GATHER) { if (last && has_next) { asm volatile("" : "+v"(gn0r[0]), "+v"(gn0r[1]), "+v"(gn1r[0]), "+v"(gn1r[1]));
#pragma unroll
                for (int i = 0; i < 2; ++i) { s0[i] = (unsigned)gn0r[i] * (unsigned)(g.lda * ESZ) + gC2[i]; s1[i] = (unsigned)gn1r[i] * (unsigned)(g.lda * ESZ) + gC2[i]; } } }
            if constexpr (SP2) {
            PG8_LDB(B0, 0, 0); PG8_LDB(B1, 0, 1); PG8_SCHED; PG8_LDA(At, 0, 0); PG8_STAGE(PG8_SA(1, 1), a1 + hstepA, gc1);
            PG8_WAIT_V(8); PG8_WAIT_L(0); PG8_BAR; PG8_MMA(0, 0, At, B0); PG8_MMA(0, 1, At, B1); PG8_BAR; PG8_SCHED;
            PG8_LDA(At, 0, 1); PG8_STAGE(PG8_SB(0, 0), b2, voffB); PG8_STAGE(PG8_SB(0, 1), b2 + hstepB, voffB); PG8_STAGE(PG8_SA(0, 0), a2, s0);
            PG8_WAIT_V(8); PG8_WAIT_L(0); PG8_BAR; PG8_MMA(1, 0, At, B0); PG8_MMA(1, 1, At, B1); PG8_BAR; PG8_SCHED;
            PG8_LDB(B0, 1, 0); PG8_LDB(B1, 1, 1); PG8_SCHED; PG8_LDA(At, 1, 0); PG8_STAGE(PG8_SA(0, 1), a2 + hstepA, s1);
            PG8_WAIT_V(8); PG8_WAIT_L(0); PG8_BAR; PG8_MMA(0, 0, At, B0); PG8_MMA(0, 1, At, B1); PG8_BAR; PG8_SCHED;
            PG8_LDA(At, 1, 1); PG8_STAGE(PG8_SB(1, 0), b3, voffB); PG8_STAGE(PG8_SB(1, 1), b3 + hstepB, voffB); PG8_STAGE(PG8_SA(1, 0), a3, s0);
            PG8_WAIT_V(8); PG8_WAIT_L(0); PG8_BAR; PG8_MMA(1, 0, At, B0); PG8_MMA(1, 1, At, B1); PG8_BAR; PG8_SCHED;
            } else {
            PG8_LDB(B0, 0, 0); PG8_SCHED; PG8_LDA(At, 0, 0); PG8_STAGE(PG8_SA(1, 1), a1 + hstepA, voffA);
            PG8_WAIT_L(8); PG8_BAR; PG8_WAIT_L(0); PG8_MMA(0, 0, At, B0); PG8_BAR; PG8_SCHED;
            PG8_LDB(B1, 0, 1); PG8_STAGE(PG8_SB(0, 0), b2, voffB);
            PG8_BAR; PG8_WAIT_L(0); PG8_MMA(0, 1, At, B1); PG8_BAR;
            PG8_LDA(At, 0, 1); PG8_STAGE(PG8_SA(0, 0), a2, voffA);
            PG8_BAR; PG8_WAIT_L(0); PG8_MMA(1, 0, At, B0); PG8_BAR; PG8_SCHED;
            PG8_STAGE(PG8_SB(0, 1), b2 + hstepB, voffB);
            PG8_WAIT_V(6); PG8_BAR; PG8_MMA(1, 1, At, B1); PG8_BAR;
            PG8_LDB(B0, 1, 0); PG8_SCHED; PG8_LDA(At, 1, 0); PG8_STAGE(PG8_SA(0, 1), a2 + hstepA, voffA);
            PG8_WAIT_L(8); PG8_BAR; PG8_WAIT_L(0); PG8_MMA(0, 0, At, B0); PG8_BAR; PG8_SCHED;
            PG8_LDB(B1, 1, 1); PG8_STAGE(PG8_SB(1, 0), b3, voffB);
            PG8_BAR; PG8_WAIT_L(0); PG8_MMA(0, 1, At, B1); PG8_BAR;
            PG8_LDA(At, 1, 1); PG8_STAGE(PG8_SA(1, 0), a3, voffA);
            PG8_BAR; PG8_WAIT_L(0); PG8_MMA(1, 0, At, B0); PG8_BAR; PG8_SCHED;
            PG8_STAGE(PG8_SB(1, 1), b3 + hstepB, voffB);
            PG8_WAIT_V(6); PG8_BAR; PG8_MMA(1, 1, At, B1); PG8_BAR;
            }
        }
        if constexpr (ALIGN_EPI) { if (wr == 0) PG8_BAR; }
        if constexpr (FP8) asm volatile("s_nop 7\n\ts_nop 7\n\ts_nop 3" ::: "memory");
        E(acc, cur, wr, wc, fr, fq); S.done(cur);
        if (!has_next) break;
#pragma unroll
        for (int a = 0; a < 2; ++a)
#pragma unroll
            for (int b = 0; b < 2; ++b)
#pragma unroll
                for (int m = 0; m < 4; ++m)
#pragma unroll
                    for (int n = 0; n < 2; ++n) acc[a][b][m][n] = (f32x4){0.f, 0.f, 0.f, 0.f};
        cur = nxt; cA = nA; cB = nB; ++ui;
        if constexpr (GATHER) {
#pragma unroll
            for (int i = 0; i < 2; ++i) { gc0[i] = (unsigned)gn0r[i] * (unsigned)(g.lda * ESZ) + gC2[i]; gc1[i] = (unsigned)gn1r[i] * (unsigned)(g.lda * ESZ) + gC2[i]; } }
        if constexpr (ALIGN_EPI) { if (wr == 1) PG8_BAR; }
    }
    PG8_WAIT_V(0);
    if constexpr (!ALIGN_EPI) { if (wr == 0) PG8_BAR; }
    PG8_BAR;
#undef PG8_SA
#undef PG8_SB
#undef PG8_STAGE
#undef PG8_LDA
#undef PG8_LDB
#undef PG8_MMA
#undef PG8_CAT
#undef PG8_WAIT_V
#undef PG8_WAIT_L
#undef PG8_BAR
#undef PG8_SCHED
}
}
using pg8::Unit;

#define XB_TMO      128
#define XB_XCNT(j)  (256  + 64 * (j))
#define XB_XSUB(j)  (1280 + 64 * (j))
#define XB_XGEN(j)  (2304 + 64 * (j))
#define XB_TOP      3328
#define XB_TOPGEN   3392
#define XCD_BAR_WORDS 3456
#define XB_SPIN_CAP (1u << 18)

__device__ __forceinline__ unsigned xb_ld(unsigned* p)              { return __hip_atomic_load(p, __ATOMIC_RELAXED, __HIP_MEMORY_SCOPE_AGENT); }
__device__ __forceinline__ unsigned xb_add(unsigned* p, unsigned v) { return __hip_atomic_fetch_add(p, v, __ATOMIC_RELAXED, __HIP_MEMORY_SCOPE_AGENT); }
__device__ __forceinline__ unsigned xb_xcc_id() { return (unsigned)__builtin_amdgcn_s_getreg((3 << 11) | 20) & 0xFu; }
#define XB_SPIN(cond, bar) do { unsigned _sp = 0; while (cond) { __builtin_amdgcn_s_sleep(1); \
    if ((++_sp & 255u) == 0u) { if (xb_ld(&(bar)[XB_TMO])) break; if (_sp > XB_SPIN_CAP) { atomicAdd(&(bar)[XB_TMO], 1u); break; } } } } while (0)

struct XcdBarrier {
    unsigned* bar; unsigned x;
    volatile LAS unsigned* st;
};

__device__ __forceinline__ XcdBarrier xcd_barrier_post(unsigned* bar, volatile LAS unsigned* st) {
    XcdBarrier b; b.bar = bar; b.x = xb_xcc_id(); b.st = st;
    if (threadIdx.x == 0) (void)xb_add(&bar[XB_XCNT(b.x)], 1u);
    return b;
}
__device__ __forceinline__ void xcd_barrier_complete(unsigned* bar, unsigned x, unsigned& nloc, unsigned& nx) {
    const unsigned G = gridDim.x * gridDim.y * gridDim.z;
    unsigned sum, cnt, mine, sp = 0u;
    for (;;) {
        sum = 0u; cnt = 0u; mine = 0u;
#pragma unroll
        for (unsigned j = 0; j < 16; ++j) { const unsigned c = xb_ld(&bar[XB_XCNT(j)]); sum += c; cnt += (c > 0u) ? 1u : 0u; mine = (j == x) ? c : mine; }
        if (sum == G) break;
        __builtin_amdgcn_s_sleep(1);
        if ((++sp & 255u) == 0u) { if (xb_ld(&bar[XB_TMO])) break; if (sp > XB_SPIN_CAP) { atomicAdd(&bar[XB_TMO], 1u); break; } }
    }
    nloc = mine > 0u ? mine : 1u; nx = cnt > 0u ? cnt : 1u;
}

__device__ __forceinline__ void xcd_barrier(const XcdBarrier& b) {
    asm volatile("s_waitcnt vmcnt(0)" ::: "memory");
    __syncthreads();
    if (threadIdx.x == 0) {
        unsigned* bar = b.bar;
        __builtin_amdgcn_s_waitcnt(0);
        unsigned nloc = b.st[0], nx = b.st[1];
        if (nloc == 0u) { xcd_barrier_complete(bar, b.x, nloc, nx); b.st[0] = nloc; b.st[1] = nx; }
        const unsigned old = xb_add(&bar[XB_XSUB(b.x)], 1u);
        const unsigned gen = old / nloc;
        if (old + 1u == (gen + 1u) * nloc) {
            __builtin_amdgcn_fence(__ATOMIC_RELEASE, "agent");
            asm volatile("s_waitcnt vmcnt(0)" ::: "memory");
            const unsigned og = xb_add(&bar[XB_TOP], 1u);
            const unsigned tg = og / nx;
            if (og + 1u == (tg + 1u) * nx) xb_add(&bar[XB_TOPGEN], 1u);
            else XB_SPIN(xb_ld(&bar[XB_TOPGEN]) == tg, bar);
            __builtin_amdgcn_fence(__ATOMIC_ACQUIRE, "agent");
            xb_add(&bar[XB_XGEN(b.x)], 1u);
            asm volatile("s_waitcnt vmcnt(0)" ::: "memory");
        } else {
            XB_SPIN(xb_ld(&bar[XB_XGEN(b.x)]) == gen, bar);
            __builtin_amdgcn_fence(__ATOMIC_ACQUIRE, "agent");
            asm volatile("s_waitcnt vmcnt(0)" ::: "memory");
        }
    }
    __syncthreads();
}

__device__ __forceinline__ unsigned pk4_fp8(float a, float b, float c, float d) { int w = 0; w = __builtin_amdgcn_cvt_pk_fp8_f32(a, b, w, false); w = __builtin_amdgcn_cvt_pk_fp8_f32(c, d, w, true); return (unsigned)w; }
#define EPI_SIG const f32x4 (&acc)[2][2][4][2], const Unit& u, int wr, int wc, int fr, int fq
struct EpiZ { static constexpr bool PERM = true; bf16* ZB; float* ZF;
    __device__ __forceinline__ void operator()(EPI_SIG) const {
        const int row0 = u.pm * 256 + wr * 64 + fr;
        if (u.pn < 11) {
            const int col0 = u.pn * 256 + wc * 32 + 8 * fq;
#pragma unroll
            for (int ai = 0; ai < 2; ++ai)
#pragma unroll
                for (int m = 0; m < 4; ++m) { bf16* rowp = ZB + (size_t)(row0 + ai * 128 + m * 16) * NZB + col0;
#pragma unroll
                    for (int bj = 0; bj < 2; ++bj) { const f32x4 v0 = acc[ai][bj][m][0], v1 = acc[ai][bj][m][1]; v4u w; w.x = cvt_pk_bf16(v0[0], v0[1]); w.y = cvt_pk_bf16(v0[2], v0[3]); w.z = cvt_pk_bf16(v1[0], v1[1]); w.w = cvt_pk_bf16(v1[2], v1[3]);
                        *(v4u*)(rowp + bj * 128) = w; } }
        } else {
            const int col0 = (u.pn - 11) * 256 + wc * 32 + 8 * fq;
#pragma unroll
            for (int ai = 0; ai < 2; ++ai)
#pragma unroll
                for (int m = 0; m < 4; ++m) { float* rowp = ZF + (size_t)(row0 + ai * 128 + m * 16) * NZF + col0;
#pragma unroll
                    for (int bj = 0; bj < 2; ++bj) { *(f32x4*)(rowp + bj * 128) = acc[ai][bj][m][0]; *(f32x4*)(rowp + bj * 128 + 4) = acc[ai][bj][m][1]; } }
        }
    }
};
struct EpiBf { static constexpr bool PERM = true; bf16* O; int ldc; const float* roww;
    __device__ __forceinline__ void operator()(EPI_SIG) const {
        const int row0 = u.pm * 256 + wr * 64 + fr, col0 = u.pn * 256 + wc * 32 + 8 * fq;
#pragma unroll
        for (int ai = 0; ai < 2; ++ai)
#pragma unroll
            for (int m = 0; m < 4; ++m) { const int row = row0 + ai * 128 + m * 16; const float s = roww ? roww[row] : 1.0f; bf16* rowp = O + (size_t)row * ldc + col0;
#pragma unroll
                for (int bj = 0; bj < 2; ++bj) { const f32x4 v0 = acc[ai][bj][m][0] * s, v1 = acc[ai][bj][m][1] * s; v4u w; w.x = cvt_pk_bf16(v0[0], v0[1]); w.y = cvt_pk_bf16(v0[2], v0[3]); w.z = cvt_pk_bf16(v1[0], v1[1]); w.w = cvt_pk_bf16(v1[2], v1[3]);
                    *(v4u*)(rowp + bj * 128) = w; } }
    }
};
struct EpiFour1 { static constexpr bool PERM = true; bf16* VTL; bf16* VTC;
    __device__ __forceinline__ void operator()(EPI_SIG) const {
        bf16* base; int ldc;
        if (u.pn < 128) { const int b = u.pn >> 3, t0 = (u.pn & 7) * 256; base = VTL + (size_t)b * 256 * 4096 + u.pm * 2048 + t0; ldc = 4096; }
        else { const int b = u.pn - 128; base = VTC + (size_t)b * 256 * 512 + u.pm * 256; ldc = 512; }
        const int r0 = wr * 64 + fr, col0 = wc * 32 + 8 * fq;
#pragma unroll
        for (int ai = 0; ai < 2; ++ai)
#pragma unroll
            for (int m = 0; m < 4; ++m) { bf16* rowp = base + (size_t)(r0 + ai * 128 + m * 16) * ldc + col0;
#pragma unroll
                for (int bj = 0; bj < 2; ++bj) { const f32x4 v0 = acc[ai][bj][m][0], v1 = acc[ai][bj][m][1]; v4u w; w.x = cvt_pk_bf16(v0[0], v0[1]); w.y = cvt_pk_bf16(v0[2], v0[3]); w.z = cvt_pk_bf16(v1[0], v1[1]); w.w = cvt_pk_bf16(v1[2], v1[3]);
                    *(v4u*)(rowp + bj * 128) = w; } }
    }
};
struct EpiF32 { static constexpr bool PERM = false; float* C; int ldc;
    __device__ __forceinline__ void operator()(EPI_SIG) const {
        const int row0 = u.pm * 256 + wr * 64 + fr, col0 = u.pn * 256 + wc * 32 + 4 * fq;
#pragma unroll
        for (int ai = 0; ai < 2; ++ai)
#pragma unroll
            for (int m = 0; m < 4; ++m) { float* rowp = C + (size_t)(row0 + ai * 128 + m * 16) * ldc + col0;
#pragma unroll
                for (int bj = 0; bj < 2; ++bj)
#pragma unroll
                    for (int n = 0; n < 2; ++n) *(f32x4*)(rowp + bj * 128 + n * 16) = acc[ai][bj][m][n]; }
    }
};
struct EpiFourT { static constexpr bool PERM = false; float* FO; int ctx;
    __device__ __forceinline__ void operator()(EPI_SIG) const {
        float* base = ctx ? FO + (size_t)(ML + u.pn * 256) * 256 : FO + (size_t)(u.pn & 1) * MT * 256 + (size_t)((u.pn >> 1) * 2048 + u.pm * 256) * 256;
        const int r0 = wr * 64 + fr, col0 = wc * 32 + 4 * fq;
#pragma unroll
        for (int ai = 0; ai < 2; ++ai)
#pragma unroll
            for (int m = 0; m < 4; ++m) { float* rowp = base + (size_t)(r0 + ai * 128 + m * 16) * 256 + col0;
#pragma unroll
                for (int bj = 0; bj < 2; ++bj)
#pragma unroll
                    for (int n = 0; n < 2; ++n) *(f32x4*)(rowp + bj * 128 + n * 16) = acc[ai][bj][m][n]; }
    }
};
struct EpiP { static constexpr bool PERM = true; bf16* P2;
    __device__ __forceinline__ void operator()(EPI_SIG) const {
        const int g = u.pn >> 2, ct = u.pn & 3;
#pragma unroll
        for (int ai = 0; ai < 2; ++ai)
#pragma unroll
            for (int m = 0; m < 4; ++m)
#pragma unroll
                for (int bj = 0; bj < 2; ++bj) { const int pn = ct * 4 + bj * 2 + (wc >> 1), wave_m = wr * 4 + (wc & 1) * 2 + (fq >> 1);
#pragma unroll
                    for (int n = 0; n < 2; ++n) { const int lane_m = ((fq & 1) * 2 + n) * 16 + fr; const f32x4 v = acc[ai][bj][m][n];
                        v2u w; w.x = cvt_pk_bf16(v[0], v[1]); w.y = cvt_pk_bf16(v[2], v[3]);
                        *(v2u*)(P2 + ((((((size_t)u.pm * 16 + pn) * 2 + ai) * 4 + m) * 8 + wave_m) * 4 + g) * 256 + lane_m * 4) = w; } }
    }
};
struct EpiMerge { static constexpr bool PERM = false; const bf16* P; bf16* T; const float* bg;
    __device__ __forceinline__ void operator()(EPI_SIG) const {
        const int row0 = u.pm * 256 + wr * 64 + fr, oc = u.pn * 64 + wc * 16 + 4 * fq;
        f32x4 bv[4];
#pragma unroll
        for (int g = 0; g < 4; ++g) bv[g] = *(const f32x4*)(bg + g * 1024 + oc);
#pragma unroll
        for (int ai = 0; ai < 2; ++ai)
#pragma unroll
            for (int m = 0; m < 4; ++m) { const int row = row0 + ai * 128 + m * 16; const bf16* prow = P + (((((size_t)u.pm * 16 + u.pn) * 2 + ai) * 4 + m) * 8 + (wr * 4 + wc)) * 1024 + (fq * 16 + fr) * 4;
                v2u pw[4];
#pragma unroll
                for (int g = 0; g < 4; ++g) pw[g] = *(const v2u*)(prow + g * 256);
                f32x4 t = (f32x4){0.f, 0.f, 0.f, 0.f};
#pragma unroll
                for (int bj = 0; bj < 2; ++bj)
#pragma unroll
                    for (int n = 0; n < 2; ++n) { const int g = 2 * bj + n; const f32x4 a = acc[ai][bj][m][n] + bv[g];
                        t[0] += sigmoid_fast(a[0]) * bf2f(pw[g].x & 0xffffu); t[1] += sigmoid_fast(a[1]) * bf2f(pw[g].x >> 16);
                        t[2] += sigmoid_fast(a[2]) * bf2f(pw[g].y & 0xffffu); t[3] += sigmoid_fast(a[3]) * bf2f(pw[g].y >> 16); }
                v2u w; w.x = cvt_pk_bf16(t[0], t[1]); w.y = cvt_pk_bf16(t[2], t[3]);
                *(v2u*)(T + (size_t)row * 1024 + oc) = w; }
    }
};
struct EpiSwiGLU { static constexpr bool PERM = true; unsigned char* HID;
    __device__ __forceinline__ void operator()(EPI_SIG) const {
        const int row0 = u.pm * 256 + wr * 64 + fr, col0 = u.pn * 128 + wc * 32 + 8 * fq;
#pragma unroll
        for (int ai = 0; ai < 2; ++ai)
#pragma unroll
            for (int m = 0; m < 4; ++m) { unsigned char* rowp = HID + (size_t)(row0 + ai * 128 + m * 16) * 1024 + col0; float o[8];
#pragma unroll
                for (int n = 0; n < 2; ++n)
#pragma unroll
                    for (int j = 0; j < 4; ++j) { const float gv = acc[ai][0][m][n][j], uv = acc[ai][1][m][n][j]; o[4 * n + j] = fminf(fmaxf(gv * sigmoid_fast(gv) * uv, -448.f), 448.f); }
                v2u w; w.x = pk4_fp8(o[0], o[1], o[2], o[3]); w.y = pk4_fp8(o[4], o[5], o[6], o[7]);
                *(v2u*)rowp = w; }
    }
};
struct EpiZB { static constexpr bool PERM = true; bf16* O;
    __device__ __forceinline__ void operator()(EPI_SIG) const {
        const int row0 = u.pm * 256 + wr * 64 + fr, col0 = u.pn * 256 + wc * 32 + 8 * fq; const bool sl = (u.pn == 0);
#pragma unroll
        for (int ai = 0; ai < 2; ++ai)
#pragma unroll
            for (int m = 0; m < 4; ++m) { bf16* rowp = O + (size_t)(row0 + ai * 128 + m * 16) * NZB + col0;
#pragma unroll
                for (int bj = 0; bj < 2; ++bj) { f32x4 v0 = acc[ai][bj][m][0], v1 = acc[ai][bj][m][1];
                    if (sl) {
#pragma unroll
                        for (int t = 0; t < 4; ++t) { v0[t] *= sigmoid_fast(v0[t]); v1[t] *= sigmoid_fast(v1[t]); } }
                    v4u w; w.x = cvt_pk_bf16(v0[0], v0[1]); w.y = cvt_pk_bf16(v0[2], v0[3]); w.z = cvt_pk_bf16(v1[0], v1[1]); w.w = cvt_pk_bf16(v1[2], v1[3]);
                    *(v4u*)(rowp + bj * 128) = w; } }
    }
};
struct EpiZF { static constexpr bool PERM = false; float* C; const float* lb;
    __device__ __forceinline__ void operator()(EPI_SIG) const {
        const int row0 = u.pm * 256 + wr * 64 + fr, cc = wc * 32 + 4 * fq;
        f32x4 lbv[2][2];
#pragma unroll
        for (int bj = 0; bj < 2; ++bj)
#pragma unroll
            for (int n = 0; n < 2; ++n) lbv[bj][n] = (u.pn < 2) ? *(const f32x4*)(lb + u.pn * 1024 + cc + bj * 128 + n * 16) : (f32x4){0.f, 0.f, 0.f, 0.f};
#pragma unroll
        for (int ai = 0; ai < 2; ++ai)
#pragma unroll
            for (int m = 0; m < 4; ++m) { float* rowp = C + (size_t)(row0 + ai * 128 + m * 16) * NZF + u.pn * 256 + cc;
#pragma unroll
                for (int bj = 0; bj < 2; ++bj)
#pragma unroll
                    for (int n = 0; n < 2; ++n) { f32x4 v = acc[ai][bj][m][n];
                        if (u.pn < 2) {
#pragma unroll
                            for (int t = 0; t < 4; ++t) v[t] = __logf(fmaxf(lbv[bj][n][t] + (1.0f - lbv[bj][n][t]) * sigmoid_fast(v[t]), 1e-30f)); }
                        if (u.pn < 2 || (bj == 0 && wc == 0 && (n == 0 || fq < 2))) *(f32x4*)(rowp + bj * 128 + n * 16) = v; } }
    }
};
struct EpiF8 { static constexpr bool PERM = true; unsigned char* O; const float* roww;
    __device__ __forceinline__ void operator()(EPI_SIG) const {
        const int row0 = u.pm * 256 + wr * 64 + fr, col0 = u.pn * 256 + wc * 32 + 8 * fq;
#pragma unroll
        for (int ai = 0; ai < 2; ++ai)
#pragma unroll
            for (int m = 0; m < 4; ++m) { const int row = row0 + ai * 128 + m * 16; const float s = roww[row] * 64.0f; unsigned char* rowp = O + (size_t)row * 1024 + col0;
#pragma unroll
                for (int bj = 0; bj < 2; ++bj) { const f32x4 v0 = acc[ai][bj][m][0] * s, v1 = acc[ai][bj][m][1] * s; v2u w;
                    w.x = pk4_fp8(fminf(fmaxf(v0[0], -448.f), 448.f), fminf(fmaxf(v0[1], -448.f), 448.f), fminf(fmaxf(v0[2], -448.f), 448.f), fminf(fmaxf(v0[3], -448.f), 448.f));
                    w.y = pk4_fp8(fminf(fmaxf(v1[0], -448.f), 448.f), fminf(fmaxf(v1[1], -448.f), 448.f), fminf(fmaxf(v1[2], -448.f), 448.f), fminf(fmaxf(v1[3], -448.f), 448.f));
                    *(v2u*)(rowp + bj * 128) = w; } }
    }
};
struct MapPlain { const char* A; const char* B; size_t sa, sb; __device__ __forceinline__ void operator()(Unit& u) const { u.A = A + (size_t)u.pm * sa; u.B = B + (size_t)u.pn * sb; } };
struct MapP { const char* OUTS; const char* WBR; __device__ __forceinline__ void operator()(Unit& u) const { const int g = u.pn >> 2; u.A = OUTS + (size_t)u.pm * (256 * 1024 * 2) + g * 512; u.B = WBR + (size_t)g * (1024 * 256 * 2) + (size_t)(u.pn & 3) * (256 * 256 * 2); } };
struct MapFourT { const char* DFTL; const char* VTL; __device__ __forceinline__ void operator()(Unit& u) const { const int kh = u.pn & 1; u.A = DFTL + (size_t)u.pm * (256 * 4096 * 2) + kh * 4096; u.B = VTL + (size_t)(u.pn >> 1) * (256 * 4096 * 2) + kh * 4096; } };
struct MapMoE { const char* A; const char* W; size_t se, st; __device__ __forceinline__ void operator()(Unit& u) const { const int e = u.pm < 256 ? (u.pm >> 4) : ((u.pm - 256) >> 1); u.A = A + (size_t)u.pm * st; u.B = W + (size_t)e * se + (size_t)u.pn * st; } };
struct MapMoEG { const char* A; const char* W; size_t se, st; __device__ __forceinline__ void operator()(Unit& u) const { const int e = u.pm < 256 ? (u.pm >> 4) : ((u.pm - 256) >> 1); u.A = A; u.B = W + (size_t)e * se + (size_t)u.pn * st; } };
struct Args { const float* in[31]; float* out; unsigned char* ws; int ph_lo, ph_hi, li, pad; };
enum { I_X = 0, I_C, I_CTX, I_CCTX, I_ADAW, I_ADAB, I_WIN, I_LBLOG, I_HGRN_NW, I_GDN_CW, I_GDN_ALOG, I_GDN_DTB, I_GDN_NW, I_SSD_CW, I_SSD_CB, I_SSD_ALOG, I_SSD_DTB, I_SSD_D, I_SSD_NW,
       I_WGATE, I_BGATE, I_WBR, I_WOUT, I_LN1G, I_LN1B, I_WROUTER, I_WFFG, I_WFFU, I_WFFD, I_LN2G, I_LN2B };
struct WCtx { int tid, lane, wave, bid, G, gw, NGW; };

__device__ __forceinline__ float dpp_xor1(float x) { return __int_as_float(__builtin_amdgcn_mov_dpp(__float_as_int(x), 0xB1, 0xf, 0xf, true)); }
__device__ __forceinline__ float dpp_xor2(float x) { return __int_as_float(__builtin_amdgcn_mov_dpp(__float_as_int(x), 0x4E, 0xf, 0xf, true)); }
__device__ __forceinline__ int zrow(int n) {
    if (n < 256) return n;
    if (n < 512) return 11 * 256 + (n - 256);
    if (n < 768) return 12 * 256 + (n - 512);
    if (n < 1024) return 1 * 256 + (n - 768);
    if (n < 1280) return 2 * 256 + (n - 1024);
    if (n < 2048) return 3 * 256 + (n - 1280);
    if (n < 2304) return 6 * 256 + (n - 2048);
    if (n < 2312) return 13 * 256 + (n - 2304);
    if (n < 2320) return 13 * 256 + 8 + (n - 2312);
    if (n < 2576) return 7 * 256 + (n - 2320);
    if (n < 3088) return 8 * 256 + (n - 2576);
    if (n < 3344) return 10 * 256 + (n - 3088);
    return 13 * 256 + 16 + (n - 3344);
}
__device__ __forceinline__ int rowmap(int mode, int aux, int n) {
    if (mode == 0) return n;
    if (mode == 1) return zrow(n);
    if (mode == 2) return 256 * (n >> 6) + 128 * (aux >> 1) + 32 * ((n & 63) >> 4) + 16 * (aux & 1) + (n & 15);
    if (mode == 3) return 256 * (n >> 7) + (n & 127);
    return 256 * (n >> 7) + 128 + (n & 127);
}
__device__ __forceinline__ void transpose_item(const float* W, int N, bf16* WT, int ldt, LAS unsigned* scr, int item, int lane, int mode, int aux) {
    const int nblk = (N + 63) >> 6, kb = item / nblk, nb = item - kb * nblk, k0 = 64 * kb, n0 = 64 * nb;
    const int ncol = n0 + lane; const bool okc = ncol < N;
    const float* wp = W + (size_t)k0 * N + (okc ? ncol : 0);
    float v[64];
#pragma unroll
    for (int i = 0; i < 64; ++i) v[i] = wp[(size_t)i * N];
#pragma unroll
    for (int i = 0; i < 32; ++i) scr[i * 65 + lane] = okc ? pk2(v[2 * i], v[2 * i + 1]) : 0u;
    LDS_WAIT();
    const int c = lane & 7;
#pragma unroll
    for (int j = 0; j < 8; ++j) { const int nn = (lane >> 3) + 8 * j, n = n0 + nn;
        v4u o; o.x = scr[(4 * c + 0) * 65 + nn]; o.y = scr[(4 * c + 1) * 65 + nn]; o.z = scr[(4 * c + 2) * 65 + nn]; o.w = scr[(4 * c + 3) * 65 + nn];
        if (n < N) *(v4u*)(WT + (size_t)rowmap(mode, aux, n) * ldt + k0 + 8 * c) = o; }
    LDS_WAIT();
}
__device__ __forceinline__ void transpose_item8(const float* W, int N, unsigned char* WT, int ldt, int item, int lane, int mode, int aux) {
    const int nblk = (N + 63) >> 6, kb = item / nblk, nb = item - kb * nblk, k0 = 64 * kb, n0 = 64 * nb;
    const int ncol = n0 + lane;
    const float* wp = W + (size_t)k0 * N + ncol;
    float v[64];
#pragma unroll
    for (int i = 0; i < 64; ++i) v[i] = wp[(size_t)i * N];
    unsigned o[16];
#pragma unroll
    for (int q = 0; q < 16; ++q) o[q] = pk4_fp8(fminf(fmaxf(v[4 * q] * 64.f, -448.f), 448.f), fminf(fmaxf(v[4 * q + 1] * 64.f, -448.f), 448.f), fminf(fmaxf(v[4 * q + 2] * 64.f, -448.f), 448.f), fminf(fmaxf(v[4 * q + 3] * 64.f, -448.f), 448.f));
    v4u* dst = (v4u*)(WT + (size_t)rowmap(mode, aux, ncol) * ldt + k0);
#pragma unroll
    for (int q = 0; q < 4; ++q) dst[q] = (v4u){o[4 * q], o[4 * q + 1], o[4 * q + 2], o[4 * q + 3]};
}
constexpr int WI_IN = 16 * 53, WI_G = 4 * 256, WI_BR = 4 * 64, WI_OUT = 256, WI_FF = 16 * 256;
constexpr int WI_REST = WI_G + WI_BR + WI_OUT + 3 * WI_FF;
constexpr int WI_XA = 9216, WI_XB = 10368;
__device__ __forceinline__ void convert_win(const Args& a, LAS unsigned char* lds, int wave, int lane, int gw, int ngw, int l) {
    LAS unsigned* scr = (LAS unsigned*)(lds + wave * 8448);
    for (int it = gw; it < WI_IN; it += ngw) transpose_item(a.in[I_WIN] + (size_t)l * 1024 * IN_COLS, IN_COLS, (bf16*)(a.ws + WS_WIN), 1024, scr, it, lane, 1, 0);
}
__device__ __forceinline__ void convert_rest(const Args& a, LAS unsigned char* lds, int wave, int lane, int gw, int ngw, int l, int it0, int it1) {
    LAS unsigned* scr = (LAS unsigned*)(lds + wave * 8448);
    unsigned char* ws = a.ws;
    for (int it = it0 + gw; it < it1; it += ngw) {
        int r = it;
        if (r < WI_G) { const int g = r >> 8; transpose_item8(a.in[I_WGATE] + (size_t)(l * 4 + g) * 1024 * 1024, 1024, ws + WS_WG, 1024, r & 255, lane, 2, g); continue; } r -= WI_G;
        if (r < WI_BR) { const int g = r >> 6; transpose_item(a.in[I_WBR] + (size_t)(l * 4 + g) * 256 * 1024, 1024, (bf16*)(ws + WS_WBR) + (size_t)g * 1024 * 256, 256, scr, r & 63, lane, 0, 0); continue; } r -= WI_BR;
        if (r < WI_OUT) { transpose_item(a.in[I_WOUT] + (size_t)l * 1024 * 1024, 1024, (bf16*)(ws + WS_WOUT), 1024, scr, r, lane, 0, 0); continue; } r -= WI_OUT;
        if (r < WI_FF) { const int e = r >> 8; transpose_item8(a.in[I_WFFG] + (size_t)(l * 16 + e) * 1024 * 1024, 1024, ws + WS_WGU + (size_t)e * 2048 * 1024, 1024, r & 255, lane, 3, 0); continue; } r -= WI_FF;
        if (r < WI_FF) { const int e = r >> 8; transpose_item8(a.in[I_WFFU] + (size_t)(l * 16 + e) * 1024 * 1024, 1024, ws + WS_WGU + (size_t)e * 2048 * 1024, 1024, r & 255, lane, 4, 0); continue; } r -= WI_FF;
        { const int e = r >> 8; transpose_item8(a.in[I_WFFD] + (size_t)(l * 16 + e) * 1024 * 1024, 1024, ws + WS_WDN + (size_t)e * 1024 * 1024, 1024, r & 255, lane, 0, 0); }
    }
}

__device__ __forceinline__ void row_load(const float* p, int lane, f32x4 (&v)[4]) { const f32x4* xr = (const f32x4*)p + lane;
#pragma unroll
    for (int j = 0; j < 4; ++j) v[j] = xr[64 * j]; }
__device__ __forceinline__ void row_store(float* p, int lane, const f32x4 (&v)[4]) { f32x4* xr = (f32x4*)p + lane;
#pragma unroll
    for (int j = 0; j < 4; ++j) xr[64 * j] = v[j]; }
__device__ __forceinline__ void ln_stats(const f32x4 (&v)[4], float& mean, float& rstd) {
    float s = 0.f;
#pragma unroll
    for (int j = 0; j < 4; ++j) s += (v[j][0] + v[j][1]) + (v[j][2] + v[j][3]);
    mean = wave_sum(s) * (1.f / 1024.f); float q = 0.f;
#pragma unroll
    for (int j = 0; j < 4; ++j) { const f32x4 d = v[j] - mean; q += (d[0] * d[0] + d[1] * d[1]) + (d[2] * d[2] + d[3] * d[3]); }
    rstd = 1.0f / sqrtf(wave_sum(q) * (1.f / 1024.f) + LN_EPS);
}
__device__ __forceinline__ unsigned pk4c_fp8(f32x4 v) { return pk4_fp8(fminf(fmaxf(v[0], -448.f), 448.f), fminf(fmaxf(v[1], -448.f), 448.f), fminf(fmaxf(v[2], -448.f), 448.f), fminf(fmaxf(v[3], -448.f), 448.f)); }
__device__ __forceinline__ void modulate_row(const f32x4 (&v)[4], const float* sh, const float* sc, bf16* hrow, unsigned* h8row, int lane, f32x4 (&hv)[4]) {
    float mean, rstd; ln_stats(v, mean, rstd);
#pragma unroll
    for (int j = 0; j < 4; ++j) { const f32x4 s = *((const f32x4*)sc + lane + 64 * j), t = *((const f32x4*)sh + lane + 64 * j);
        hv[j] = (v[j] - mean) * rstd * (s + 1.0f) + t;
        v2u w; w.x = cvt_pk_bf16(hv[j][0], hv[j][1]); w.y = cvt_pk_bf16(hv[j][2], hv[j][3]); *((v2u*)hrow + lane + 64 * j) = w; h8row[lane + 64 * j] = pk4c_fp8(hv[j]); }
}
__device__ __forceinline__ const float* mod_ptr(const Args& a, int l, int row, int chunk) { const int r = row < ML ? (row >> 11) : 16; return (const float*)(a.ws + WS_MOD) + ((size_t)(l * 17 + r) * 6144 + chunk * 1024); }

__device__ __forceinline__ void phase_prologue(const Args& a, LAS unsigned char* lds, const WCtx& w) {
    {
        LAS float* SC = (LAS float*)lds; LAS float* RED = (LAS float*)(lds + 17 * 1024 * 4);
        for (int i = w.tid; i < 17 * 1024; i += NTHREADS) { const int r = i >> 10, k = i & 1023; const float v = r < 16 ? a.in[I_C][r * 1024 + k] : a.in[I_CCTX][k]; SC[i] = silu_acc(v); }
        __syncthreads();
        float* MOD = (float*)(a.ws + WS_MOD);
        for (int it = w.bid; it < 4 * 96; it += w.G) {
            const int l = it / 96, cg = it - l * 96;
            const float* wp = a.in[I_ADAW] + (size_t)l * 1024 * 6144 + cg * 64 + w.lane;
            float acc[17];
#pragma unroll
            for (int r = 0; r < 17; ++r) acc[r] = 0.f;
            const int k0 = w.wave * 128;
            const float* wq = wp + (size_t)k0 * 6144;
            float a0 = wq[0], a1 = wq[6144], a2 = wq[2 * 6144], a3 = wq[3 * 6144], b0 = wq[4 * 6144], b1 = wq[5 * 6144], b2 = wq[6 * 6144], b3 = wq[7 * 6144];
#pragma unroll 1
            for (int k = k0; k < k0 + 128; k += 4) {
                const float w0 = a0, w1 = a1, w2 = a2, w3 = a3; a0 = b0; a1 = b1; a2 = b2; a3 = b3;
                if (k + 8 < k0 + 128) { const float* wn = wp + (size_t)(k + 8) * 6144; b0 = wn[0]; b1 = wn[6144]; b2 = wn[2 * 6144]; b3 = wn[3 * 6144]; }
#pragma unroll
                for (int r = 0; r < 17; ++r) { const f32x4 s = *(const LAS f32x4*)(SC + r * 1024 + k); acc[r] += (s[0] * w0 + s[1] * w1) + (s[2] * w2 + s[3] * w3); }
            }
#pragma unroll
            for (int r = 0; r < 17; ++r) RED[(w.wave * 17 + r) * 64 + w.lane] = acc[r];
            __syncthreads();
            for (int i = w.tid; i < 17 * 64; i += NTHREADS) { const int r = i >> 6, col = i & 63; float s = 0.f;
#pragma unroll
                for (int q = 0; q < 8; ++q) s += RED[(q * 17 + r) * 64 + col];
                MOD[(size_t)(l * 17 + r) * 6144 + cg * 64 + col] = s + a.in[I_ADAB][l * 6144 + cg * 64 + col]; }
            __syncthreads();
        }
    }
    {
        float* X = (float*)(a.ws + WS_X);
        float om[4];
#pragma unroll
        for (int e = 0; e < 4; ++e) om[e] = 1.0f / powf(10000.0f, (float)(4 * w.lane + e) * (1.0f / 256.0f));
        int tcur = -1; f32x4 pos[4];
#pragma unroll
        for (int j = 0; j < 4; ++j) pos[j] = (f32x4){0.f, 0.f, 0.f, 0.f};
        for (int row = w.gw; row < MT; row += w.NGW) {
            f32x4 v[4];
            if (row < ML) { row_load(a.in[I_X] + (size_t)row * 1024, w.lane, v); const int t = row & 2047;
                if (t != tcur) { tcur = t; const float pr = (float)(t >> 6), pc = (float)(t & 63);
#pragma unroll
                    for (int e = 0; e < 4; ++e) { pos[0][e] = sinf(pr * om[e]); pos[1][e] = cosf(pr * om[e]); pos[2][e] = sinf(pc * om[e]); pos[3][e] = cosf(pc * om[e]); } }
#pragma unroll
                for (int j = 0; j < 4; ++j) v[j] += pos[j]; }
            else row_load(a.in[I_CTX] + (size_t)(row - ML) * 1024, w.lane, v);
            row_store(X + (size_t)row * 1024, w.lane, v);
        }
    }
    {
        { float* TWg = (float*)(a.ws + WS_LB + 65536);
          for (int i = w.bid * NTHREADS + w.tid; i < 1024; i += w.G * NTHREADS) { float s, c; sincospif((float)i * (1.0f / 1024.0f), &s, &c); TWg[2 * i] = c; TWg[2 * i + 1] = -s; } }
        bf16* D6 = (bf16*)(a.ws + WS_DFT64);
        for (int i = w.bid * NTHREADS + w.tid; i < 512 * 256; i += w.G * NTHREADS) { const int j = i >> 8, k = i & 255; const int g = (j & 255) >> 6, kc = j & 63; float val = 0.f;
            if ((k >> 6) == g) { const int m = (kc * (k & 63)) & 63; float s, c; sincospif((float)m * (1.0f / 32.0f), &s, &c); val = (j >> 8) ? -s : c; }
            D6[i] = (bf16)f2bf(val); }
        if (w.bid == 0) { float* LB = (float*)(a.ws + WS_LB); const int d = w.tid >> 8, ch = w.tid & 255; float lg[4], mx = -1e30f;
#pragma unroll
            for (int l = 0; l < 4; ++l) { lg[l] = a.in[I_LBLOG][(d * 4 + l) * 256 + ch]; mx = fmaxf(mx, lg[l]); }
            float s = 0.f;
#pragma unroll
            for (int l = 0; l < 4; ++l) { lg[l] = expf(lg[l] - mx); s += lg[l]; }
            float cum = 0.f;
#pragma unroll
            for (int l = 0; l < 4; ++l) { if (l > 0) cum += lg[l] / s; LB[(d * 4 + l) * 256 + ch] = cum; } }
    }
    __syncthreads();
    convert_win(a, lds, w.wave, w.lane, w.gw, w.NGW, 0);
}
__device__ __forceinline__ void phase_mod_rows(const Args& a, const WCtx& w, int l) {
    const float* X = (const float*)(a.ws + WS_X); bf16* H = (bf16*)(a.ws + WS_H);
    for (int row = w.gw; row < MT; row += w.NGW) { f32x4 v[4], hv[4]; row_load(X + (size_t)row * 1024, w.lane, v);
        modulate_row(v, mod_ptr(a, l, row, 0), mod_ptr(a, l, row, 1), H + (size_t)row * 1024, (unsigned*)(a.ws + WS_H8 + (size_t)row * 1024), w.lane, hv); }
}

__device__ __forceinline__ f32x4 ld_bf4(const bf16* p) { const v2u u = *(const v2u*)p; return (f32x4){bf2f(u.x & 0xffffu), bf2f(u.x >> 16), bf2f(u.y & 0xffffu), bf2f(u.y >> 16)}; }
__device__ __forceinline__ void st_bf4(bf16* p, f32x4 v) { v2u w; w.x = cvt_pk_bf16(v[0], v[1]); w.y = cvt_pk_bf16(v[2], v[3]); *(v2u*)p = w; }
__device__ __forceinline__ void phase_prep(const Args& a, const WCtx& w, int l) {
    const bf16* ZB = (const bf16*)(a.ws + WS_ZB); bf16* PB = (bf16*)(a.ws + WS_PB);
    constexpr int NSEG = 16 * 128 + 16 * 16;
    for (int it = w.gw; it < NSEG * 3; it += w.NGW) {
        const int seg = it / 3, bg = it - seg * 3;
        int T, t0, rowbase;
        if (seg < 2048) { const int b = seg >> 7; t0 = (seg & 127) * 16; T = 2048; rowbase = b * 2048; } else { const int s2 = seg - 2048; const int b = s2 >> 4; t0 = (s2 & 15) * 16; T = 256; rowbase = ML + b * 256; }
        const int blk = bg * 8 + (w.lane >> 3), c8 = (w.lane & 7) * 8;
        if (blk < 20) {
            int zcol, pcol; float cw[5][8], bias[8];
            if (blk < 12) { const int c = blk * 64 + c8; zcol = 768 + c; pcol = c;
#pragma unroll
                for (int k = 0; k < 5; ++k) { const f32x4 w0 = *(const f32x4*)(a.in[I_GDN_CW] + (size_t)(l * 5 + k) * 768 + c), w1 = *(const f32x4*)(a.in[I_GDN_CW] + (size_t)(l * 5 + k) * 768 + c + 4);
#pragma unroll
                    for (int i = 0; i < 4; ++i) { cw[k][i] = w0[i]; cw[k][4 + i] = w1[i]; } }
#pragma unroll
                for (int i = 0; i < 8; ++i) bias[i] = 0.f; }
            else { const int c = (blk - 12) * 64 + c8; zcol = 2048 + c; pcol = 768 + c;
#pragma unroll
                for (int k = 0; k < 5; ++k) { const f32x4 w0 = *(const f32x4*)(a.in[I_SSD_CW] + (size_t)(l * 5 + k) * 512 + c), w1 = *(const f32x4*)(a.in[I_SSD_CW] + (size_t)(l * 5 + k) * 512 + c + 4);
#pragma unroll
                    for (int i = 0; i < 4; ++i) { cw[k][i] = w0[i]; cw[k][4 + i] = w1[i]; } }
                const f32x4 b0 = *(const f32x4*)(a.in[I_SSD_CB] + l * 512 + c), b1 = *(const f32x4*)(a.in[I_SSD_CB] + l * 512 + c + 4);
#pragma unroll
                for (int i = 0; i < 4; ++i) { bias[i] = b0[i]; bias[4 + i] = b1[i]; } }
            const bf16* zp = ZB + (size_t)rowbase * NZB + zcol;
            v4u raw[20];
#pragma unroll
            for (int r = 0; r < 20; ++r) { const int t = t0 - 2 + r; raw[r] = (t >= 0 && t < T) ? *(const v4u*)(zp + (size_t)t * NZB) : (v4u){0u, 0u, 0u, 0u}; }
#pragma unroll
            for (int i = 0; i < 16; ++i) {
                float y[8];
#pragma unroll
                for (int q = 0; q < 8; ++q) y[q] = bias[q];
#pragma unroll
                for (int k = 0; k < 5; ++k) { const v4u rr = raw[i + k]; const unsigned uu[4] = {rr.x, rr.y, rr.z, rr.w};
#pragma unroll
                    for (int q = 0; q < 4; ++q) { y[2 * q] += cw[k][2 * q] * bf2f(uu[q] & 0xffffu); y[2 * q + 1] += cw[k][2 * q + 1] * bf2f(uu[q] >> 16); } }
                float ss = 0.f;
#pragma unroll
                for (int q = 0; q < 8; ++q) { y[q] = y[q] * sigmoid_fast(y[q]); ss += y[q] * y[q]; }
                if (blk < 8) { ss += dpp_xor1(ss); ss += dpp_xor2(ss); ss += dpp_x7(ss); float r = __builtin_amdgcn_rsqf(ss + LN_EPS); if (blk < 4) r *= 0.125f;
#pragma unroll
                    for (int q = 0; q < 8; ++q) y[q] *= r; }
                v4u o; o.x = cvt_pk_bf16(y[0], y[1]); o.y = cvt_pk_bf16(y[2], y[3]); o.z = cvt_pk_bf16(y[4], y[5]); o.w = cvt_pk_bf16(y[6], y[7]);
                *(v4u*)(PB + (size_t)(rowbase + t0 + i) * NPB + pcol) = o;
            }
        }
    }
}

__device__ __forceinline__ float red4(float x) { x += dpp_xor1(x); x += dpp_xor2(x); return x; }
__device__ __forceinline__ void phase_scan(const Args& a, LAS unsigned char* lds, const WCtx& w, int l) {
    LAS float* Qs = (LAS float*)lds; LAS float* Ks = Qs + 4096; LAS float* Dd = Qs + 8192; LAS float* Vs = Qs + 12288; LAS float* As = Qs + 16384; LAS float* Bs = As + 64;
    LAS bf16* Os = (LAS bf16*)(lds + 66048);
    const bf16* ZB = (const bf16*)(a.ws + WS_ZB); const float* ZF = (const float*)(a.ws + WS_ZF); const bf16* PB = (const bf16*)(a.ws + WS_PB); bf16* SO = (bf16*)(a.ws + WS_SO);
    const int sdir = w.tid >> 8, sr = (w.tid & 255) >> 3, c0 = (w.tid & 7) * 8;
    const int cdir = w.wave >> 2, eg = w.wave & 3, el = w.lane >> 2, dq = w.lane & 3;
    for (int pi = w.bid; pi < 192; pi += w.G) {
        const int mix = pi >> 6, b = (pi & 63) >> 2, h = pi & 3;
        float lbv[8]; float alog = 0.f, dtb = 0.f;
#pragma unroll
        for (int i = 0; i < 8; ++i) lbv[i] = 0.f;
        if (mix == 0) {
#pragma unroll
            for (int i = 0; i < 8; ++i) lbv[i] = ((const float*)(a.ws + WS_LB))[(sdir * 4 + l) * 256 + h * 64 + c0 + i]; }
        else if (mix == 1) { alog = expf(a.in[I_GDN_ALOG][(l * 2 + sdir) * 4 + h]); dtb = a.in[I_GDN_DTB][(l * 2 + sdir) * 4 + h]; }
        else { alog = expf(a.in[I_SSD_ALOG][(l * 2 + sdir) * 4 + h]); dtb = a.in[I_SSD_DTB][(l * 2 + sdir) * 4 + h]; }
        float S[16];
#pragma unroll
        for (int i = 0; i < 16; ++i) S[i] = 0.f;
        v4u rA, rB, rC; f32x4 rF0, rF1; float rs0 = 0.f, rs1 = 0.f;
        rA = rB = rC = (v4u){0u, 0u, 0u, 0u}; rF0 = rF1 = (f32x4){0.f, 0.f, 0.f, 0.f};
#define SCAN_ROW(dir_, sg_) (((sg_) < 256) ? (ML + b * 256 + ((dir_) ? 255 - (sg_) : (sg_))) : (b * 2048 + ((dir_) ? 2047 - ((sg_) - 256) : ((sg_) - 256))))
#define SCAN_LOAD(tb_) do { const int row_ = SCAN_ROW(sdir, (tb_) * 32 + sr); \
            if (mix == 0) { rA = *(const v4u*)(ZB + (size_t)row_ * NZB + h * 64 + c0); rC = *(const v4u*)(ZB + (size_t)row_ * NZB + 256 + h * 64 + c0); \
                            rF0 = *(const f32x4*)(ZF + (size_t)row_ * NZF + sdir * 256 + h * 64 + c0); rF1 = *(const f32x4*)(ZF + (size_t)row_ * NZF + sdir * 256 + h * 64 + c0 + 4); } \
            else if (mix == 1) { rA = *(const v4u*)(PB + (size_t)row_ * NPB + h * 64 + c0); rB = *(const v4u*)(PB + (size_t)row_ * NPB + 256 + h * 64 + c0); rC = *(const v4u*)(PB + (size_t)row_ * NPB + 512 + h * 64 + c0); \
                            rs0 = ZF[(size_t)row_ * NZF + 512 + sdir * 4 + h]; rs1 = ZF[(size_t)row_ * NZF + 520 + sdir * 4 + h]; } \
            else { rA = *(const v4u*)(PB + (size_t)row_ * NPB + 768 + 384 + (h >> 1) * 64 + c0); rB = *(const v4u*)(PB + (size_t)row_ * NPB + 768 + 256 + (h >> 1) * 64 + c0); rC = *(const v4u*)(PB + (size_t)row_ * NPB + 768 + h * 64 + c0); \
                            rs0 = ZF[(size_t)row_ * NZF + 528 + sdir * 4 + h]; } } while (0)
#define SCAN_STORE() do { const int o_ = (sdir * 32 + sr) * 64 + c0; float qa[8], ka[8], va[8], da[8]; \
            const unsigned ua[4] = {rA.x, rA.y, rA.z, rA.w}, ub[4] = {rB.x, rB.y, rB.z, rB.w}, uc[4] = {rC.x, rC.y, rC.z, rC.w}; \
            _Pragma("unroll") for (int i_ = 0; i_ < 4; ++i_) { qa[2 * i_] = bf2f(ua[i_] & 0xffffu); qa[2 * i_ + 1] = bf2f(ua[i_] >> 16); ka[2 * i_] = bf2f(ub[i_] & 0xffffu); ka[2 * i_ + 1] = bf2f(ub[i_] >> 16); \
                va[2 * i_] = bf2f(uc[i_] & 0xffffu); va[2 * i_ + 1] = bf2f(uc[i_] >> 16); } \
            if (mix == 0) { const float zf_[8] = {rF0[0], rF0[1], rF0[2], rF0[3], rF1[0], rF1[1], rF1[2], rF1[3]}; \
                _Pragma("unroll") for (int i_ = 0; i_ < 8; ++i_) { const float sg_ = sigmoid_acc(zf_[i_]); da[i_] = lbv[i_] + (1.0f - lbv[i_]) * sg_; ka[i_] = (1.0f - lbv[i_]) * (1.0f - sg_); qa[i_] = silu_acc(qa[i_]); } \
                if (c0 == 0) { As[sdir * 32 + sr] = 0.f; Bs[sdir * 32 + sr] = 0.f; } } \
            else if (mix == 1) { const float av_ = expf(-alog * softplus_acc(rs0 + dtb)); _Pragma("unroll") for (int i_ = 0; i_ < 8; ++i_) da[i_] = av_; \
                if (c0 == 0) { As[sdir * 32 + sr] = av_; Bs[sdir * 32 + sr] = sigmoid_acc(rs1); } } \
            else { const float dt_ = softplus_acc(rs0 + dtb); const float av_ = expf(-alog * dt_); _Pragma("unroll") for (int i_ = 0; i_ < 8; ++i_) { da[i_] = av_; va[i_] *= dt_; } \
                if (c0 == 0) { As[sdir * 32 + sr] = av_; Bs[sdir * 32 + sr] = 0.f; } } \
            *(LAS f32x4*)(Qs + o_) = (f32x4){qa[0], qa[1], qa[2], qa[3]}; *(LAS f32x4*)(Qs + o_ + 4) = (f32x4){qa[4], qa[5], qa[6], qa[7]}; \
            *(LAS f32x4*)(Ks + o_) = (f32x4){ka[0], ka[1], ka[2], ka[3]}; *(LAS f32x4*)(Ks + o_ + 4) = (f32x4){ka[4], ka[5], ka[6], ka[7]}; \
            *(LAS f32x4*)(Dd + o_) = (f32x4){da[0], da[1], da[2], da[3]}; *(LAS f32x4*)(Dd + o_ + 4) = (f32x4){da[4], da[5], da[6], da[7]}; \
            *(LAS f32x4*)(Vs + o_) = (f32x4){va[0], va[1], va[2], va[3]}; *(LAS f32x4*)(Vs + o_ + 4) = (f32x4){va[4], va[5], va[6], va[7]}; } while (0)
        SCAN_LOAD(0); SCAN_STORE(); __syncthreads();
        for (int tb = 0; tb < 72; ++tb) {
            if (tb + 1 < 72) SCAN_LOAD(tb + 1);
#pragma unroll 2
            for (int s = 0; s < 32; ++s) {
                const int base = (cdir * 32 + s) * 64 + dq * 16;
                f32x4 q4[4], k4[4];
#pragma unroll
                for (int i = 0; i < 4; ++i) { q4[i] = *(const LAS f32x4*)(Qs + base + 4 * i); k4[i] = *(const LAS f32x4*)(Ks + base + 4 * i); }
                float vv = Vs[(cdir * 32 + s) * 64 + eg * 16 + el];
                const float av = As[cdir * 32 + s];
                float o0 = 0.f, o1 = 0.f, o2 = 0.f, o3 = 0.f;
                if (mix == 0) {
                    f32x4 d4[4];
#pragma unroll
                    for (int i = 0; i < 4; ++i) d4[i] = *(const LAS f32x4*)(Dd + base + 4 * i);
#pragma unroll
                    for (int i = 0; i < 4; ++i) {
                        S[4 * i + 0] = d4[i][0] * S[4 * i + 0] + k4[i][0] * vv; o0 += q4[i][0] * S[4 * i + 0];
                        S[4 * i + 1] = d4[i][1] * S[4 * i + 1] + k4[i][1] * vv; o1 += q4[i][1] * S[4 * i + 1];
                        S[4 * i + 2] = d4[i][2] * S[4 * i + 2] + k4[i][2] * vv; o2 += q4[i][2] * S[4 * i + 2];
                        S[4 * i + 3] = d4[i][3] * S[4 * i + 3] + k4[i][3] * vv; o3 += q4[i][3] * S[4 * i + 3]; }
                } else {
                    if (mix == 1) { const float be = Bs[cdir * 32 + s]; float k0 = 0.f, k1 = 0.f, k2 = 0.f, k3 = 0.f;
#pragma unroll
                        for (int i = 0; i < 4; ++i) { k0 += k4[i][0] * S[4 * i + 0]; k1 += k4[i][1] * S[4 * i + 1]; k2 += k4[i][2] * S[4 * i + 2]; k3 += k4[i][3] * S[4 * i + 3]; }
                        const float ks = red4((k0 + k1) + (k2 + k3)); vv = be * (vv - av * ks); }
#pragma unroll
                    for (int i = 0; i < 4; ++i) {
                        S[4 * i + 0] = av * S[4 * i + 0] + k4[i][0] * vv; o0 += q4[i][0] * S[4 * i + 0];
                        S[4 * i + 1] = av * S[4 * i + 1] + k4[i][1] * vv; o1 += q4[i][1] * S[4 * i + 1];
                        S[4 * i + 2] = av * S[4 * i + 2] + k4[i][2] * vv; o2 += q4[i][2] * S[4 * i + 2];
                        S[4 * i + 3] = av * S[4 * i + 3] + k4[i][3] * vv; o3 += q4[i][3] * S[4 * i + 3]; }
                }
                const float o = red4((o0 + o1) + (o2 + o3));
                if (dq == 0) Os[(w.wave * 32 + s) * 16 + el] = (bf16)f2bf(o);
            }
            LDS_WAIT();
            { const int r = w.lane >> 1, hf = w.lane & 1; const int row = SCAN_ROW(cdir, tb * 32 + r);
              const v4u ov = *(const LAS v4u*)(Os + (w.wave * 32 + r) * 16 + hf * 8);
              *(v4u*)(SO + ((size_t)(mix * 2 + cdir) * MT + row) * 256 + h * 64 + eg * 16 + hf * 8) = ov; }
            __syncthreads();
            if (tb + 1 < 72) SCAN_STORE();
            __syncthreads();
        }
#undef SCAN_ROW
#undef SCAN_LOAD
#undef SCAN_STORE
    }
}

__device__ __forceinline__ f32x4 silu4(f32x4 x) { return (f32x4){silu_acc(x[0]), silu_acc(x[1]), silu_acc(x[2]), silu_acc(x[3])}; }
__device__ __forceinline__ f32x4 silu4f(f32x4 x) { return (f32x4){x[0] * sigmoid_fast(x[0]), x[1] * sigmoid_fast(x[1]), x[2] * sigmoid_fast(x[2]), x[3] * sigmoid_fast(x[3])}; }
__device__ __forceinline__ f32x4 bf4(v2u u) { return (f32x4){bf2f(u.x & 0xffffu), bf2f(u.x >> 16), bf2f(u.y & 0xffffu), bf2f(u.y >> 16)}; }
struct FinRow { v2u so[6], zg[3], px; f32x4 fo0, fo1; };
__device__ __forceinline__ void fin_load(FinRow& R, const bf16* ZB, const bf16* PB, const bf16* SO, const float* FO, int row, int ch) {
#pragma unroll
    for (int k = 0; k < 6; ++k) R.so[k] = *(const v2u*)(SO + ((size_t)k * MT + row) * 256 + ch);
    R.zg[0] = *(const v2u*)(ZB + (size_t)row * NZB + 512 + ch); R.zg[1] = *(const v2u*)(ZB + (size_t)row * NZB + 1536 + ch); R.zg[2] = *(const v2u*)(ZB + (size_t)row * NZB + 2560 + ch);
    R.px = *(const v2u*)(PB + (size_t)row * NPB + 768 + ch);
    R.fo0 = *(const f32x4*)(FO + (size_t)row * 256 + ch); R.fo1 = (f32x4){0.f, 0.f, 0.f, 0.f};
}
__device__ __forceinline__ void phase_finish(const Args& a, const WCtx& w, int l, int nrows) {
    const bf16* ZB = (const bf16*)(a.ws + WS_ZB); const bf16* PB = (const bf16*)(a.ws + WS_PB); const bf16* SO = (const bf16*)(a.ws + WS_SO); const float* FO = (const float*)(a.ws + WS_FO);
    bf16* OUTS = (bf16*)(a.ws + WS_OUTS);
    const int ch = 4 * w.lane, hd = w.lane >> 4;
    const f32x4 nwa = *(const f32x4*)(a.in[I_HGRN_NW] + l * 256 + ch), nwb = *(const f32x4*)(a.in[I_GDN_NW] + l * 256 + ch), nwd = *(const f32x4*)(a.in[I_SSD_NW] + l * 256 + ch);
    const float dsk = a.in[I_SSD_D][l * 4 + hd];
    int row = w.gw; FinRow R, Rn;
    if (row < nrows) fin_load(R, ZB, PB, SO, FO, row, ch);
    while (row < nrows) {
        const int nrow = row + w.NGW;
        if (nrow < nrows) fin_load(Rn, ZB, PB, SO, FO, nrow, ch);
        asm volatile("" ::: "memory");
        bf16* orow = OUTS + (size_t)row * 1024 + ch;
        { f32x4 o = bf4(R.so[0]) + bf4(R.so[1]);
          float ss = (o[0] * o[0] + o[1] * o[1]) + (o[2] * o[2] + o[3] * o[3]); ss += dpp_xor1(ss); ss += dpp_xor2(ss); ss += dpp_x7(ss); ss += dpp_x15(ss);
          const float r = __builtin_amdgcn_rsqf(ss * (1.f / 64.f) + LN_EPS); st_bf4(orow, o * r * nwa * silu4f(bf4(R.zg[0]))); }
        { f32x4 o = bf4(R.so[2]) + bf4(R.so[3]);
          float ss = (o[0] * o[0] + o[1] * o[1]) + (o[2] * o[2] + o[3] * o[3]); ss += dpp_xor1(ss); ss += dpp_xor2(ss); ss += dpp_x7(ss); ss += dpp_x15(ss);
          const float r = __builtin_amdgcn_rsqf(ss * (1.f / 64.f) + LN_EPS); st_bf4(orow + 256, o * r * nwb * silu4f(bf4(R.zg[1]))); }
        st_bf4(orow + 512, R.fo0 + R.fo1);
        { f32x4 o = bf4(R.so[4]) + bf4(R.so[5]); f32x4 y = (o + bf4(R.px) * dsk) * silu4f(bf4(R.zg[2]));
          const float ss = wave_sum((y[0] * y[0] + y[1] * y[1]) + (y[2] * y[2] + y[3] * y[3]));
          const float r = __builtin_amdgcn_rsqf(ss * (1.f / 256.f) + LN_EPS); st_bf4(orow + 768, y * r * nwd); }
        R = Rn; row = nrow;
    }
}

__device__ __forceinline__ int row_batch(int row) { return row < ML ? (row >> 11) : 16; }
__device__ __forceinline__ void phase_ln1(const Args& a, LAS unsigned char* lds, const WCtx& w, int l, int nrows) {
    LAS float* WRT = (LAS float*)lds;
    LAS float* LNG = WRT + 16384; LAS float* LNB = LNG + 1024; LAS float* BV = LNB + 1024;
    const int rpb = (nrows + w.G - 1) / w.G, r0 = w.bid * rpb, r1 = (r0 + rpb < nrows) ? r0 + rpb : nrows;
    const int b_lo = row_batch(r0 < nrows ? r0 : 0), b_hi = row_batch(r1 > r0 ? r1 - 1 : 0);
    for (int i = w.tid; i < 16384; i += NTHREADS) { const int d = i >> 4, e = i & 15; WRT[e * 1024 + d] = a.in[I_WROUTER][(size_t)l * 16384 + i]; }
    for (int i = w.tid; i < 1024; i += NTHREADS) { LNG[i] = a.in[I_LN1G][l * 1024 + i]; LNB[i] = a.in[I_LN1B][l * 1024 + i];
#pragma unroll
        for (int s = 0; s < 2; ++s) { const float* mp = (const float*)(a.ws + WS_MOD) + (size_t)(l * 17 + (s ? b_hi : b_lo)) * 6144;
            BV[(s * 3 + 0) * 1024 + i] = mp[2048 + i]; BV[(s * 3 + 1) * 1024 + i] = mp[3072 + i]; BV[(s * 3 + 2) * 1024 + i] = mp[4096 + i]; } }
    __syncthreads();
    float* X = (float*)(a.ws + WS_X); const bf16* Y = (const bf16*)(a.ws + WS_Y); bf16* H = (bf16*)(a.ws + WS_H); float* AFF = (float*)(a.ws + WS_AFF);
    int row = r0 + w.wave;
    f32x4 x[4]; v2u yb[4];
#pragma unroll
    for (int j = 0; j < 4; ++j) { x[j] = (f32x4){0.f, 0.f, 0.f, 0.f}; yb[j] = (v2u){0u, 0u}; }
    if (row < r1) { row_load(X + (size_t)row * 1024, w.lane, x);
#pragma unroll
        for (int j = 0; j < 4; ++j) yb[j] = *((const v2u*)(Y + (size_t)row * 1024) + w.lane + 64 * j); }
    f32x4 wr[10][4];
#pragma unroll
    for (int e = 0; e < 10; ++e)
#pragma unroll
        for (int j = 0; j < 4; ++j) wr[e][j] = *(const LAS f32x4*)(WRT + e * 1024 + 256 * j + 4 * w.lane);
    while (row < r1) {
        const int nrow = row + NWAVES; f32x4 xn[4]; v2u ybn[4];
#pragma unroll
        for (int j = 0; j < 4; ++j) { xn[j] = (f32x4){0.f, 0.f, 0.f, 0.f}; ybn[j] = (v2u){0u, 0u}; }
        if (nrow < r1) { row_load(X + (size_t)nrow * 1024, w.lane, xn);
#pragma unroll
            for (int j = 0; j < 4; ++j) ybn[j] = *((const v2u*)(Y + (size_t)nrow * 1024) + w.lane + 64 * j); }
        asm volatile("" ::: "memory");
        const LAS float* bv = BV + ((row_batch(row) != b_lo) ? 3 * 1024 : 0);
        f32x4 hv[4];
#pragma unroll
        for (int j = 0; j < 4; ++j) { const f32x4 g1 = *(const LAS f32x4*)(bv + 4 * w.lane + 256 * j);
            const f32x4 yv = (f32x4){bf2f(yb[j].x & 0xffffu), bf2f(yb[j].x >> 16), bf2f(yb[j].y & 0xffffu), bf2f(yb[j].y >> 16)};
            x[j] = x[j] * ALPHA + g1 * yv; }
        float mean, rstd; ln_stats(x, mean, rstd);
#pragma unroll
        for (int j = 0; j < 4; ++j) x[j] = (x[j] - mean) * rstd * *(const LAS f32x4*)(LNG + 4 * w.lane + 256 * j) + *(const LAS f32x4*)(LNB + 4 * w.lane + 256 * j);
        row_store(X + (size_t)row * 1024, w.lane, x);
        ln_stats(x, mean, rstd);
        { unsigned* hrow = (unsigned*)((unsigned char*)H + (size_t)row * 1024);
#pragma unroll
          for (int j = 0; j < 4; ++j) { const f32x4 sh = *(const LAS f32x4*)(bv + 1024 + 4 * w.lane + 256 * j), sc = *(const LAS f32x4*)(bv + 2048 + 4 * w.lane + 256 * j);
              hv[j] = (x[j] - mean) * rstd * (sc + 1.0f) + sh;
              hrow[w.lane + 64 * j] = pk4_fp8(fminf(fmaxf(hv[j][0], -448.f), 448.f), fminf(fmaxf(hv[j][1], -448.f), 448.f), fminf(fmaxf(hv[j][2], -448.f), 448.f), fminf(fmaxf(hv[j][3], -448.f), 448.f)); } }
        float pe[16];
#pragma unroll
        for (int e = 0; e < 16; ++e) { float p = 0.f;
#pragma unroll
            for (int j = 0; j < 4; ++j) { const f32x4 wv = (e < 10) ? wr[e < 10 ? e : 0][j] : *(const LAS f32x4*)(WRT + e * 1024 + 256 * j + 4 * w.lane); p += (hv[j][0] * wv[0] + hv[j][1] * wv[1]) + (hv[j][2] * wv[2] + hv[j][3] * wv[3]); }
            pe[e] = p; }
        float q8[8], q4[4], q2[2];
#pragma unroll
        for (int k = 0; k < 8; ++k) q8[k] = swap32_add(pe[k], pe[k + 8]);
#pragma unroll
        for (int k = 0; k < 4; ++k) q4[k] = swap16_add(q8[k], q8[k + 4]);
        { const bool hi = (w.lane & 8) != 0;
#pragma unroll
          for (int k = 0; k < 2; ++k) { const float mine = hi ? q4[k + 2] : q4[k], oth = hi ? q4[k] : q4[k + 2]; q2[k] = mine + dpp_x8(oth); } }
        float lg;
        { const bool hi = (w.lane & 4) != 0; const float mine = hi ? q2[1] : q2[0], oth = hi ? q2[0] : q2[1]; lg = mine + dpp_x4(oth); }
        lg += dpp_xor1(lg); lg += dpp_xor2(lg);
        float mx = lg;
        mx = fmaxf(mx, dpp_x4(mx)); mx = fmaxf(mx, dpp_x8(mx)); mx = swap16_max(mx); mx = swap32_max(mx);
        const float ex = __expf(lg - mx); float s = ex;
        s += dpp_x4(s); s += dpp_x8(s); s = swap16_add(s, s); s = swap32_add(s, s);
        if ((w.lane & 3) == 0) AFF[(size_t)row * 16 + (w.lane >> 2)] = ex / s;
#pragma unroll
        for (int j = 0; j < 4; ++j) { x[j] = xn[j]; yb[j] = ybn[j]; }
        row = nrow;
    }
}

typedef int i32x4 __attribute__((ext_vector_type(4)));
__device__ __forceinline__ void phase_topk(const Args& a, LAS unsigned char* lds, const WCtx& w, int nitems) {
    LAS int* CNT = (LAS int*)lds;
    LAS int* WS1 = CNT + 128;
    LAS int* WS2 = WS1 + 8;
    LAS int* SEL = WS2 + 8;
    LAS int* SELW = SEL + 256;
    const float* AFF = (const float*)(a.ws + WS_AFF); int* SLOT = (int*)(a.ws + WS_SLOT); float* ROWW = (float*)(a.ws + WS_ROWW);
    int* SELROW = (int*)(a.ws + WS_ROWW + 512 * 1024);
    for (int it2 = w.gw; it2 < nitems - 256; it2 += w.NGW) {
        const int b = it2 >> 4, e = it2 & 15, rowbase = ML + b * 256, xebase = 65536 + e * 512 + b * 32;
        unsigned key[4];
#pragma unroll
        for (int j = 0; j < 4; ++j) key[j] = __float_as_uint(AFF[(size_t)(rowbase + w.lane * 4 + j) * 16 + e]);
        unsigned T = 0u;
        for (int bit = 29; bit >= 0; --bit) { const unsigned trial = T | (1u << bit); int tot = 0;
#pragma unroll
            for (int j = 0; j < 4; ++j) tot += __popcll(__ballot(key[j] >= trial));
            if (tot >= CAP_C) T = trial; }
        int ngt = 0, ceq = 0;
#pragma unroll
        for (int j = 0; j < 4; ++j) { ngt += (key[j] > T) ? 1 : 0; ceq += (key[j] == T) ? 1 : 0; }
        const int xg = wave_scan(ngt), xq = wave_scan(ceq);
        const int need_eq = CAP_C - __builtin_amdgcn_readlane(xg, 63); int eqrank = xq - ceq;
        int sel[4], csel = 0;
#pragma unroll
        for (int j = 0; j < 4; ++j) { const bool iseq = key[j] == T; sel[j] = (key[j] > T) || (iseq && eqrank < need_eq); if (iseq) ++eqrank; csel += sel[j]; }
        const int xs = wave_scan(csel);
        int slot = xs - csel;
#pragma unroll
        for (int j = 0; j < 4; ++j) { const int t = w.lane * 4 + j; int sv = -1; if (sel[j] && slot < CAP_C) { sv = slot; ROWW[xebase + slot] = __uint_as_float(key[j]); ++slot; }
            SLOT[(size_t)(rowbase + t) * 16 + e] = sv;
            if (sv >= 0) SELW[w.wave * 32 + sv] = t; }
        LDS_WAIT();
        if (w.lane < CAP_C) SELROW[xebase + w.lane] = rowbase + SELW[w.wave * 32 + w.lane];
        LDS_WAIT();
    }
    __syncthreads();
    for (int item = w.bid; item < (nitems < 256 ? nitems : 256); item += w.G) {
        int b, e, n, cap, rowbase, xebase;
        if (item < 256) { b = item >> 4; e = item & 15; n = 2048; cap = CAP_L; rowbase = b * 2048; xebase = e * 4096 + b * 256; }
        else { const int it2 = item - 256; b = it2 >> 4; e = it2 & 15; n = 256; cap = CAP_C; rowbase = ML + b * 256; xebase = 65536 + e * 512 + b * 32; }
        unsigned key[4];
#pragma unroll
        for (int j = 0; j < 4; ++j) { const int t = w.tid * 4 + j; key[j] = t < n ? __float_as_uint(AFF[(size_t)(rowbase + t) * 16 + e]) : 0u; }
        unsigned T = 0u;
        for (int dg = 9; dg >= 0; --dg) {
            const int sh = 3 * dg; LAS int* cb = CNT + (dg & 1) * 64;
            i32x4 clo, chi; chi[3] = 0;
#pragma unroll
            for (int m = 1; m < 8; ++m) { const unsigned trial = T | ((unsigned)m << sh); int c = 0;
#pragma unroll
                for (int j = 0; j < 4; ++j) c += __popcll(__ballot(key[j] >= trial));
                if (m <= 4) clo[m - 1] = c; else chi[m - 5] = c; }
            if (w.lane == 0) { *(LAS i32x4*)(cb + w.wave * 8) = clo; *(LAS i32x4*)(cb + w.wave * 8 + 4) = chi; }
            __syncthreads();
            i32x4 tlo = *(const LAS i32x4*)cb, thi = *(const LAS i32x4*)(cb + 4);
#pragma unroll
            for (int q = 1; q < 8; ++q) { tlo += *(const LAS i32x4*)(cb + q * 8); thi += *(const LAS i32x4*)(cb + q * 8 + 4); }
            unsigned best = 0u;
#pragma unroll
            for (int m = 1; m < 8; ++m) { const int tot = (m <= 4) ? tlo[m - 1] : thi[m - 5]; if (tot >= cap) best = (unsigned)m; }
            T |= best << sh;
        }
        int ngt = 0, ceq = 0;
#pragma unroll
        for (int j = 0; j < 4; ++j) { ngt += (key[j] > T) ? 1 : 0; ceq += (key[j] == T && key[j] != 0u) ? 1 : 0; }
        const int xg = wave_scan(ngt), xe = wave_scan(ceq);
        __syncthreads();
        if (w.lane == 63) { WS1[w.wave] = xg; WS2[w.wave] = xe; }
        __syncthreads();
        int totg = 0, offe = 0;
#pragma unroll
        for (int q = 0; q < 8; ++q) { totg += WS1[q]; if (q < w.wave) offe += WS2[q]; }
        const int need_eq = cap - totg; int eqrank = offe + xe - ceq;
        int sel[4], csel = 0;
#pragma unroll
        for (int j = 0; j < 4; ++j) { const bool iseq = (key[j] == T && key[j] != 0u); sel[j] = (key[j] > T) || (iseq && eqrank < need_eq); if (iseq) ++eqrank; csel += sel[j]; }
        const int xs = wave_scan(csel);
        __syncthreads();
        if (w.lane == 63) WS1[w.wave] = xs;
        __syncthreads();
        int offs = 0;
#pragma unroll
        for (int q = 0; q < 8; ++q) if (q < w.wave) offs += WS1[q];
        int slot = offs + xs - csel;
#pragma unroll
        for (int j = 0; j < 4; ++j) { const int t = w.tid * 4 + j; if (t < n) { int sv = -1; if (sel[j]) { sv = slot; if (slot < cap) { SEL[slot] = t; ROWW[xebase + slot] = __uint_as_float(key[j]); } ++slot; }
                SLOT[(size_t)(rowbase + t) * 16 + e] = (sv < cap) ? sv : -1; } }
        __syncthreads();
        for (int s = w.tid; s < cap; s += NTHREADS) SELROW[xebase + s] = rowbase + SEL[s];
        __syncthreads();
    }
}

__device__ __forceinline__ void phase_ln2(const Args& a, LAS unsigned char* lds, const WCtx& w, int l, int nrows) {
    LAS float* LNG = (LAS float*)lds; LAS float* LNB = LNG + 1024; LAS float* BV = LNB + 1024;
    const int rpb = (nrows + w.G - 1) / w.G, r0 = w.bid * rpb, r1 = (r0 + rpb < nrows) ? r0 + rpb : nrows;
    const int b_lo = row_batch(r0 < nrows ? r0 : 0), b_hi = row_batch(r1 > r0 ? r1 - 1 : 0);
    const int ln = (l + 1 < DEPTH) ? l + 1 : l;
    for (int i = w.tid; i < 1024; i += NTHREADS) { LNG[i] = a.in[I_LN2G][l * 1024 + i]; LNB[i] = a.in[I_LN2B][l * 1024 + i];
#pragma unroll
        for (int s = 0; s < 2; ++s) { const int bb = s ? b_hi : b_lo; const float* mp = (const float*)(a.ws + WS_MOD) + (size_t)(l * 17 + bb) * 6144; const float* mn = (const float*)(a.ws + WS_MOD) + (size_t)(ln * 17 + bb) * 6144;
            BV[(s * 3 + 0) * 1024 + i] = mp[5120 + i]; BV[(s * 3 + 1) * 1024 + i] = mn[i]; BV[(s * 3 + 2) * 1024 + i] = mn[1024 + i]; } }
    __syncthreads();
    float* X = (float*)(a.ws + WS_X); bf16* H = (bf16*)(a.ws + WS_H); const unsigned char* YE = (const unsigned char*)(a.ws + WS_YE);   const int* SLOT = (const int*)(a.ws + WS_SLOT);
    int row = r0 + w.wave;
    f32x4 x[4]; int myslot = -1;
#pragma unroll
    for (int j = 0; j < 4; ++j) x[j] = (f32x4){0.f, 0.f, 0.f, 0.f};
    if (row < r1) { row_load(X + (size_t)row * 1024, w.lane, x); myslot = SLOT[(size_t)row * 16 + (w.lane & 15)]; }
    while (row < r1) {
        const int nrow = row + NWAVES; f32x4 xn[4]; int nslot = -1;
#pragma unroll
        for (int j = 0; j < 4; ++j) xn[j] = (f32x4){0.f, 0.f, 0.f, 0.f};
        f32x4 mo[4];
#pragma unroll
        for (int j = 0; j < 4; ++j) mo[j] = (f32x4){0.f, 0.f, 0.f, 0.f};
        const int b = row < ML ? (row >> 11) : ((row - ML) >> 8);
        unsigned m = (unsigned)(__ballot(myslot >= 0) & 0xFFFFull);
        while (m) {
            unsigned t[4][4];
#pragma unroll
            for (int k = 0; k < 4; ++k) {
#pragma unroll
                for (int j = 0; j < 4; ++j) t[k][j] = 0u;
                if (m) { const int e = __builtin_ctz(m); m &= m - 1u; const int s = __builtin_amdgcn_readlane(myslot, e);
                    const size_t xr = row < ML ? (size_t)(e * 4096 + b * 256 + s) : (size_t)(65536 + e * 512 + b * 32 + s); const unsigned* yr = (const unsigned*)(YE + xr * 1024) + w.lane;
#pragma unroll
                    for (int j = 0; j < 4; ++j) t[k][j] = yr[64 * j]; } }
#pragma unroll
            for (int k = 0; k < 4; ++k)
#pragma unroll
                for (int j = 0; j < 4; ++j) { const f32x2 lo = __builtin_amdgcn_cvt_pk_f32_fp8((int)t[k][j], false), hi = __builtin_amdgcn_cvt_pk_f32_fp8((int)t[k][j], true); mo[j][0] += lo[0]; mo[j][1] += lo[1]; mo[j][2] += hi[0]; mo[j][3] += hi[1]; }
        }
#pragma unroll
        for (int j = 0; j < 4; ++j) mo[j] = mo[j] * (1.0f / 64.0f);
        if (nrow < r1) { row_load(X + (size_t)nrow * 1024, w.lane, xn); nslot = SLOT[(size_t)nrow * 16 + (w.lane & 15)]; }
        asm volatile("" ::: "memory");
        const LAS float* bv = BV + ((row_batch(row) != b_lo) ? 3 * 1024 : 0);
#pragma unroll
        for (int j = 0; j < 4; ++j) x[j] = x[j] * ALPHA + *(const LAS f32x4*)(bv + 4 * w.lane + 256 * j) * mo[j];
        float mean, rstd; ln_stats(x, mean, rstd);
#pragma unroll
        for (int j = 0; j < 4; ++j) x[j] = (x[j] - mean) * rstd * *(const LAS f32x4*)(LNG + 4 * w.lane + 256 * j) + *(const LAS f32x4*)(LNB + 4 * w.lane + 256 * j);
        if (l == DEPTH - 1) row_store(a.out + (size_t)row * 1024, w.lane, x);
        else { row_store(X + (size_t)row * 1024, w.lane, x);
            ln_stats(x, mean, rstd); bf16* hrow = H + (size_t)row * 1024;
#pragma unroll
            for (int j = 0; j < 4; ++j) { const f32x4 sh = *(const LAS f32x4*)(bv + 1024 + 4 * w.lane + 256 * j), sc = *(const LAS f32x4*)(bv + 2048 + 4 * w.lane + 256 * j);
                const f32x4 hv = (x[j] - mean) * rstd * (sc + 1.0f) + sh;
                v2u wv; wv.x = cvt_pk_bf16(hv[0], hv[1]); wv.y = cvt_pk_bf16(hv[2], hv[3]); *((v2u*)hrow + w.lane + 64 * j) = wv;
                ((unsigned*)(a.ws + WS_H8 + (size_t)row * 1024))[w.lane + 64 * j] = pk4c_fp8(hv); } }
#pragma unroll
        for (int j = 0; j < 4; ++j) x[j] = xn[j];
        myslot = nslot; row = nrow;
    }
}
typedef float f32x16 __attribute__((ext_vector_type(16)));
constexpr int TS = 72, TILE_BYTES = 64 * TS * 2;
constexpr int SCG_BYTES = 7 * TILE_BYTES + 2048;
constexpr size_t WS_UT = WS_R1 + 684 * MiB;
constexpr size_t WS_WW = WS_R1 + 720 * MiB;
__device__ __forceinline__ f32x16 mma64(f32x16 acc, const LAS bf16* A, const LAS bf16* BT, int lane) {
    const int r = lane & 31, h = lane >> 5;
    const LAS bf16* ap = A + r * TS + 8 * h; const LAS bf16* bp = BT + r * TS + 8 * h;
#pragma unroll
    for (int ks = 0; ks < 4; ++ks) { const bf16x8 av = *(const LAS bf16x8*)(ap + ks * 16), bv = *(const LAS bf16x8*)(bp + ks * 16); acc = __builtin_amdgcn_mfma_f32_32x32x16_bf16(av, bv, acc, 0, 0, 0); }
    return acc;
}
__device__ __forceinline__ int swz(int row, int col) { return row * TS + ((((col >> 3) ^ ((row >> 4) & 3)) << 3) | (col & 7)); }
template <bool SWA, bool SWB>
__device__ __forceinline__ f32x16 mma64s(f32x16 acc, const LAS bf16* A, int ablk, const LAS bf16* BT, int bblk, int lane) {
    const int r = lane & 31, h = lane >> 5;
    const int sa = SWA ? ((2 * ablk + (r >> 4)) & 3) : 0, sb = SWB ? ((2 * bblk + (r >> 4)) & 3) : 0;
    const LAS bf16* ap = A + (32 * ablk + r) * TS; const LAS bf16* bp = BT + (32 * bblk + r) * TS;
#pragma unroll
    for (int ks = 0; ks < 4; ++ks) { const bf16x8 av = *(const LAS bf16x8*)(ap + (((2 * ks + h) ^ sa) << 3)), bv = *(const LAS bf16x8*)(bp + (((2 * ks + h) ^ sb) << 3)); acc = __builtin_amdgcn_mfma_f32_32x32x16_bf16(av, bv, acc, 0, 0, 0); }
    return acc;
}
__device__ __forceinline__ f32x16 zero16() { f32x16 z;
#pragma unroll
    for (int i = 0; i < 16; ++i) z[i] = 0.f;
    return z; }
__device__ __forceinline__ int chain_row(int b, int dir, int c, int i) {
    if (c < 4) { const int p = 64 * c + i; return ML + b * 256 + (dir ? 255 - p : p); }
    const int p = 64 * (c - 4) + i; return b * 2048 + (dir ? 2047 - p : p);
}
__device__ __forceinline__ float expc(float x) { return __expf(fminf(x, 80.f)); }
__device__ __forceinline__ bf16 bfr(float x) { return (bf16)cvt_pk_bf16(x, x); }
__device__ __forceinline__ void st4bf(LAS bf16* p, float a, float b, float c, float d) { v2u w; w.x = cvt_pk_bf16(a, b); w.y = cvt_pk_bf16(c, d); *(LAS v2u*)p = w; }
__device__ __forceinline__ void unpack8(const v4u u, float (&f)[8]) { f[0] = bf2f(u.x & 0xffffu); f[1] = bf2f(u.x >> 16); f[2] = bf2f(u.y & 0xffffu); f[3] = bf2f(u.y >> 16); f[4] = bf2f(u.z & 0xffffu); f[5] = bf2f(u.z >> 16); f[6] = bf2f(u.w & 0xffffu); f[7] = bf2f(u.w >> 16); }
__device__ __forceinline__ void store_state_T(LAS bf16* TST, const f32x16& S, int wm, int wn, int r, int hh) {
#pragma unroll
    for (int q = 0; q < 4; ++q) st4bf(TST + (32 * wn + r) * TS + 32 * wm + 8 * q + 4 * hh, S[4 * q], S[4 * q + 1], S[4 * q + 2], S[4 * q + 3]);
}

constexpr int SOLVE_ITEM_BYTES = 33024;
__device__ __forceinline__ void solve_diag(float (&x)[64], const LAS float* AT, const int o, const int ja, const int jb) {
#pragma unroll
    for (int j = ja; j < jb; ++j) { const float xj = x[o + j];
        int z = 0; if (j >= 2) asm("" : "+v"(z) : "v"(x[o + j - 2]));
        const LAS float* ATj = AT + z;
#pragma unroll
        for (int i4 = ((j + 1) >> 2) << 2; i4 < 32; i4 += 4) { const f32x4 av = *(const LAS f32x4*)(ATj + j * 36 + i4);
#pragma unroll
            for (int t = 0; t < 4; ++t) if (i4 + t > j) x[o + i4 + t] -= av[t] * xj; } }
}
__device__ __forceinline__ void phase_gdn_solve(const Args& a, LAS unsigned char* lds, const WCtx& w, int l) {
    const int sub = w.wave >> 1, wv = w.wave & 1;
    LAS unsigned char* gb = lds + sub * SOLVE_ITEM_BYTES;
    LAS bf16* TK = (LAS bf16*)gb; LAS float* A11T = (LAS float*)(gb + 9216); LAS float* A22T = (LAS float*)(gb + 13824); LAS bf16* A21 = (LAS bf16*)(gb + 18432);
    LAS bf16* XT = (wv == 0) ? TK : (LAS bf16*)(gb + 23040); LAS float* G = (LAS float*)(gb + 32256); LAS float* BETA = G + 64;
    const bf16* PB = (const bf16*)(a.ws + WS_PB); const float* ZF = (const float*)(a.ws + WS_ZF);
    bf16* UT = (bf16*)(a.ws + WS_UT); bf16* WW = (bf16*)(a.ws + WS_WW);
    const int full = (128 * 36) / (4 * w.G), rem = 128 * 36 - full * 4 * w.G, rounds = full + (rem > 0 ? 1 : 0);
    for (int k = 0; k < rounds; ++k) {
        int tl_ = w.tid; asm volatile("" : "+v"(tl_));
        const int t2 = tl_ & 127, lane = tl_ & 63, r = lane & 31, hh = lane >> 5;
        const int it = (k < full) ? k * 4 * w.G + w.bid * 4 + sub : full * 4 * w.G + sub * w.G + w.bid;
        const bool live = (k < full) || (sub * w.G + w.bid < rem);
        const int chain = live ? it / 36 : 0, c = live ? it - chain * 36 : 0; const int b = chain >> 3, h = (chain >> 1) & 3, dir = chain & 1;
        const int row0 = chain_row(b, dir, c, 0); const long sg = dir ? -1 : 1;
        float x[64];
        if (live) {
        { const bf16* xp = PB + (size_t)row0 * NPB + (wv == 0 ? 512 : 256) + h * 64 + lane;
#pragma unroll
          for (int i = 0; i < 32; ++i) x[i] = bf2f(xp[sg * i * NPB]); }
        { const int i = t2 >> 1, hf = t2 & 1; const v4u* src = (const v4u*)(PB + (size_t)(row0 + sg * i) * NPB + 256 + h * 64 + 32 * hf);
          const v4u k0 = src[0], k1 = src[1], k2 = src[2], k3 = src[3]; LAS v4u* dst = (LAS v4u*)(TK + i * TS + 32 * hf); dst[0] = k0; dst[1] = k1; dst[2] = k2; dst[3] = k3; }
        if (wv == 0) { const int row = row0 + (int)sg * lane;
            const float al = expf(a.in[I_GDN_ALOG][(l * 2 + dir) * 4 + h]), dtb = a.in[I_GDN_DTB][(l * 2 + dir) * 4 + h];
            float g = -al * softplus_acc(ZF[(size_t)row * NZF + 512 + dir * 4 + h] + dtb);
            g = wave_scan(g);
            const float be = sigmoid_acc(ZF[(size_t)row * NZF + 520 + dir * 4 + h]); G[lane] = g; BETA[lane] = be; BETA[64 + lane] = be * __expf(g); }
        }
        __syncthreads();
        if (!live) { }
        else if (wv == 0) {
#pragma unroll
            for (int bi = 0; bi < 2; ++bi) {
                f32x16 acc = zero16(); acc = mma64(acc, TK + 32 * bi * TS, TK + 32 * bi * TS, lane);
                LAS float* AT = bi ? A22T : A11T; const float gj = G[32 * bi + r];
#pragma unroll
                for (int q = 0; q < 4; ++q) { const int i0 = 8 * q + 4 * hh; const f32x4 gi = *(const LAS f32x4*)(G + 32 * bi + i0), bi4 = *(const LAS f32x4*)(BETA + 32 * bi + i0); f32x4 o;
#pragma unroll
                    for (int t = 0; t < 4; ++t) o[t] = (r < i0 + t) ? bi4[t] * acc[4 * q + t] * __expf(gi[t] - gj) : 0.f;
                    *(LAS f32x4*)(AT + r * 36 + i0) = o; } }
        } else {
            f32x16 acc = zero16(); acc = mma64(acc, TK, TK + 32 * TS, lane);
            const float gi = G[32 + r], bi = BETA[32 + r];
#pragma unroll
            for (int q = 0; q < 4; ++q) { const int j0 = 8 * q + 4 * hh; const f32x4 gj = *(const LAS f32x4*)(G + j0);
                st4bf(A21 + r * TS + j0, bi * acc[4 * q] * __expf(gi - gj[0]), bi * acc[4 * q + 1] * __expf(gi - gj[1]), bi * acc[4 * q + 2] * __expf(gi - gj[2]), bi * acc[4 * q + 3] * __expf(gi - gj[3])); }
        }
        __syncthreads();
        if (live) {
#pragma unroll
            for (int i = 0; i < 32; i += 4) { const f32x4 sc = *(const LAS f32x4*)(BETA + 64 * wv + i);
#pragma unroll
                for (int t = 0; t < 4; ++t) x[i + t] *= sc[t]; }
            solve_diag(x, A11T, 0, 0, 16);
            { long zz = 0; asm volatile("" : "+v"(zz) : "v"(x[15]));
              const bf16* xp = PB + (size_t)row0 * NPB + (wv == 0 ? 512 : 256) + h * 64 + lane + zz;
#pragma unroll
              for (int i = 32; i < 64; ++i) x[i] = bf2f(xp[sg * i * NPB]); }
            solve_diag(x, A11T, 0, 16, 31);
#pragma unroll
            for (int i = 32; i < 64; i += 4) { const f32x4 sc = *(const LAS f32x4*)(BETA + 64 * wv + i);
#pragma unroll
                for (int t = 0; t < 4; ++t) x[i + t] *= sc[t]; }
#pragma unroll
            for (int q = 0; q < 4; ++q) { v4u o; o.x = cvt_pk_bf16(x[8 * q], x[8 * q + 1]); o.y = cvt_pk_bf16(x[8 * q + 2], x[8 * q + 3]); o.z = cvt_pk_bf16(x[8 * q + 4], x[8 * q + 5]); o.w = cvt_pk_bf16(x[8 * q + 6], x[8 * q + 7]); *(LAS v4u*)(XT + lane * TS + 8 * q) = o; }
            f32x16 d0 = zero16(), d1 = zero16();
#pragma unroll
            for (int ks = 0; ks < 2; ++ks) { const bf16x8 av = *(const LAS bf16x8*)(A21 + r * TS + 8 * hh + 16 * ks);
                const bf16x8 b0 = *(const LAS bf16x8*)(XT + r * TS + 8 * hh + 16 * ks), b1 = *(const LAS bf16x8*)(XT + (32 + r) * TS + 8 * hh + 16 * ks);
                d0 = __builtin_amdgcn_mfma_f32_32x32x16_bf16(av, b0, d0, 0, 0, 0); d1 = __builtin_amdgcn_mfma_f32_32x32x16_bf16(av, b1, d1, 0, 0, 0); }
#pragma unroll
            for (int e = 0; e < 16; ++e) { const auto sw = __builtin_amdgcn_permlane32_swap(__float_as_uint(d0[e]), __float_as_uint(d1[e]), false, false);
                x[32 + 8 * (e >> 2) + (e & 3)] -= __uint_as_float(sw[0]); x[32 + 8 * (e >> 2) + 4 + (e & 3)] -= __uint_as_float(sw[1]); }
            solve_diag(x, A22T, 32, 0, 31);
            {
                if (wv == 0) { bf16* dst = UT + ((size_t)(chain * 36 + c) * 64 + lane) * 64;
#pragma unroll
                    for (int q = 0; q < 8; ++q) { v4u o; o.x = cvt_pk_bf16(x[8 * q], x[8 * q + 1]); o.y = cvt_pk_bf16(x[8 * q + 2], x[8 * q + 3]); o.z = cvt_pk_bf16(x[8 * q + 4], x[8 * q + 5]); o.w = cvt_pk_bf16(x[8 * q + 6], x[8 * q + 7]); *(v4u*)(dst + 8 * q) = o; } }
                else { bf16* dst = WW + (size_t)(chain * 36 + c) * 4096 + lane;
#pragma unroll
                    for (int j = 0; j < 64; ++j) dst[j * 64] = (bf16)f2bf(x[j]); }
            }
        }
        __syncthreads();
    }
}
#define LBAR() asm volatile("s_waitcnt lgkmcnt(0)\n\ts_barrier" ::: "memory")
__device__ __forceinline__ void phase_scan_chunk(const Args& a, LAS unsigned char* lds, const WCtx& w, int l) {
    const int grp = w.tid >> 8, tl = w.tid & 255, gw4 = w.wave & 3, wm = gw4 >> 1, wn = gw4 & 1, lane = w.lane, r = lane & 31, hh = lane >> 5;
    const int dir = grp;
    LAS unsigned char* gb = lds + grp * SCG_BYTES;
    LAS bf16* TQ = (LAS bf16*)gb; LAS bf16* TK = TQ + 64 * TS; LAS bf16* TX = TK + 64 * TS; LAS bf16* TKD = TX + 64 * TS; LAS bf16* TVT = TKD + 64 * TS; LAS bf16* TST = TVT + 64 * TS; LAS bf16* TP = TST + 64 * TS;
    LAS float* G = (LAS float*)(gb + 7 * TILE_BYTES); LAS float* EG = G + 64; LAS float* DEC = G + 128; LAS float* BD = G + 192; LAS float* QSUM = G + 256;
    const bf16* ZB = (const bf16*)(a.ws + WS_ZB); const float* ZF = (const float*)(a.ws + WS_ZF); const bf16* PB = (const bf16*)(a.ws + WS_PB); bf16* SO = (bf16*)(a.ws + WS_SO);
    const bf16* UT = (const bf16*)(a.ws + WS_UT); const bf16* WW = (const bf16*)(a.ws + WS_WW);
    for (int pi = w.bid; pi < 64; pi += w.G) {
        const int mix = 0, b = (pi & 63) >> 2, h = pi & 3;
        f32x16 S = zero16();
        bf16* so = SO + (size_t)(mix * 2 + dir) * MT * 256 + h * 64 + 32 * wn + r;
        {
            const int d = tl & 63, iq = tl >> 6;
            unsigned short rq[16], rv[16]; float rz[16];
#define GLA_LOAD(c_) do { const int row0_ = chain_row(b, dir, (c_), 16 * iq); const long sg_ = dir ? -1 : 1; \
                const bf16* pq_ = ZB + (size_t)row0_ * NZB + h * 64 + d; const float* pz_ = ZF + (size_t)row0_ * NZF + dir * 256 + h * 64 + d; \
                _Pragma("unroll") for (int ii = 0; ii < 16; ++ii) rq[ii] = pq_[sg_ * ii * NZB]; asm volatile("" ::: "memory"); \
                _Pragma("unroll") for (int ii = 0; ii < 16; ++ii) rv[ii] = pq_[sg_ * ii * NZB + 256]; asm volatile("" ::: "memory"); \
                _Pragma("unroll") for (int ii = 0; ii < 16; ++ii) rz[ii] = pz_[sg_ * ii * NZF]; asm volatile("" ::: "memory"); } while (0)
            GLA_LOAD(0);
            for (int c = 0; c < 36; ++c) {
                float lc[16], kk[16], qq[16], vvv[16]; float run = 0.f;
#pragma unroll
                for (int ii = 0; ii < 16; ++ii) { kk[ii] = 1.0f - __expf(rz[ii]); run += rz[ii]; lc[ii] = run; qq[ii] = bf2f(rq[ii]); vvv[ii] = bf2f(rv[ii]); }
                QSUM[iq * 64 + d] = run;
                LBAR();
                const float s0 = QSUM[d], s1 = QSUM[64 + d], s2 = QSUM[128 + d], s3 = QSUM[192 + d];
                const float off = (iq > 0 ? s0 : 0.f) + (iq > 1 ? s1 : 0.f) + (iq > 2 ? s2 : 0.f), g31 = s0 + s1, g63 = g31 + s2 + s3;
                { float kd[16];
                  const float e2 = __expf(g63 - g31);
#pragma unroll
                  for (int ii = 0; ii < 16; ++ii) { const int i = 16 * iq + ii; const float gi = off + lc[ii]; const float ea = __expf(gi), eb = expc(g31 - gi);
                      TQ[i * TS + d] = bfr(qq[ii] * ea);
                      TK[i * TS + d] = bfr(kk[ii] * eb);
                      if (iq >= 2) TX[(i - 32) * TS + d] = bfr(qq[ii] * __builtin_amdgcn_rcpf(eb));
                      else TX[(32 + i) * TS + d] = bfr(kk[ii] * __builtin_amdgcn_rcpf(fmaxf(ea, 1e-35f)));
                      kd[ii] = kk[ii] * eb * e2; }
                  v4u o0, o1; o0.x = cvt_pk_bf16(kd[0], kd[1]); o0.y = cvt_pk_bf16(kd[2], kd[3]); o0.z = cvt_pk_bf16(kd[4], kd[5]); o0.w = cvt_pk_bf16(kd[6], kd[7]);
                  o1.x = cvt_pk_bf16(kd[8], kd[9]); o1.y = cvt_pk_bf16(kd[10], kd[11]); o1.z = cvt_pk_bf16(kd[12], kd[13]); o1.w = cvt_pk_bf16(kd[14], kd[15]);
                  *(LAS v4u*)(TKD + swz(d, 16 * iq)) = o0; *(LAS v4u*)(TKD + swz(d, 16 * iq + 8)) = o1;
                  o0.x = cvt_pk_bf16(vvv[0], vvv[1]); o0.y = cvt_pk_bf16(vvv[2], vvv[3]); o0.z = cvt_pk_bf16(vvv[4], vvv[5]); o0.w = cvt_pk_bf16(vvv[6], vvv[7]);
                  o1.x = cvt_pk_bf16(vvv[8], vvv[9]); o1.y = cvt_pk_bf16(vvv[10], vvv[11]); o1.z = cvt_pk_bf16(vvv[12], vvv[13]); o1.w = cvt_pk_bf16(vvv[14], vvv[15]);
                  *(LAS v4u*)(TVT + swz(d, 16 * iq)) = o0; *(LAS v4u*)(TVT + swz(d, 16 * iq + 8)) = o1;
                  if (iq == 0) DEC[d] = __expf(g63); }
                store_state_T(TST, S, wm, wn, r, hh);
                if (c + 1 < 36) GLA_LOAD(c + 1);
                LBAR();
                { f32x16 acc = zero16();
                  if (wn >= wm) { const LAS bf16* Ap = (wm == 0 && wn == 0) ? TX + 32 * TS : TK + 32 * wm * TS; const LAS bf16* Bp = (wn == 0) ? TQ : TX;
                      acc = mma64(acc, Ap, Bp, lane); }
                  const int i = 32 * wn + r;
#pragma unroll
                  for (int q = 0; q < 4; ++q) { const int j0 = 32 * wm + 8 * q + 4 * hh;
                      st4bf(TP + i * TS + j0, (j0 <= i) ? acc[4 * q] : 0.f, (j0 + 1 <= i) ? acc[4 * q + 1] : 0.f, (j0 + 2 <= i) ? acc[4 * q + 2] : 0.f, (j0 + 3 <= i) ? acc[4 * q + 3] : 0.f); } }
                LBAR();
                { bf16* sop = so + (size_t)chain_row(b, dir, c, 32 * wm + 4 * hh) * 256; const long sstep = dir ? -256 : 256;
                  f32x16 o = zero16(); o = mma64s<false, true>(o, TP, wm, TVT, wn, lane); o = mma64(o, TQ + 32 * wm * TS, TST + 32 * wn * TS, lane);
                  f32x16 ds = zero16(); ds = mma64s<true, true>(ds, TKD, wm, TVT, wn, lane);
#pragma unroll
                  for (int q = 0; q < 4; ++q) { const f32x4 dv = *(const LAS f32x4*)(DEC + 32 * wm + 8 * q + 4 * hh);
#pragma unroll
                      for (int t = 0; t < 4; ++t) { S[4 * q + t] = dv[t] * S[4 * q + t] + ds[4 * q + t]; sop[(long)(8 * q + t) * sstep] = bfr(o[4 * q + t]); } } }
                LBAR();
            }
#undef GLA_LOAD
        }
    }
    for (int pi = w.bid; pi < 192; pi += w.G) {
        if (pi < 64) continue;
        const int mix = pi >> 6, b = (pi & 63) >> 2, h = pi & 3;
        const int chain = (b * 4 + h) * 2 + dir;
        f32x16 S = zero16();
        bf16* so = SO + (size_t)(mix * 2 + dir) * MT * 256 + h * 64 + 32 * wn + r;
        {
            const int i = tl >> 2, dq = tl & 3;
            const float al = expf(mix == 1 ? a.in[I_GDN_ALOG][(l * 2 + dir) * 4 + h] : a.in[I_SSD_ALOG][(l * 2 + dir) * 4 + h]);
            const float dtb = mix == 1 ? a.in[I_GDN_DTB][(l * 2 + dir) * 4 + h] : a.in[I_SSD_DTB][(l * 2 + dir) * 4 + h];
            v4u rq0s[2], rq1s[2], rk0s[2], rk1s[2], ra0s[2], ra1s[2], rb0s[2], rb1s[2]; float rs0s[2] = {0.f, 0.f}, rs1s[2] = {0.f, 0.f};
#pragma unroll
            for (int u = 0; u < 2; ++u) { rq0s[u] = rq1s[u] = rk0s[u] = rk1s[u] = ra0s[u] = ra1s[u] = rb0s[u] = rb1s[u] = (v4u){0u, 0u, 0u, 0u}; }
#define SD_LOAD(c_, u_) do { const int row_ = chain_row(b, dir, (c_), i); \
                if (mix == 1) { const v4u* pq_ = (const v4u*)(PB + (size_t)row_ * NPB + h * 64 + 16 * dq); const v4u* pk_ = (const v4u*)(PB + (size_t)row_ * NPB + 256 + h * 64 + 16 * dq); rq0s[u_] = pq_[0]; rq1s[u_] = pq_[1]; rk0s[u_] = pk_[0]; rk1s[u_] = pk_[1]; \
                    const v4u* pw_ = (const v4u*)(WW + (size_t)(chain * 36 + (c_)) * 4096 + i * 64 + 16 * dq); const v4u* pu_ = (const v4u*)(UT + (size_t)(chain * 36 + (c_)) * 4096 + i * 64 + 16 * dq); ra0s[u_] = pw_[0]; ra1s[u_] = pw_[1]; rb0s[u_] = pu_[0]; rb1s[u_] = pu_[1]; } \
                else { const v4u* pq_ = (const v4u*)(PB + (size_t)row_ * NPB + 768 + 384 + (h >> 1) * 64 + 16 * dq); const v4u* pk_ = (const v4u*)(PB + (size_t)row_ * NPB + 768 + 256 + (h >> 1) * 64 + 16 * dq); rq0s[u_] = pq_[0]; rq1s[u_] = pq_[1]; rk0s[u_] = pk_[0]; rk1s[u_] = pk_[1]; \
                    const v4u* pv_ = (const v4u*)(PB + (size_t)row_ * NPB + 768 + h * 64 + 16 * dq); ra0s[u_] = pv_[0]; ra1s[u_] = pv_[1]; } \
                if (gw4 == 0) { const int rj_ = chain_row(b, dir, (c_), lane); if (mix == 1) { rs0s[u_] = ZF[(size_t)rj_ * NZF + 512 + dir * 4 + h]; rs1s[u_] = ZF[(size_t)rj_ * NZF + 520 + dir * 4 + h]; } else rs0s[u_] = ZF[(size_t)rj_ * NZF + 528 + dir * 4 + h]; } } while (0)
            SD_LOAD(0, 0); SD_LOAD(1, 1);
            for (int c2 = 0; c2 < 36; c2 += 2) {
#pragma unroll
            for (int u = 0; u < 2; ++u) { const int c = c2 + u;
                if (gw4 == 0) { const float sp = softplus_acc(rs0s[u] + dtb); float g = -al * sp;
                    g = wave_scan(g);
                    G[lane] = g; EG[lane] = __expf(g); BD[lane] = (mix == 1) ? sigmoid_acc(rs1s[u]) : sp; }
                LBAR();
                { const float gi = G[i], g63 = G[63]; const float kdsc = __expf(g63 - gi), vsc = (mix == 2) ? BD[i] : 1.0f;
                  const int colsw = ((((i >> 3) ^ dq) << 3) | (i & 7)); LAS bf16* kdb = TKD + 16 * dq * TS + colsw; LAS bf16* vtb = TVT + 16 * dq * TS + colsw;
                  *(LAS v4u*)(TQ + i * TS + 16 * dq) = rq0s[u]; *(LAS v4u*)(TQ + i * TS + 16 * dq + 8) = rq1s[u];
                  *(LAS v4u*)(TK + i * TS + 16 * dq) = rk0s[u]; *(LAS v4u*)(TK + i * TS + 16 * dq + 8) = rk1s[u];
                  float kf[8];
                  unpack8(rk0s[u], kf);
#pragma unroll
                  for (int t = 0; t < 8; ++t) kdb[t * TS] = bfr(kf[t] * kdsc);
                  unpack8(rk1s[u], kf);
#pragma unroll
                  for (int t = 0; t < 8; ++t) kdb[(8 + t) * TS] = bfr(kf[t] * kdsc);
                  if (mix == 2) { unpack8(ra0s[u], kf);
#pragma unroll
                      for (int t = 0; t < 8; ++t) vtb[t * TS] = bfr(kf[t] * vsc);
                      unpack8(ra1s[u], kf);
#pragma unroll
                      for (int t = 0; t < 8; ++t) vtb[(8 + t) * TS] = bfr(kf[t] * vsc); }
                  else { *(LAS v4u*)(TX + i * TS + 16 * dq) = ra0s[u]; *(LAS v4u*)(TX + i * TS + 16 * dq + 8) = ra1s[u];
                         *(LAS v4u*)(TVT + swz(i, 16 * dq)) = rb0s[u]; *(LAS v4u*)(TVT + swz(i, 16 * dq + 8)) = rb1s[u]; } }
                store_state_T(TST, S, wm, wn, r, hh);
                if (c + 2 < 36) SD_LOAD(c + 2, u);
                LBAR();
                { f32x16 acc = zero16();
                  if (wn >= wm) acc = mma64(acc, TK + 32 * wm * TS, TQ + 32 * wn * TS, lane);
                  const int ii = 32 * wn + r; const float gi = G[ii];
#pragma unroll
                  for (int q = 0; q < 4; ++q) { const int j0 = 32 * wm + 8 * q + 4 * hh; const f32x4 gj = *(const LAS f32x4*)(G + j0); float pv[4];
#pragma unroll
                      for (int t = 0; t < 4; ++t) pv[t] = (j0 + t <= ii) ? acc[4 * q + t] * __expf(gi - gj[t]) : 0.f;
                      st4bf(TP + ii * TS + j0, pv[0], pv[1], pv[2], pv[3]); }
                  if (mix == 1) { f32x16 ws_ = zero16(); ws_ = mma64(ws_, TX + 32 * wm * TS, TST + 32 * wn * TS, lane);
#pragma unroll
                      for (int q = 0; q < 4; ++q) { LAS bf16* up = TVT + swz(32 * wn + r, 32 * wm + 8 * q + 4 * hh); const v2u uu = *(const LAS v2u*)up;
                          st4bf(up, bf2f(uu.x & 0xffffu) - ws_[4 * q], bf2f(uu.x >> 16) - ws_[4 * q + 1], bf2f(uu.y & 0xffffu) - ws_[4 * q + 2], bf2f(uu.y >> 16) - ws_[4 * q + 3]); } } }
                LBAR();
                { bf16* sop = so + (size_t)chain_row(b, dir, c, 32 * wm + 4 * hh) * 256; const long sstep = dir ? -256 : 256;
                  f32x16 o = zero16(); o = mma64s<false, true>(o, TP, wm, TVT, wn, lane);
                  f32x16 qs = zero16(); qs = mma64(qs, TQ + 32 * wm * TS, TST + 32 * wn * TS, lane);
                  f32x16 ds = zero16(); ds = mma64s<true, true>(ds, TKD, wm, TVT, wn, lane);
                  const float dsc = EG[63];
#pragma unroll
                  for (int q = 0; q < 4; ++q) { const f32x4 eg = *(const LAS f32x4*)(EG + 32 * wm + 8 * q + 4 * hh);
#pragma unroll
                      for (int t = 0; t < 4; ++t) { S[4 * q + t] = dsc * S[4 * q + t] + ds[4 * q + t]; sop[(long)(8 * q + t) * sstep] = bfr(o[4 * q + t] + eg[t] * qs[4 * q + t]); } } }
                LBAR();
            } }
#undef SD_LOAD
        }
    }
}

constexpr size_t WS_TW = WS_LB + 65536;
__device__ __forceinline__ int fpad(int i) { return i + ((i >> 7) << 3); }
__device__ __forceinline__ void cst16(int k, float& c, float& s) {
    constexpr float C[8] = {1.0f, 0.92387953251128674f, 0.70710678118654752f, 0.38268343236508977f, 0.0f, -0.38268343236508977f, -0.70710678118654752f, -0.92387953251128674f};
    constexpr float S[8] = {0.0f, -0.38268343236508977f, -0.70710678118654752f, -0.92387953251128674f, -1.0f, -0.92387953251128674f, -0.70710678118654752f, -0.38268343236508977f};
    c = C[k]; s = S[k]; }
template <int LOGN, int S0, int R, int NCOL>
__device__ __forceinline__ void fft_pass(LAS float* XR, LAS float* XI, const float* TW, int tid) {
    constexpr int N = 1 << LOGN, G = 1 << R, STR = N >> (S0 + R), NGC = N / G, CS = N + 8 * (N / 128);
    for (int gi = tid; gi < NCOL * NGC; gi += NTHREADS) {
        const int col = gi / NGC, g = gi - col * NGC, lo = g & (STR - 1), hi = g / STR;
        const int i0 = hi * (STR * G) + lo;
        LAS float* xr = XR + col * CS; LAS float* xi = XI + col * CS;
        float er[G], ei[G];
        if constexpr (STR == 1) {
#pragma unroll
            for (int m = 0; m < G; m += 4) { const f32x4 a = *(const LAS f32x4*)(xr + fpad(i0) + m), b = *(const LAS f32x4*)(xi + fpad(i0) + m);
#pragma unroll
                for (int t = 0; t < 4; ++t) { er[m + t] = a[t]; ei[m + t] = b[t]; } }
        } else {
#pragma unroll
            for (int m = 0; m < G; ++m) { er[m] = xr[fpad(i0 + STR * m)]; ei[m] = xi[fpad(i0 + STR * m)]; }
        }
#pragma unroll
        for (int t = 0; t < R; ++t) {
            constexpr int dummy = 0; (void)dummy;
            const int hs = G >> (t + 1), s = S0 + t;
            float wlr = 1.0f, wli = 0.0f;
            if constexpr (STR > 1) { const int ti = (lo << s) * (2048 / N); wlr = TW[2 * ti]; wli = TW[2 * ti + 1]; }
#pragma unroll
            for (int blk = 0; blk < G; blk += 2 * hs)
#pragma unroll
                for (int q = 0; q < hs; ++q) {
                    const float ar = er[blk + q], ai = ei[blk + q], br = er[blk + q + hs], bi = ei[blk + q + hs];
                    const float dr = ar - br, di = ai - bi;
                    er[blk + q] = ar + br; ei[blk + q] = ai + bi;
                    float cr, ci; cst16((q << t) * (16 / G), cr, ci);
                    float tr, tim;
                    if (q == 0) { tr = wlr; tim = wli; } else if constexpr (STR == 1) { tr = cr; tim = ci; } else { tr = wlr * cr - wli * ci; tim = wlr * ci + wli * cr; }
                    er[blk + q + hs] = dr * tr - di * tim; ei[blk + q + hs] = dr * tim + di * tr;
                }
        }
        if constexpr (STR == 1) {
#pragma unroll
            for (int m = 0; m < G; m += 4) { *(LAS f32x4*)(xr + fpad(i0) + m) = (f32x4){er[m], er[m + 1], er[m + 2], er[m + 3]}; *(LAS f32x4*)(xi + fpad(i0) + m) = (f32x4){ei[m], ei[m + 1], ei[m + 2], ei[m + 3]}; }
        } else {
#pragma unroll
            for (int m = 0; m < G; ++m) { xr[fpad(i0 + STR * m)] = er[m]; xi[fpad(i0 + STR * m)] = ei[m]; }
        }
    }
}
template <int LOGN, int NCOL>
__device__ __forceinline__ void fft_items(const Args& a, LAS unsigned char* lds, const WCtx& w, const bf16* VT, float* FO, int rowbase0, float scale) {
    constexpr int N = 1 << LOGN, CS = N + 8 * (N / 128), NCG = 256 / NCOL, TPC = NTHREADS / NCOL;
    LAS float* XR = (LAS float*)lds; LAS float* XI = XR + NCOL * CS; const float* TW = (const float*)(a.ws + WS_TW);
    const int c = w.tid / TPC, j = w.tid - c * TPC;
    for (int it = w.bid; it < 16 * NCG; it += w.G) {
        const int b = it / NCG, cg = it - b * NCG, ch = cg * NCOL + c;
        const bf16* src = VT + (size_t)(b * 256 + ch) * (2 * N);
        for (int m = j; m < N / 8; m += TPC) {
            const v4u vr = *(const v4u*)(src + 8 * m), vi = *(const v4u*)(src + N + 8 * m); float f[8];
            unpack8(vr, f); *(LAS f32x4*)(XR + c * CS + fpad(8 * m)) = (f32x4){f[0], f[1], f[2], f[3]}; *(LAS f32x4*)(XR + c * CS + fpad(8 * m) + 4) = (f32x4){f[4], f[5], f[6], f[7]};
            unpack8(vi, f); *(LAS f32x4*)(XI + c * CS + fpad(8 * m)) = (f32x4){f[0], f[1], f[2], f[3]}; *(LAS f32x4*)(XI + c * CS + fpad(8 * m) + 4) = (f32x4){f[4], f[5], f[6], f[7]}; }
        __syncthreads();
        if constexpr (LOGN == 11) { fft_pass<11, 0, 4, NCOL>(XR, XI, TW, w.tid); __syncthreads(); fft_pass<11, 4, 4, NCOL>(XR, XI, TW, w.tid); __syncthreads(); fft_pass<11, 8, 3, NCOL>(XR, XI, TW, w.tid); }
        else { fft_pass<8, 0, 4, NCOL>(XR, XI, TW, w.tid); __syncthreads(); fft_pass<8, 4, 4, NCOL>(XR, XI, TW, w.tid); }
        __syncthreads();
        { const int oc = w.tid % NCOL, k0 = w.tid / NCOL; float* dst = FO + (size_t)(rowbase0 + b * N) * 256 + cg * NCOL + oc;
          for (int kt = k0; kt < N; kt += TPC) { const int br_ = (int)(__brev((unsigned)kt) >> (32 - LOGN)); dst[(size_t)kt * 256] = XR[oc * CS + fpad(br_)] * scale; } }
        __syncthreads();
    }
}
__device__ __forceinline__ void phase_fourier_time(const Args& a, LAS unsigned char* lds, const WCtx& w) {
    fft_items<11, 8>(a, lds, w, (const bf16*)(a.ws + WS_VTL), (float*)(a.ws + WS_FO), 0, 0.0027621358640099515f);
    fft_items<8, 32>(a, lds, w, (const bf16*)(a.ws + WS_VTC), (float*)(a.ws + WS_FO), ML, 0.0078125f);
}
constexpr int PPL = 13;
constexpr int N_PHASES = 2 + PPL * DEPTH;
#ifndef PHMASK
#define PHMASK 0xFFFFu
#endif
#define EN(k) (((PHMASK) >> (k)) & 1u)
__global__ void __launch_bounds__(NTHREADS, 2) fwd_kernel(Args args) {
    extern __shared__ __attribute__((aligned(16))) unsigned char lds_raw[];
    LAS unsigned char* lds = (LAS unsigned char*)lds_raw;
#define MKW() WCtx w; { int t_ = threadIdx.x; asm volatile("" : "+v"(t_)); w.tid = t_; w.lane = t_ & 63; w.wave = __builtin_amdgcn_readfirstlane(t_ >> 6); { int b_ = blockIdx.x; asm volatile("" : "+s"(b_)); w.bid = b_; } { int g_ = gridDim.x; asm volatile("" : "+s"(g_)); w.G = g_; } w.gw = w.bid * NWAVES + w.wave; w.NGW = w.G * NWAVES; } \
              unsigned char* ws = args.ws; asm volatile("" : "+s"(ws)); const int c = w.bid; (void)c; (void)ws
    for (int u = threadIdx.x; u < (LDS_BYTES - LDSCTL_OFF) / 4; u += NTHREADS) ((LAS unsigned*)(lds + LDSCTL_OFF))[u] = 0u;
    __syncthreads();
    XcdBarrier bar = xcd_barrier_post((unsigned*)(args.ws + WS_CTL) + CW_BAR + args.li * XCD_BAR_WORDS, (volatile LAS unsigned*)(lds + MISC_OFF) + 8);
    const int lo = args.ph_lo, hi = args.ph_hi;
#define INP(k) (lo <= (k) && (k) < hi)
#define SEAM(k) do { if (INP(k) && INP((k) + 1)) xcd_barrier(bar); } while (0)
#ifdef PROBE_MASK
    unsigned long long pr_prev = __builtin_amdgcn_s_memrealtime(), pr_acc = 0ull;
#define STAMP(slot) do { const unsigned long long n_ = __builtin_amdgcn_s_memrealtime(); if (((PROBE_MASK) >> (slot)) & 1u) pr_acc += n_ - pr_prev; pr_prev = n_; } while (0)
#else
#define STAMP(slot) do { } while (0)
#endif
    if (EN(12) && INP(0)) { MKW(); phase_prologue(args, lds, w); }
    SEAM(0); STAMP(12);
    if (EN(13) && INP(1)) { MKW(); phase_mod_rows(args, w, 0); }
    SEAM(1); STAMP(13);
    for (int l = 0; l < DEPTH; ++l) {
        const int pb = 2 + PPL * l;
        const bool lastl = (l == DEPTH - 1);
        const int nrows = lastl ? ML : MT, nMr = nrows / 256;
        if (EN(0) && INP(pb + 0)) { MKW();
            { pg8::Order<MapPlain> S; S.init(MT / 256, 11, w.G, c); S.map = MapPlain{(const char*)(ws + WS_H), (const char*)(ws + WS_WIN), (size_t)256 * 1024 * 2, (size_t)256 * 1024 * 2};
              EpiZB E{(bf16*)(ws + WS_ZB)};
              pg8::gemm_phase<EpiZB, pg8::Order<MapPlain>>(lds, pg8::Gemm{1024, 1024, 1024}, S, E); }
            { pg8::Order<MapPlain> S; S.init(MT / 256, 3, w.G, w.G - 1 - c); S.map = MapPlain{(const char*)(ws + WS_H), (const char*)(ws + WS_WIN) + (size_t)11 * 256 * 1024 * 2, (size_t)256 * 1024 * 2, (size_t)256 * 1024 * 2};
              EpiZF E{(float*)(ws + WS_ZF), (const float*)(ws + WS_LB) + l * 256};
              pg8::gemm_phase<EpiZF, pg8::Order<MapPlain>>(lds, pg8::Gemm{1024, 1024, 1024}, S, E); }
        }
        SEAM(pb + 0); STAMP(0);
        if (EN(1) && INP(pb + 1)) { MKW();
            pg8::Order<MapPlain> S; S.init(2, MT / 256, w.G, c); S.map = MapPlain{(const char*)(ws + WS_DFT64), (const char*)(ws + WS_ZB) + 1792 * 2, (size_t)256 * 256 * 2, (size_t)256 * NZB * 2};
            EpiFour1 E{(bf16*)(ws + WS_VTL), (bf16*)(ws + WS_VTC)};
            pg8::gemm_phase<EpiFour1, pg8::Order<MapPlain>>(lds, pg8::Gemm{256, 256, NZB}, S, E);
            if (EN(15)) phase_prep(args, w, l);
        }
        SEAM(pb + 1); STAMP(1);
        if (EN(2) && INP(pb + 2)) { MKW();
            phase_fourier_time(args, lds, w);
            __syncthreads();
            if (EN(14)) phase_gdn_solve(args, lds, w, l);
            __syncthreads(); convert_rest(args, lds, w.wave, w.lane, w.gw, w.NGW, l, WI_XA, WI_XB);
        }
        SEAM(pb + 2); STAMP(2);
        if (EN(14) && INP(pb + 3)) { MKW();
            if (w.G > 192) { if (w.bid >= 192) convert_rest(args, lds, w.wave, w.lane, (w.bid - 192) * NWAVES + w.wave, (w.G - 192) * NWAVES, l, 0, WI_XA); else phase_scan_chunk(args, lds, w, l); }
            else { phase_scan_chunk(args, lds, w, l); __syncthreads(); convert_rest(args, lds, w.wave, w.lane, w.gw, w.NGW, l, 0, WI_XA); } }
        SEAM(pb + 3); STAMP(14);
        if (EN(3) && INP(pb + 4)) { MKW(); phase_finish(args, w, l, nrows); }
        SEAM(pb + 4); STAMP(3);
        if (EN(4) && INP(pb + 5)) { MKW();
            pg8::Order<MapP> S; S.init(nMr, 16, w.G, c); S.map = MapP{(const char*)(ws + WS_OUTS), (const char*)(ws + WS_WBR)};
            EpiP E{(bf16*)(ws + WS_P)};
            pg8::gemm_phase<EpiP, pg8::Order<MapP>>(lds, pg8::Gemm{256, 1024, 256}, S, E);
        }
        SEAM(pb + 5); STAMP(4);
        if (EN(5) && INP(pb + 6)) { MKW();
            pg8::Order<MapPlain> S; S.init(nMr, 16, w.G, c); S.map = MapPlain{(const char*)(ws + WS_H8), (const char*)(ws + WS_WG), (size_t)256 * 1024, (size_t)256 * 1024};
            EpiMerge E{(const bf16*)(ws + WS_P), (bf16*)(ws + WS_T), args.in[I_BGATE] + (size_t)l * 4096};
            pg8::gemm_phase<EpiMerge, pg8::Order<MapPlain>, true, true, false, 1>(lds, pg8::Gemm{1024, 1024, 1024, 0x79797979, 0x7F7F7F7F}, S, E);
        }
        SEAM(pb + 6); STAMP(5);
        if (EN(6) && INP(pb + 7)) { MKW();
            pg8::Order<MapPlain> S; S.init(nMr, 4, w.G, c); S.map = MapPlain{(const char*)(ws + WS_T), (const char*)(ws + WS_WOUT), (size_t)256 * 1024 * 2, (size_t)256 * 1024 * 2};
            EpiBf E{(bf16*)(ws + WS_Y), 1024, nullptr};
            pg8::gemm_phase<EpiBf, pg8::Order<MapPlain>>(lds, pg8::Gemm{1024, 1024, 1024}, S, E);
            { const int rr = (nMr * 4) % w.G; __syncthreads();
              if (rr > 0) { if (c >= rr) convert_rest(args, lds, w.wave, w.lane, (c - rr) * NWAVES + w.wave, (w.G - rr) * NWAVES, l, WI_XB, WI_REST); }
              else convert_rest(args, lds, w.wave, w.lane, w.gw, w.NGW, l, WI_XB, WI_REST); }
        }
        SEAM(pb + 7); STAMP(6);
        if (EN(7) && INP(pb + 8)) { MKW(); phase_ln1(args, lds, w, l, nrows); }
        SEAM(pb + 8); STAMP(7);
        if (EN(8) && INP(pb + 9)) { MKW(); phase_topk(args, lds, w, lastl ? 256 : 512); }
        SEAM(pb + 9); STAMP(8);
        const int nMe = lastl ? 256 : 288;
        if (EN(9) && INP(pb + 10)) { MKW();
            pg8::Order<MapMoEG> S; S.init(nMe, 8, w.G, c); S.map = MapMoEG{(const char*)(ws + WS_H), (const char*)(ws + WS_WGU), (size_t)2048 * 1024, (size_t)256 * 1024};
            EpiSwiGLU E{(unsigned char*)(ws + WS_HID)};
            pg8::gemm_phase<EpiSwiGLU, pg8::Order<MapMoEG>, true, true, true, 1>(lds, pg8::Gemm{1024, 1024, 1024, 0x79797979, 0x7F7F7F7F}, S, E, (const int*)(ws + WS_ROWW + 512 * 1024));
        }
        SEAM(pb + 10); STAMP(9);
        if (EN(10) && INP(pb + 11)) { MKW();
            pg8::Order<MapMoE> S; S.init(nMe, 4, w.G, c); S.map = MapMoE{(const char*)(ws + WS_HID), (const char*)(ws + WS_WDN), (size_t)1024 * 1024, (size_t)256 * 1024};
            EpiF8 E{(unsigned char*)(ws + WS_YE), (const float*)(ws + WS_ROWW)};
            pg8::gemm_phase<EpiF8, pg8::Order<MapMoE>, true, true, false, 1>(lds, pg8::Gemm{1024, 1024, 1024, 0x79797979, 0x7F7F7F7F}, S, E);
        }
        SEAM(pb + 11); STAMP(10);
        if (EN(11) && INP(pb + 12)) { MKW(); phase_ln2(args, lds, w, l, nrows); if (!lastl) { __syncthreads(); convert_win(args, lds, w.wave, w.lane, w.gw, w.NGW, l + 1); } }
        SEAM(pb + 12); STAMP(11);
    }
#ifdef PROBE_MASK
    if (blockIdx.x == 0 && threadIdx.x == 0) { const unsigned long long t0_ = __builtin_amdgcn_s_memrealtime(); while (__builtin_amdgcn_s_memrealtime() - t0_ < 4ull * pr_acc) __builtin_amdgcn_s_sleep(8); }
#endif
#undef INP
#undef SEAM
}

#ifndef MK_SPLIT
#define MK_SPLIT 0
#endif
extern "C" void kernel_launch(void* const* d_in, const int* in_sizes, int n_in, void* d_out, int out_size, void* d_ws, size_t ws_size, hipStream_t stream) {
    static int grid = 0;
    if (grid == 0) {
        if (n_in != 31 || out_size != ML * D || ws_size < WS_END) { fprintf(stderr, "kernel_launch: unexpected problem (n_in %d, out %d, ws %zu, need %zu)\n", n_in, out_size, ws_size, (size_t)WS_END); grid = -1; return; }
        int dev = 0, cus = 0, per_cu = 0;
        if (hipGetDevice(&dev) != hipSuccess || hipDeviceGetAttribute(&cus, hipDeviceAttributeMultiprocessorCount, dev) != hipSuccess) { grid = -1; return; }
        if (hipFuncSetAttribute((const void*)fwd_kernel, hipFuncAttributeMaxDynamicSharedMemorySize, LDS_BYTES) != hipSuccess) { fprintf(stderr, "kernel_launch: hipFuncSetAttribute failed\n"); grid = -1; return; }
        if (hipOccupancyMaxActiveBlocksPerMultiprocessor(&per_cu, (const void*)fwd_kernel, NTHREADS, LDS_BYTES) != hipSuccess || per_cu < 1) fprintf(stderr, "kernel_launch: occupancy query says %d\n", per_cu);
        (void)hipGetLastError();
        grid = cus;
    }
    if (grid < 0) return;
    if (hipMemsetAsync((char*)d_ws + WS_CTL, 0, CTL_ZERO_BYTES, stream) != hipSuccess) return;
    Args a{};
    for (int i = 0; i < 31; ++i) a.in[i] = (const float*)d_in[i];
    a.out = (float*)d_out; a.ws = (unsigned char*)d_ws;
#if MK_SPLIT
    for (int p = 0; p < N_PHASES; ++p) { a.ph_lo = p; a.ph_hi = p + 1; a.li = p; a.pad = 0; hipLaunchKernelGGL(fwd_kernel, dim3(grid), dim3(NTHREADS), LDS_BYTES, stream, a); }
#else
    a.ph_lo = 0; a.ph_hi = N_PHASES; a.li = 0; a.pad = 0;
    hipLaunchKernelGGL(fwd_kernel, dim3(grid), dim3(NTHREADS), LDS_BYTES, stream, a);
#endif
    const hipError_t le = hipPeekAtLastError();
    if (le != hipSuccess) fprintf(stderr, "kernel_launch: launch failed: %s\n", hipGetErrorName(le));
}
```
